# Optimizing an MI355X kernel written in HIP

```python
import math
import jax, jax.numpy as jnp
from jax import lax
import numpy as np

D_MODEL = 1024
BATCH = 2
SEQ = 8192
DEPTH = 2

N_A_LAYERS = DEPTH // 2
N_B_LAYERS = DEPTH - N_A_LAYERS
N_DENSE = (DEPTH + 1) // 2
N_MOE = DEPTH // 2

HGRN_HEADS = 8
HGRN_HEAD_DIM = D_MODEL // HGRN_HEADS
HGRN_CHUNK = 64

NSA_HEADS = 16
NSA_KV_HEADS = 4
NSA_HPG = NSA_HEADS // NSA_KV_HEADS
NSA_HEAD_DIM = D_MODEL // NSA_HEADS
N_BRANCH = 3
CMP_BLOCK = 32
CMP_STRIDE = 16
CMP_HIDDEN = 256
SLC_BLOCK = 64
SLC_TOP = 16
WINDOW = 512
Q_BLOCK = 128

REL_BUCKETS = 32
REL_MAX_DIST = 2048

FFN_DIM = 2816
N_EXPERTS = 8
TOP_K = 2
EXPERT_DIM = 3584

NORM_EPS = 1e-6
NEG_INF = -1e30
FORCE_BONUS = 1e4

kernel_name = "hybrid_hgrn2_nsa_yoco_moe"


def rmsnorm(x, g):
    xf = x.astype(jnp.float32)
    y = xf * lax.rsqrt(jnp.mean(xf * xf, axis=-1, keepdims=True) + NORM_EPS)
    return (y * g.astype(jnp.float32)).astype(x.dtype)


def rel_bucket(dist):
    max_exact = REL_BUCKETS // 2
    d = jnp.maximum(dist, 0)
    large = max_exact + (jnp.log(jnp.maximum(d, 1).astype(jnp.float32) / max_exact)
                         / math.log(REL_MAX_DIST / max_exact) * (REL_BUCKETS - max_exact)).astype(jnp.int32)
    large = jnp.minimum(large, REL_BUCKETS - 1)
    return jnp.where(d < max_exact, d, large)


def masked_softmax(logits, mask):
    p = jax.nn.softmax(jnp.where(mask, logits, NEG_INF), axis=-1)
    return p * mask


def swiglu(x, w_gu, w_down):
    gate, up = jnp.split(x @ w_gu, 2, axis=-1)
    return (jax.nn.silu(gate) * up) @ w_down


def moe_swiglu(xn, w_router, w_gu, w_down):
    logits = (xn @ w_router).astype(jnp.float32)
    top_v, top_i = lax.top_k(logits, TOP_K)
    top_w = jax.nn.softmax(top_v, axis=-1)
    gates = jnp.sum(jax.nn.one_hot(top_i, N_EXPERTS, dtype=jnp.float32) * top_w[..., None], axis=-2)
    out = jnp.zeros(xn.shape, jnp.float32)
    for e in range(N_EXPERTS):
        out = out + gates[..., e:e + 1] * swiglu(xn, w_gu[e], w_down[e]).astype(jnp.float32)
    return out.astype(xn.dtype)


def hgrn2_mixer(xn, w_in, w_out, o_norm_g, lb):
    B, T, D = xn.shape
    H, dh, C = HGRN_HEADS, HGRN_HEAD_DIM, HGRN_CHUNK
    nC = T // C
    q, f, i, g = jnp.split(xn @ w_in, 4, axis=-1)
    fgate = lb + (1.0 - lb) * jax.nn.sigmoid(f.astype(jnp.float32))
    k = 1.0 - fgate

    def chunks(t):
        return t.astype(jnp.float32).reshape(B, nC, C, H, dh).transpose(1, 0, 3, 2, 4)

    qc, kc, vc = chunks(q), chunks(k), chunks(i)
    bc = jnp.cumsum(chunks(jnp.log(fgate)), axis=3)
    tril = jnp.tril(jnp.ones((C, C), bool))

    def step(S, inp):
        qj, kj, vj, bj = inp
        rel = bj[:, :, :, None, :] - bj[:, :, None, :, :]
        dec = jnp.where(tril[:, :, None], jnp.exp(jnp.minimum(rel, 0.0)), 0.0)
        attn = jnp.einsum('bhsud,bhud->bhsu', qj[:, :, :, None, :] * dec, kj)
        o = (jnp.einsum('bhsu,bhue->bhse', attn, vj)
             + jnp.einsum('bhsd,bhde->bhse', qj * jnp.exp(bj), S))
        b_last = bj[:, :, -1, :]
        S = (jnp.exp(b_last)[..., None] * S
             + jnp.einsum('bhud,bhue->bhde', kj * jnp.exp(b_last[:, :, None, :] - bj), vj))
        return S, o

    S0 = jnp.zeros((B, H, dh, dh), jnp.float32)
    _, o = lax.scan(step, S0, (qc, kc, vc, bc))
    o = o.transpose(1, 0, 3, 2, 4).reshape(B, T, H, dh)
    o = rmsnorm(o, o_norm_g).reshape(B, T, D) * jax.nn.silu(g.astype(jnp.float32))
    return o.astype(xn.dtype) @ w_out


def compress_blocks(t, pos, w1, w2):
    B, T, Hk, dh = t.shape
    ch = t.reshape(B, T // CMP_STRIDE, CMP_STRIDE, Hk, dh)
    blocks = jnp.concatenate([ch[:, :-1], ch[:, 1:]], axis=2) + pos[None, None, :, None, :]
    flat = blocks.transpose(0, 1, 3, 2, 4).reshape(B, -1, Hk, CMP_BLOCK * dh)
    return jax.nn.gelu(flat @ w1) @ w2


def nsa_shared_kv(h, kv_norm_g, w_kv, k_norm_g, cmp_pos_k, cmp_w1_k, cmp_w2_k,
                  cmp_pos_v, cmp_w1_v, cmp_w2_v):
    B, T, _ = h.shape
    G, dh = NSA_KV_HEADS, NSA_HEAD_DIM
    kv = (rmsnorm(h, kv_norm_g) @ w_kv).reshape(B, T, N_BRANCH, 2, G, dh)
    k, v = kv[:, :, :, 0], kv[:, :, :, 1]
    k_cmp = rmsnorm(compress_blocks(k[:, :, 0], cmp_pos_k, cmp_w1_k, cmp_w2_k), k_norm_g[0])
    v_cmp = compress_blocks(v[:, :, 0], cmp_pos_v, cmp_w1_v, cmp_w2_v)
    k_slc = rmsnorm(k[:, :, 1], k_norm_g[1])
    k_win = rmsnorm(k[:, :, 2], k_norm_g[2])
    n_sel = T // SLC_BLOCK

    def heads(t):
        return t.transpose(0, 2, 1, 3)

    def blocked(t):
        return heads(t).reshape(B, G, n_sel, SLC_BLOCK, dh)

    def padded(t):
        return jnp.pad(heads(t), ((0, 0), (0, 0), (WINDOW, 0), (0, 0)))

    return (heads(k_cmp), heads(v_cmp), blocked(k_slc), blocked(v[:, :, 1]),
            padded(k_win), padded(v[:, :, 2]))


def nsa_mixer(xn, w_in, w_out, q_norm_g, rel_bias, k_cmp, v_cmp, k_slc, v_slc, k_win, v_win):
    B, T, _ = xn.shape
    G, HP, dh = NSA_KV_HEADS, NSA_HPG, NSA_HEAD_DIM
    n_cmp = k_cmp.shape[2]
    n_sel = T // SLC_BLOCK
    n_top = min(SLC_TOP, n_sel)
    n_qb = T // Q_BLOCK
    f32 = jnp.float32

    proj = xn @ w_in
    q = rmsnorm(proj[..., :NSA_HEADS * dh].reshape(B, T, G, HP, dh), q_norm_g) * (dh ** -0.5)
    q = q.transpose(0, 2, 3, 1, 4)
    gates = jax.nn.sigmoid(proj[..., NSA_HEADS * dh:].astype(f32)).reshape(
        B, T, G, HP, N_BRANCH).transpose(0, 2, 3, 1, 4)
    tb = rel_bias.T.reshape(G, HP, REL_BUCKETS)

    cs = np.arange(n_cmp)[:, None] * CMP_STRIDE
    ss = np.arange(n_sel)[None, :] * SLC_BLOCK
    ov = np.clip(np.minimum(cs + CMP_BLOCK, ss + SLC_BLOCK) - np.maximum(cs, ss), 0, None)
    overlap = jnp.asarray(ov / CMP_BLOCK, dtype=f32)

    cmp_end = jnp.arange(n_cmp, dtype=jnp.int32) * CMP_STRIDE + (CMP_BLOCK - 1)
    blk = jnp.arange(n_sel, dtype=jnp.int32)
    dist_w_np = np.arange(Q_BLOCK)[:, None] + WINDOW - np.arange(Q_BLOCK + WINDOW)[None, :]
    win_mask = jnp.asarray((dist_w_np >= 0) & (dist_w_np < WINDOW))
    bias_w = tb[:, :, rel_bucket(jnp.asarray(dist_w_np, jnp.int32))]
    bi = jnp.arange(B)[:, None, None, None]
    gi = jnp.arange(G)[None, :, None, None]
    gi6 = jnp.arange(G)[None, :, None, None, None, None]
    hi6 = jnp.arange(HP)[None, None, :, None, None, None]

    def block(i):
        s0 = i * Q_BLOCK
        t = s0 + jnp.arange(Q_BLOCK, dtype=jnp.int32)
        qi = lax.dynamic_slice_in_dim(q, s0, Q_BLOCK, axis=3)
        gq = lax.dynamic_slice_in_dim(gates, s0, Q_BLOCK, axis=3)
        dist_c = t[:, None] - cmp_end[None, :]
        lc = jnp.einsum('bghqd,bgnd->bghqn', qi, k_cmp).astype(f32) + tb[:, :, rel_bucket(dist_c)]
        pc = masked_softmax(lc, dist_c >= 0)
        o_cmp = jnp.einsum('bghqn,bgnd->bghqd', pc, v_cmp.astype(f32))
        imp = jnp.einsum('bghqn,ns->bgqs', pc, overlap)
        cur = (t // SLC_BLOCK)[:, None]
        forced = (blk[None, :] == 0) | (blk[None, :] == cur) | (blk[None, :] == cur - 1)
        causal = blk[None, :] * SLC_BLOCK <= t[:, None]
        score = jnp.where(causal, imp + jnp.where(forced, FORCE_BONUS, 0.0), NEG_INF)
        _, top_i = lax.top_k(score, n_top)
        ks = k_slc[bi, gi, top_i]
        vs = v_slc[bi, gi, top_i]
        pos = top_i[..., None] * SLC_BLOCK + jnp.arange(SLC_BLOCK, dtype=jnp.int32)
        dist_s = t[None, None, :, None, None] - pos
        ls = (jnp.einsum('bghqd,bgqnsd->bghqns', qi, ks).astype(f32)
              + tb[gi6, hi6, rel_bucket(dist_s)[:, :, None]])
        ps = masked_softmax(ls.reshape(B, G, HP, Q_BLOCK, n_top * SLC_BLOCK),
                            (dist_s >= 0).reshape(B, G, 1, Q_BLOCK, n_top * SLC_BLOCK))
        o_slc = jnp.einsum('bghqm,bgqmd->bghqd', ps,
                           vs.reshape(B, G, Q_BLOCK, n_top * SLC_BLOCK, dh).astype(f32))
        kw = lax.dynamic_slice_in_dim(k_win, s0, Q_BLOCK + WINDOW, axis=2)
        vw = lax.dynamic_slice_in_dim(v_win, s0, Q_BLOCK + WINDOW, axis=2)
        kpos = s0 - WINDOW + jnp.arange(Q_BLOCK + WINDOW, dtype=jnp.int32)
        lw = jnp.einsum('bghqd,bgkd->bghqk', qi, kw).astype(f32) + bias_w
        pw = masked_softmax(lw, win_mask & (kpos >= 0)[None, :])
        o_win = jnp.einsum('bghqk,bgkd->bghqd', pw, vw.astype(f32))
        return gq[..., 0:1] * o_cmp + gq[..., 1:2] * o_slc + gq[..., 2:3] * o_win

    outs = lax.map(block, jnp.arange(n_qb, dtype=jnp.int32))
    o = outs.transpose(1, 0, 4, 2, 3, 5).reshape(B, T, NSA_HEADS * dh)
    return o.astype(xn.dtype) @ w_out


def setup_inputs(seed: int = 0) -> dict:
    key = jax.random.key(seed)
    ks = jax.random.split(key, 32)
    f32 = jnp.float32
    H, dh, G = NSA_HEADS, NSA_HEAD_DIM, NSA_KV_HEADS

    def nrm(k, shape, fan_in):
        return jax.random.normal(k, shape, f32) * fan_in ** -0.5

    def gain(k, shape):
        return 1.0 + 0.02 * jax.random.normal(k, shape, f32)

    return {
        'x': jax.random.normal(ks[0], (BATCH, SEQ, D_MODEL), f32),
        'norm_mix_g': gain(ks[1], (DEPTH, D_MODEL)),
        'norm_ffn_g': gain(ks[2], (DEPTH, D_MODEL)),
        'a_w_in': nrm(ks[3], (N_A_LAYERS, D_MODEL, 4 * D_MODEL), D_MODEL),
        'a_w_out': nrm(ks[4], (N_A_LAYERS, D_MODEL, D_MODEL), D_MODEL),
        'a_onorm_g': gain(ks[5], (N_A_LAYERS, HGRN_HEAD_DIM)),
        'lb_param': 0.1 * jax.random.normal(ks[6], (DEPTH, D_MODEL), f32),
        'kv_norm_g': gain(ks[7], (D_MODEL,)),
        'w_kv': nrm(ks[8], (D_MODEL, N_BRANCH * 2 * G * dh), D_MODEL),
        'k_norm_g': gain(ks[9], (N_BRANCH, dh)),
        'cmp_pos_k': 0.02 * jax.random.normal(ks[10], (CMP_BLOCK, dh), f32),
        'cmp_w1_k': nrm(ks[11], (CMP_BLOCK * dh, CMP_HIDDEN), CMP_BLOCK * dh),
        'cmp_w2_k': nrm(ks[12], (CMP_HIDDEN, dh), CMP_HIDDEN),
        'cmp_pos_v': 0.02 * jax.random.normal(ks[13], (CMP_BLOCK, dh), f32),
        'cmp_w1_v': nrm(ks[14], (CMP_BLOCK * dh, CMP_HIDDEN), CMP_BLOCK * dh),
        'cmp_w2_v': nrm(ks[15], (CMP_HIDDEN, dh), CMP_HIDDEN),
        'b_w_in': nrm(ks[16], (N_B_LAYERS, D_MODEL, H * dh + N_BRANCH * H), D_MODEL),
        'b_w_out': nrm(ks[17], (N_B_LAYERS, H * dh, D_MODEL), H * dh),
        'b_qnorm_g': gain(ks[18], (N_B_LAYERS, dh)),
        'rel_bias': 0.2 * jax.random.normal(ks[19], (REL_BUCKETS, H), f32),
        'ffn_w_gu': nrm(ks[20], (N_DENSE, D_MODEL, 2 * FFN_DIM), D_MODEL),
        'ffn_w_down': nrm(ks[21], (N_DENSE, FFN_DIM, D_MODEL), FFN_DIM),
        'moe_router': nrm(ks[22], (N_MOE, D_MODEL, N_EXPERTS), D_MODEL),
        'moe_w_gu': nrm(ks[23], (N_MOE, N_EXPERTS, D_MODEL, 2 * EXPERT_DIM), D_MODEL),
        'moe_w_down': nrm(ks[24], (N_MOE, N_EXPERTS, EXPERT_DIM, D_MODEL), EXPERT_DIM),
    }


def reference(x, norm_mix_g, norm_ffn_g, a_w_in, a_w_out, a_onorm_g, lb_param,
              kv_norm_g, w_kv, k_norm_g, cmp_pos_k, cmp_w1_k, cmp_w2_k,
              cmp_pos_v, cmp_w1_v, cmp_w2_v, b_w_in, b_w_out, b_qnorm_g, rel_bias,
              ffn_w_gu, ffn_w_down, moe_router, moe_w_gu, moe_w_down):
    lower_bounds = jnp.cumsum(jax.nn.softmax(lb_param.astype(jnp.float32), axis=0), axis=0)
    h = x
    shared = None
    for l in range(DEPTH):
        hn = rmsnorm(h, norm_mix_g[l])
        if l < N_A_LAYERS:
            mix = hgrn2_mixer(hn, a_w_in[l], a_w_out[l], a_onorm_g[l], lower_bounds[l])
        else:
            if l == N_A_LAYERS:
                shared = nsa_shared_kv(h, kv_norm_g, w_kv, k_norm_g, cmp_pos_k, cmp_w1_k, cmp_w2_k,
                                       cmp_pos_v, cmp_w1_v, cmp_w2_v)
            j = l - N_A_LAYERS
            mix = nsa_mixer(hn, b_w_in[j], b_w_out[j], b_qnorm_g[j], rel_bias, *shared)
        h = h + mix
        hn = rmsnorm(h, norm_ffn_g[l])
        if l % 2 == 0:
            h = h + swiglu(hn, ffn_w_gu[l // 2], ffn_w_down[l // 2])
        else:
            h = h + moe_swiglu(hn, moe_router[l // 2], moe_w_gu[l // 2], moe_w_down[l // 2])
    return h
```

```cpp
#include <hip/hip_runtime.h>
#include <cstdio>
#include <cstdint>

#ifndef MK_SINGLE
#define MK_SINGLE 0
#endif

namespace pg8 {
#define PG8_LAS __attribute__((address_space(3)))
typedef unsigned short bf16_t;
typedef short bf16x8 __attribute__((ext_vector_type(8)));
typedef float f32x4 __attribute__((ext_vector_type(4)));
typedef unsigned u32x4 __attribute__((ext_vector_type(4)));
typedef float f32x2 __attribute__((ext_vector_type(2)));
constexpr int BM = 256, BK = 64, HALF = 128, HTB = HALF * BK * 2  , STAGE_BYTES = 8 * HTB, NXCD = 8, WGM = 8;

__host__ __device__ __forceinline__ int lds_byte(int r, int c) { const int st = (r >> 4) * 2 + (c >> 5), rr = r & 15, cc = c & 31, ob = rr * 64 + cc * 2; return st * 1024 + (ob ^ (((ob >> 9) & 1) << 5)); }
__host__ __device__ __forceinline__ void stage_rc(int b, int& R, int& C) { const int st = b / 1024, sb = b % 1024, swz = sb ^ (((sb >> 9) & 1) << 5); R = (st >> 1) * 16 + swz / 64; C = (st & 1) * 32 + (swz % 64) / 2; }
__host__ __device__ __forceinline__ int perm32(int rho) { const int n = rho >> 4, i = rho & 15; return 8 * (i >> 2) + 4 * n + (i & 3); }

struct Unit { int pm, pn, pnl, e; };
struct Gemm { const bf16_t* A; const bf16_t* Bt; int K; const int* rowidx; };

struct StaticOrder {
    int nM, nN, nwg, G, c;
    __host__ __device__ void init(int M, int N, int G_, int c_) { nM = M / BM; nN = N / BM; nwg = nM * nN; G = G_; c = c_; }
    __host__ __device__ bool next(int i, Unit& u) const {
        const long L = (long)i * G + c; if (L >= nwg) return false;
        int wgid = (int)L; { const int q = nwg / NXCD, r = nwg % NXCD, xcd = wgid % NXCD, off = wgid / NXCD; wgid = (xcd < r ? xcd * (q + 1) : r * (q + 1) + (xcd - r) * q) + off; }
        const int nig = WGM * nN, gid = wgid / nig, fm = gid * WGM, gsz = (nM - fm) < WGM ? (nM - fm) : WGM;
        u.pm = fm + ((wgid % nig) % gsz); u.pn = (wgid % nig) / gsz; u.pnl = u.pn; u.e = 0; return true;
    }
};

__device__ __forceinline__ unsigned cvt_pk_bf16(float lo, float hi) { unsigned r; asm volatile("v_cvt_pk_bf16_f32 %0, %1, %2" : "=v"(r) : "v"(lo), "v"(hi)); return r; }

struct EpiBf16 {
    static constexpr bool PERM = true;
    bf16_t* O; int ldc;
    __device__ __forceinline__ void operator()(const f32x4 (&acc)[2][2][4][2], const Unit& u, int wr, int wc, int fr, int fq) const {
        const int row0 = u.pm * BM + wr * 64 + fr; const int col0 = u.pnl * BM + wc * 32 + 8 * fq;
#pragma unroll
        for (int ai = 0; ai < 2; ++ai)
#pragma unroll
            for (int m = 0; m < 4; ++m) { bf16_t* rowp = O + (size_t)(row0 + ai * HALF + m * 16) * ldc + col0;
#pragma unroll
                for (int bj = 0; bj < 2; ++bj) { const f32x4 v0 = acc[ai][bj][m][0], v1 = acc[ai][bj][m][1];
                    u32x4 w; w.x = cvt_pk_bf16(v0[0], v0[1]); w.y = cvt_pk_bf16(v0[2], v0[3]); w.z = cvt_pk_bf16(v1[0], v1[1]); w.w = cvt_pk_bf16(v1[2], v1[3]);
                    *(u32x4*)(rowp + bj * HALF) = w; } }
    }
};
__device__ __forceinline__ float silu_f(float x) { return x / (1.0f + __expf(-x)); }
struct EpiSwiglu {
    static constexpr bool PERM = true;
    bf16_t* O; int ldc;
    __device__ __forceinline__ void operator()(const f32x4 (&acc)[2][2][4][2], const Unit& u, int wr, int wc, int fr, int fq) const {
        const int row0 = u.pm * BM + wr * 64 + fr; const int col0 = u.pnl * HALF + wc * 32 + 8 * fq;
#pragma unroll
        for (int ai = 0; ai < 2; ++ai)
#pragma unroll
            for (int m = 0; m < 4; ++m) { bf16_t* rowp = O + (size_t)(row0 + ai * HALF + m * 16) * ldc + col0;
                const f32x4 g0 = acc[ai][0][m][0], g1 = acc[ai][0][m][1], u0 = acc[ai][1][m][0], u1 = acc[ai][1][m][1];
                u32x4 w; w.x = cvt_pk_bf16(silu_f(g0[0]) * u0[0], silu_f(g0[1]) * u0[1]); w.y = cvt_pk_bf16(silu_f(g0[2]) * u0[2], silu_f(g0[3]) * u0[3]);
                w.z = cvt_pk_bf16(silu_f(g1[0]) * u1[0], silu_f(g1[1]) * u1[1]); w.w = cvt_pk_bf16(silu_f(g1[2]) * u1[2], silu_f(g1[3]) * u1[3]);
                *(u32x4*)rowp = w; }
    }
};
struct EpiResF32 {
    static constexpr bool PERM = false;
    const float* res; float* out; int ldc;
    __device__ __forceinline__ void operator()(const f32x4 (&acc)[2][2][4][2], const Unit& u, int wr, int wc, int fr, int fq) const {
        const int col0 = u.pnl * BM + wc * 32 + 4 * fq;
#pragma unroll
        for (int ai = 0; ai < 2; ++ai)
#pragma unroll
            for (int m = 0; m < 4; ++m) { const size_t off = (size_t)(u.pm * BM + ai * HALF + wr * 64 + m * 16 + fr) * ldc + col0;
#pragma unroll
                for (int bj = 0; bj < 2; ++bj)
#pragma unroll
                    for (int n = 0; n < 2; ++n) { const f32x4 bs = *(const f32x4*)(res + off + bj * HALF + n * 16); *(f32x4*)(out + off + bj * HALF + n * 16) = bs + acc[ai][bj][m][n]; } }
    }
};
struct EpiMoeDown {
    static constexpr bool PERM = false;
    float* out; const int* slot_tok; const float* slot_w; int ldc;
    __device__ __forceinline__ void operator()(const f32x4 (&acc)[2][2][4][2], const Unit& u, int wr, int wc, int fr, int fq) const {
        const int col0 = u.pnl * BM + wc * 32 + 4 * fq;
#pragma unroll
        for (int ai = 0; ai < 2; ++ai)
#pragma unroll
            for (int m = 0; m < 4; ++m) { const int slot = u.pm * BM + ai * HALF + wr * 64 + m * 16 + fr; const int tok = slot_tok[slot]; const float w = slot_w[slot];
                if (tok >= 0) { float* rowp = out + (size_t)tok * ldc + col0;
#pragma unroll
                    for (int bj = 0; bj < 2; ++bj)
#pragma unroll
                        for (int n = 0; n < 2; ++n) { const f32x4 v = acc[ai][bj][m][n] * w; float* p = rowp + bj * HALF + n * 16;
                            __hip_atomic_fetch_add(p + 0, v[0], __ATOMIC_RELAXED, __HIP_MEMORY_SCOPE_AGENT); __hip_atomic_fetch_add(p + 1, v[1], __ATOMIC_RELAXED, __HIP_MEMORY_SCOPE_AGENT);
                            __hip_atomic_fetch_add(p + 2, v[2], __ATOMIC_RELAXED, __HIP_MEMORY_SCOPE_AGENT); __hip_atomic_fetch_add(p + 3, v[3], __ATOMIC_RELAXED, __HIP_MEMORY_SCOPE_AGENT); } } }
    }
};

template <class Epi, class Sched, bool ALIGN_EPI, bool GATHER>
__device__ __forceinline__ void gemm_phase(PG8_LAS unsigned char* lds, const Gemm g, const Sched& S, const Epi& E) {
    const int tid = threadIdx.x, wid = __builtin_amdgcn_readfirstlane(tid >> 6), lane = tid & 63, wr = wid >> 2, wc = wid & 3, fr = lane & 15, fq = lane >> 4;
    const int K = g.K, nt = K / BK;
    unsigned voffB[2]; int RA[2], CA[2];
#pragma unroll
    for (int i = 0; i < 2; ++i) { int R, C; stage_rc(tid * 16 + i * 8192, R, C); const int Rb = Epi::PERM ? ((R & ~31) + perm32(R & 31)) : R;
        RA[i] = R; CA[i] = C; voffB[i] = (unsigned)(Rb * K + C) * 2u; }
    unsigned vA[2][2], vAn[2][2];
    const size_t kstep = (size_t)(BK * 2);
    const size_t hstep = (size_t)HALF * K * 2;
    const size_t tstep = 2 * hstep;
    const unsigned ldsw = (unsigned)wid * 1024u;
    const int aoff = lds_byte(wr * 64 + fr, fq * 8), boff = lds_byte(wc * 32 + fr, fq * 8);
#define PG8_SA(b, h) (((b) * 2 + (h)) * HTB)
#define PG8_SB(b, h) ((4 + (b) * 2 + (h)) * HTB)
#define PG8_STAGE(bufoff, gbase, voff) do { _Pragma("unroll") for (int _i = 0; _i < 2; ++_i) \
        __builtin_amdgcn_global_load_lds((const unsigned*)((const char*)(gbase) + (voff)[_i]), (PG8_LAS unsigned*)(lds + (bufoff) + ldsw + _i * 8192), 16, 0, 0); } while (0)
#define PG8_LDA(dst, b, h) do { _Pragma("unroll") for (int m = 0; m < 4; ++m) _Pragma("unroll") for (int k = 0; k < 2; ++k) dst[m][k] = *(const PG8_LAS bf16x8*)(lds + PG8_SA(b, h) + aoff + m * 2048 + k * 1024); } while (0)
#define PG8_LDB(dst, b, h) do { _Pragma("unroll") for (int n = 0; n < 2; ++n) _Pragma("unroll") for (int k = 0; k < 2; ++k) dst[n][k] = *(const PG8_LAS bf16x8*)(lds + PG8_SB(b, h) + boff + n * 2048 + k * 1024); } while (0)
#define PG8_MMA(ai, bj, At, Bt) do { __builtin_amdgcn_s_setprio(1); _Pragma("unroll") for (int m = 0; m < 4; ++m) _Pragma("unroll") for (int n = 0; n < 2; ++n) _Pragma("unroll") for (int k = 0; k < 2; ++k) \
        acc[ai][bj][m][n] = __builtin_amdgcn_mfma_f32_16x16x32_bf16(Bt[n][k], At[m][k], acc[ai][bj][m][n], 0, 0, 0); __builtin_amdgcn_s_setprio(0); } while (0)
#define PG8_WAIT_V(n) asm volatile("s_waitcnt vmcnt(" #n ")" ::: "memory")
#define PG8_WAIT_L(n) asm volatile("s_waitcnt lgkmcnt(" #n ")" ::: "memory")
#define PG8_BAR __builtin_amdgcn_s_barrier()
#define PG8_SCHED __builtin_amdgcn_sched_barrier(0)
#define PG8_VOFF(dst, u) do { _Pragma("unroll") for (int _h = 0; _h < 2; ++_h) _Pragma("unroll") for (int _i = 0; _i < 2; ++_i) { \
        if constexpr (GATHER) { int _t = g.rowidx[(u).pm * BM + _h * HALF + RA[_i]]; _t = _t < 0 ? 0 : _t; dst[_h][_i] = (unsigned)(_t * K + CA[_i]) * 2u; } \
        else dst[_h][_i] = (unsigned)((_h * HALF + RA[_i]) * K + CA[_i]) * 2u; } } while (0)
    Unit cur, nxt; int ui = 0;
    if (!S.next(0, cur)) return;
    f32x4 acc[2][2][4][2];
#pragma unroll
    for (int a = 0; a < 2; ++a)
#pragma unroll
        for (int b = 0; b < 2; ++b)
#pragma unroll
            for (int m = 0; m < 4; ++m)
#pragma unroll
                for (int n = 0; n < 2; ++n) acc[a][b][m][n] = (f32x4){0.f, 0.f, 0.f, 0.f};
    bf16x8 At[4][2], B0[2][2], B1[2][2];
    const char* cA = (const char*)g.A + (GATHER ? (size_t)0 : (size_t)cur.pm * tstep); const char* cB = (const char*)g.Bt + (size_t)cur.pn * tstep;
    PG8_VOFF(vA, cur);
    PG8_STAGE(PG8_SB(0, 0), cB, voffB); PG8_STAGE(PG8_SB(0, 1), cB + hstep, voffB); PG8_STAGE(PG8_SA(0, 0), cA, vA[0]); PG8_STAGE(PG8_SA(0, 1), cA, vA[1]);
    if (wr == 1) PG8_BAR;
    PG8_WAIT_V(2); PG8_BAR;
    PG8_STAGE(PG8_SB(1, 0), cB + kstep, voffB); PG8_STAGE(PG8_SA(1, 0), cA + kstep, vA[0]); PG8_STAGE(PG8_SB(1, 1), cB + hstep + kstep, voffB);
    PG8_WAIT_V(6); PG8_BAR;
    for (;;) {
        const bool has_next = S.next(ui + 1, nxt);
        const char* nA = has_next ? (const char*)g.A + (GATHER ? (size_t)0 : (size_t)nxt.pm * tstep) : cA; const char* nB = has_next ? (const char*)g.Bt + (size_t)nxt.pn * tstep : cB;
        if (has_next) { PG8_VOFF(vAn, nxt); } else {
#pragma unroll
            for (int _h = 0; _h < 2; ++_h)
#pragma unroll
                for (int _i = 0; _i < 2; ++_i) vAn[_h][_i] = vA[_h][_i]; }
        for (int t = 0; t < nt; t += 2) {
            const bool last = (t == nt - 2);
            const char* a1 = cA + (size_t)(t + 1) * kstep;
            const char* a2 = last ? nA : cA + (size_t)(t + 2) * kstep; const char* b2 = last ? nB : cB + (size_t)(t + 2) * kstep;
            const char* a3 = a2 + kstep; const char* b3 = b2 + kstep;
            unsigned v2[2][2];
#pragma unroll
            for (int _h = 0; _h < 2; ++_h)
#pragma unroll
                for (int _i = 0; _i < 2; ++_i) v2[_h][_i] = last ? vAn[_h][_i] : vA[_h][_i];
            PG8_LDB(B0, 0, 0); PG8_LDB(B1, 0, 1); PG8_SCHED; PG8_LDA(At, 0, 0); PG8_STAGE(PG8_SA(1, 1), a1, vA[1]);
            PG8_WAIT_V(8); PG8_WAIT_L(0); PG8_BAR; PG8_MMA(0, 0, At, B0); PG8_MMA(0, 1, At, B1); PG8_BAR; PG8_SCHED;
            PG8_LDA(At, 0, 1); PG8_STAGE(PG8_SB(0, 0), b2, voffB); PG8_STAGE(PG8_SB(0, 1), b2 + hstep, voffB); PG8_STAGE(PG8_SA(0, 0), a2, v2[0]);
            PG8_WAIT_V(8); PG8_WAIT_L(0); PG8_BAR; PG8_MMA(1, 0, At, B0); PG8_MMA(1, 1, At, B1); PG8_BAR; PG8_SCHED;
            PG8_LDB(B0, 1, 0); PG8_LDB(B1, 1, 1); PG8_SCHED; PG8_LDA(At, 1, 0); PG8_STAGE(PG8_SA(0, 1), a2, v2[1]);
            PG8_WAIT_V(8); PG8_WAIT_L(0); PG8_BAR; PG8_MMA(0, 0, At, B0); PG8_MMA(0, 1, At, B1); PG8_BAR; PG8_SCHED;
            PG8_LDA(At, 1, 1); PG8_STAGE(PG8_SB(1, 0), b3, voffB); PG8_STAGE(PG8_SB(1, 1), b3 + hstep, voffB); PG8_STAGE(PG8_SA(1, 0), a3, v2[0]);
            PG8_WAIT_V(8); PG8_WAIT_L(0); PG8_BAR; PG8_MMA(1, 0, At, B0); PG8_MMA(1, 1, At, B1); PG8_BAR; PG8_SCHED;
        }
        if constexpr (ALIGN_EPI) { if (wr == 0) PG8_BAR; }
        E(acc, cur, wr, wc, fr, fq);
        if (!has_next) break;
#pragma unroll
        for (int a = 0; a < 2; ++a)
#pragma unroll
            for (int b = 0; b < 2; ++b)
#pragma unroll
                for (int m = 0; m < 4; ++m)
#pragma unroll
                    for (int n = 0; n < 2; ++n) acc[a][b][m][n] = (f32x4){0.f, 0.f, 0.f, 0.f};
        cur = nxt; cA = nA; cB = nB; ++ui;
#pragma unroll
        for (int _h = 0; _h < 2; ++_h)
#pragma unroll
            for (int _i = 0; _i < 2; ++_i) vA[_h][_i] = vAn[_h][_i];
        if constexpr (ALIGN_EPI) { if (wr == 1) PG8_BAR; }
    }
    PG8_WAIT_V(0);
    if constexpr (!ALIGN_EPI) { if (wr == 0) PG8_BAR; }
    PG8_BAR;
#undef PG8_SA
#undef PG8_SB
#undef PG8_STAGE
#undef PG8_LDA
#undef PG8_LDB
#undef PG8_MMA
#undef PG8_WAIT_V
#undef PG8_WAIT_L
#undef PG8_BAR
#undef PG8_SCHED
#undef PG8_VOFF
}
}

constexpr int NWAVES = 8;
constexpr int BATCH = 2, T = 8192, D = 1024, M = BATCH * T;
constexpr int HG_H = 8, HG_DH = 128;
constexpr int NH = 16, NG = 4, HPG = 4, DH = 64;
constexpr int NCMP = 511, NCMPP = 512, NSEL = 128, NTOP = 16, WIN = 512;
constexpr int FF = 2816, NE = 8, EF = 3584;
constexpr int NIN0 = 4 * D;
constexpr int NKV = 1536, NQIN = 1072, NQINP = 1280;
constexpr int NSLOT = 2 * M + NE * 256;
constexpr float NORM_EPS = 1e-6f;

constexpr size_t MiB = 1u << 20;
constexpr size_t WS_CTL = 0, CTL_ZERO_BYTES = 1 * MiB;
constexpr size_t WS_LB = 1 * MiB;
constexpr size_t WS_KCMP = 2 * MiB, WS_VCMP = 3 * MiB;
constexpr size_t WS_SLOT_TOK = 4 * MiB;
constexpr size_t WS_SLOT_W = 5 * MiB;
constexpr size_t WS_ROUTE = 6 * MiB;
constexpr size_t WS_SEL = 7 * MiB;
constexpr size_t WS_W_IN0 = 16 * MiB;
constexpr size_t WS_W_OUT0 = 24 * MiB;
constexpr size_t WS_W_GU0 = 26 * MiB;
constexpr size_t WS_W_DN0 = 37 * MiB;
constexpr size_t WS_W_KV = 43 * MiB;
constexpr size_t WS_W_QIN = 46 * MiB;
constexpr size_t WS_W_OUT1 = 49 * MiB;
constexpr size_t WS_W_GU1 = 51 * MiB;
constexpr size_t WS_W_DN1 = 163 * MiB;
constexpr size_t WS_XN = 224 * MiB;
constexpr size_t WS_XN2 = 256 * MiB;
constexpr size_t WS_H2 = 288 * MiB;
constexpr size_t WS_KV = 352 * MiB;
constexpr size_t WS_QG = 400 * MiB;
constexpr size_t WS_OATT = 440 * MiB;
constexpr size_t WS_R = 480 * MiB;
constexpr size_t WS_QFIG = WS_R;
constexpr size_t WS_O0 = WS_R + 128 * MiB;
constexpr size_t WS_OG = WS_R + 192 * MiB;
constexpr size_t WS_H1 = WS_R + 224 * MiB;
constexpr size_t WS_ACT = WS_R + 288 * MiB;
constexpr size_t WS_ACT2 = WS_R;
constexpr size_t WS_IMP = WS_R + 240 * MiB;
constexpr size_t WS_OACC = WS_R + 272 * MiB;
constexpr size_t WS_END = WS_R + 376 * MiB;
static_assert(WS_ACT2 + (size_t)NSLOT * EF * 2 <= WS_IMP && WS_ACT + (size_t)M * FF * 2 <= WS_END, "d_ws map");
constexpr int CW_TMO = 0;
constexpr int CW_ECNT = 64;
constexpr int CW_BAR = 4096;

constexpr int RING_OFF = 0, RING_BYTES = 131072;
constexpr int LDSCTL_OFF = RING_BYTES, MISC_OFF = LDSCTL_OFF + 320;
constexpr int LDS_BYTES = 147456;
static_assert(MISC_OFF + 128 <= LDS_BYTES, "LDS map");

#define GAS __attribute__((address_space(1)))
#define LAS __attribute__((address_space(3)))
typedef unsigned short bf16;
typedef unsigned v4u __attribute__((ext_vector_type(4)));
typedef float f32x4 __attribute__((ext_vector_type(4)));
typedef short bf16x8 __attribute__((ext_vector_type(8)));
typedef GAS unsigned gu32;
#define RLX_AGENT __ATOMIC_RELAXED, __HIP_MEMORY_SCOPE_AGENT
#define LDS_WAIT() asm volatile("s_waitcnt lgkmcnt(0)" ::: "memory")
#define VM_WAIT() asm volatile("s_waitcnt vmcnt(0)" ::: "memory")
__device__ __forceinline__ unsigned f2bf(float f) { unsigned u = __builtin_bit_cast(unsigned, f); return (u + 0x7fffu + ((u >> 16) & 1u)) >> 16; }
__device__ __forceinline__ unsigned pk2(float lo, float hi) { return f2bf(lo) | (f2bf(hi) << 16); }
__device__ __forceinline__ float bf2f(unsigned short b) { return __builtin_bit_cast(float, (unsigned)b << 16); }
__device__ __forceinline__ float bflo(unsigned w) { return __builtin_bit_cast(float, w << 16); }
__device__ __forceinline__ float bfhi(unsigned w) { return __builtin_bit_cast(float, w & 0xffff0000u); }
__device__ __forceinline__ float sigmoid_f(float x) { return 1.0f / (1.0f + __expf(-x)); }
#define XB_TMO      128
#define XB_XCNT(j)  (256  + 64 * (j))
#define XB_XSUB(j)  (1280 + 64 * (j))
#define XB_XGEN(j)  (2304 + 64 * (j))
#define XB_TOP      3328
#define XB_TOPGEN   3392
#define XCD_BAR_WORDS 3456
#define XB_SPIN_CAP (1u << 18)

__device__ __forceinline__ unsigned xb_ld(unsigned* p)              { return __hip_atomic_load(p, __ATOMIC_RELAXED, __HIP_MEMORY_SCOPE_AGENT); }
__device__ __forceinline__ unsigned xb_add(unsigned* p, unsigned v) { return __hip_atomic_fetch_add(p, v, __ATOMIC_RELAXED, __HIP_MEMORY_SCOPE_AGENT); }
__device__ __forceinline__ unsigned xb_xcc_id() { return (unsigned)__builtin_amdgcn_s_getreg((3 << 11) | 20) & 0xFu; }
#define XB_SPIN(cond, bar) do { unsigned _sp = 0; while (cond) { __builtin_amdgcn_s_sleep(1); \
    if ((++_sp & 255u) == 0u) { if (xb_ld(&(bar)[XB_TMO])) break; if (_sp > XB_SPIN_CAP) { atomicAdd(&(bar)[XB_TMO], 1u); break; } } } } while (0)

struct XcdBarrier {
    unsigned* bar; unsigned x;
    volatile LAS unsigned* st;
};

__device__ __forceinline__ XcdBarrier xcd_barrier_post(unsigned* bar, volatile LAS unsigned* st) {
    XcdBarrier b; b.bar = bar; b.x = xb_xcc_id(); b.st = st;
    if (threadIdx.x == 0) (void)xb_add(&bar[XB_XCNT(b.x)], 1u);
    return b;
}
__device__ __forceinline__ void xcd_barrier_complete(unsigned* bar, unsigned x, unsigned& nloc, unsigned& nx) {
    const unsigned G = gridDim.x * gridDim.y * gridDim.z;
    unsigned sum, cnt, mine, sp = 0u;
    for (;;) {
        sum = 0u; cnt = 0u; mine = 0u;
#pragma unroll
        for (unsigned j = 0; j < 16; ++j) { const unsigned c = xb_ld(&bar[XB_XCNT(j)]); sum += c; cnt += (c > 0u) ? 1u : 0u; mine = (j == x) ? c : mine; }
        if (sum == G) break;
        __builtin_amdgcn_s_sleep(1);
        if ((++sp & 255u) == 0u) { if (xb_ld(&bar[XB_TMO])) break; if (sp > XB_SPIN_CAP) { atomicAdd(&bar[XB_TMO], 1u); break; } }
    }
    nloc = mine > 0u ? mine : 1u; nx = cnt > 0u ? cnt : 1u;
}

__device__ __forceinline__ void xcd_barrier(const XcdBarrier& b) {
    asm volatile("s_waitcnt vmcnt(0)" ::: "memory");
    __syncthreads();
    if (threadIdx.x == 0) {
        unsigned* bar = b.bar;
        __builtin_amdgcn_s_waitcnt(0);
        unsigned nloc = b.st[0], nx = b.st[1];
        if (nloc == 0u) { xcd_barrier_complete(bar, b.x, nloc, nx); b.st[0] = nloc; b.st[1] = nx; }
        const unsigned old = xb_add(&bar[XB_XSUB(b.x)], 1u);
        const unsigned gen = old / nloc;
        if (old + 1u == (gen + 1u) * nloc) {
            __builtin_amdgcn_fence(__ATOMIC_RELEASE, "agent");
            asm volatile("s_waitcnt vmcnt(0)" ::: "memory");
            const unsigned og = xb_add(&bar[XB_TOP], 1u);
            const unsigned tg = og / nx;
            if (og + 1u == (tg + 1u) * nx) xb_add(&bar[XB_TOPGEN], 1u);
            else XB_SPIN(xb_ld(&bar[XB_TOPGEN]) == tg, bar);
            __builtin_amdgcn_fence(__ATOMIC_ACQUIRE, "agent");
            xb_add(&bar[XB_XGEN(b.x)], 1u);
            asm volatile("s_waitcnt vmcnt(0)" ::: "memory");
        } else {
            XB_SPIN(xb_ld(&bar[XB_XGEN(b.x)]) == gen, bar);
            __builtin_amdgcn_fence(__ATOMIC_ACQUIRE, "agent");
            asm volatile("s_waitcnt vmcnt(0)" ::: "memory");
        }
    }
    __syncthreads();
}

enum InIdx { I_X = 0, I_NORM_MIX = 1, I_NORM_FFN = 2, I_A_W_IN = 3, I_A_W_OUT = 4, I_A_ONORM = 5, I_LB = 6, I_KV_NORM = 7, I_W_KV = 8, I_K_NORM = 9,
             I_CPOS_K = 10, I_CW1_K = 11, I_CW2_K = 12, I_CPOS_V = 13, I_CW1_V = 14, I_CW2_V = 15, I_B_W_IN = 16, I_B_W_OUT = 17, I_B_QNORM = 18, I_REL_BIAS = 19,
             I_FFN_GU = 20, I_FFN_DN = 21, I_MOE_ROUTER = 22, I_MOE_GU = 23, I_MOE_DN = 24, N_IN = 25 };
struct Args { const float* in[N_IN]; float* out; unsigned char* ws; int ph_lo, ph_hi; };
struct Frame {
    LAS unsigned char* lds;
    volatile LAS unsigned* MISC;
    gu32* ctl;
    int tid, lane, wave;
    int vcu, G;
    unsigned char* ws; float* out;
};
__device__ __forceinline__ float wave_sum(float v) {
#pragma unroll
    for (int o = 1; o < 64; o <<= 1) v += __shfl_xor(v, o);
    return v;
}
__device__ __forceinline__ int rel_bucket(int d) {
    d = d < 0 ? 0 : d;
    if (d < 16) return d;
    const float v = logf((float)d / 16.0f) / 4.852030263919617f * 16.0f;
    int lg = 16 + (int)v; return lg < 31 ? lg : 31;
}
__device__ __forceinline__ float gelu_tanh(float x) { const float u = 0.7978845608028654f * (x + 0.044715f * x * x * x); return 0.5f * x * (1.0f + tanhf(u)); }

__device__ __forceinline__ void p0_transpose_item(const float* W, int ldw, int ncols, int K, bf16* WT, int dst_row0, LAS float* scr, int k0, int n0, int lane) {
    const int nn = n0 + (lane & 31); const bool ok = nn < ncols;
#pragma unroll 8
    for (int i = 0; i < 32; ++i) { const int kk = 2 * i + (lane >> 5); scr[kk * 33 + (lane & 31)] = ok ? W[(size_t)(k0 + kk) * ldw + nn] : 0.f; }
    LDS_WAIT(); asm volatile("" ::: "memory");
    const int c = lane & 7;
#pragma unroll
    for (int j = 0; j < 4; ++j) { const int n = (lane >> 3) + 8 * j; const LAS float* s = scr + (8 * c) * 33 + n;
        v4u o; o.x = pk2(s[0 * 33], s[1 * 33]); o.y = pk2(s[2 * 33], s[3 * 33]); o.z = pk2(s[4 * 33], s[5 * 33]); o.w = pk2(s[6 * 33], s[7 * 33]);
        *(GAS v4u*)(WT + (size_t)(dst_row0 + n) * K + k0 + 8 * c) = o; }
    LDS_WAIT(); asm volatile("" ::: "memory");
}
template <int GU> __device__ __forceinline__ void p0_item(const float* W, int ldw, int ncols, int npad, int K, bf16* WT, LAS float* scr, int r, int lane) {
    const int nblk = npad / 32, kb = r / nblk, nb = r % nblk, n0 = 32 * nb;
    int dst = n0;
    if (GU) { if (n0 < GU) dst = 256 * (n0 / 128) + (n0 % 128); else { const int n1 = n0 - GU; dst = 256 * (n1 / 128) + 128 + (n1 % 128); } }
    p0_transpose_item(W, ldw, ncols, K, WT, dst, scr, 64 * kb, n0, lane);
}
__device__ __forceinline__ void rms_row_to_bf16(const float* xrow, const float* gain, bf16* orow, int lane) {
    const GAS f32x4* xr = (const GAS f32x4*)xrow + lane; const GAS f32x4* gr = (const GAS f32x4*)gain + lane;
    f32x4 v[4]; float s = 0.f;
#pragma unroll
    for (int j = 0; j < 4; ++j) { v[j] = xr[64 * j]; s += (v[j].x * v[j].x + v[j].y * v[j].y) + (v[j].z * v[j].z + v[j].w * v[j].w); }
    const float rstd = 1.0f / sqrtf(wave_sum(s) * (1.f / D) + NORM_EPS);
    GAS unsigned long long* o8 = (GAS unsigned long long*)orow + lane;
#pragma unroll
    for (int j = 0; j < 4; ++j) { const f32x4 gg = gr[64 * j]; o8[64 * j] = (unsigned long long)pk2(v[j].x * rstd * gg.x, v[j].y * rstd * gg.y) | ((unsigned long long)pk2(v[j].z * rstd * gg.z, v[j].w * rstd * gg.w) << 32); }
}
__device__ __forceinline__ void p0_prologue(Frame& F, const Args& a) {
    LAS float* scr = (LAS float*)(F.lds + RING_OFF + F.wave * 16384);
    const int gw = F.vcu * NWAVES + F.wave, NGW = F.G * NWAVES;
    unsigned char* ws = F.ws;
    constexpr int I1 = 16 * 128, I2 = 16 * 32, I3 = 16 * 176, I4 = 44 * 32, I5 = 16 * 48, I6 = 16 * 40, I7 = 16 * 32, I8 = 16 * 224, I9 = 56 * 32;
    constexpr int NITEMS = I1 + I2 + I3 + I4 + I5 + I6 + I7 + NE * I8 + NE * I9;
    for (int it = gw; it < NITEMS; it += NGW) {
        int r = it;
        if (r < I1) { p0_item<0>(a.in[I_A_W_IN], NIN0, NIN0, NIN0, D, (bf16*)(ws + WS_W_IN0), scr, r, F.lane); continue; } r -= I1;
        if (r < I2) { p0_item<0>(a.in[I_A_W_OUT], D, D, D, D, (bf16*)(ws + WS_W_OUT0), scr, r, F.lane); continue; } r -= I2;
        if (r < I3) { p0_item<FF>(a.in[I_FFN_GU], 2 * FF, 2 * FF, 2 * FF, D, (bf16*)(ws + WS_W_GU0), scr, r, F.lane); continue; } r -= I3;
        if (r < I4) { p0_item<0>(a.in[I_FFN_DN], D, D, D, FF, (bf16*)(ws + WS_W_DN0), scr, r, F.lane); continue; } r -= I4;
        if (r < I5) { p0_item<0>(a.in[I_W_KV], NKV, NKV, NKV, D, (bf16*)(ws + WS_W_KV), scr, r, F.lane); continue; } r -= I5;
        if (r < I6) { p0_item<0>(a.in[I_B_W_IN], NQIN, NQIN, NQINP, D, (bf16*)(ws + WS_W_QIN), scr, r, F.lane); continue; } r -= I6;
        if (r < I7) { p0_item<0>(a.in[I_B_W_OUT], D, D, D, D, (bf16*)(ws + WS_W_OUT1), scr, r, F.lane); continue; } r -= I7;
        if (r < NE * I8) { const int e = r / I8; p0_item<EF>(a.in[I_MOE_GU] + (size_t)e * D * 2 * EF, 2 * EF, 2 * EF, 2 * EF, D, (bf16*)(ws + WS_W_GU1) + (size_t)e * 2 * EF * D, scr, r % I8, F.lane); continue; } r -= NE * I8;
        { const int e = r / I9; p0_item<0>(a.in[I_MOE_DN] + (size_t)e * EF * D, D, D, D, EF, (bf16*)(ws + WS_W_DN1) + (size_t)e * D * EF, scr, r % I9, F.lane); }
    }
    if (blockIdx.x == 0) {
        const float* lbp = a.in[I_LB]; float* lbv = (float*)(ws + WS_LB);
        for (int c = F.tid; c < D; c += NWAVES * 64) { const float p0 = lbp[c], p1 = lbp[D + c], mx = fmaxf(p0, p1), e0 = __expf(p0 - mx), e1 = __expf(p1 - mx); lbv[c] = e0 / (e0 + e1); }
    }
    const float* x = a.in[I_X]; const float* gmix = a.in[I_NORM_MIX]; bf16* XN = (bf16*)(ws + WS_XN);
    for (int m = gw; m < M; m += NGW) rms_row_to_bf16(x + (size_t)m * D, gmix, XN + (size_t)m * D, F.lane);
}
__device__ __forceinline__ void p_rmsnorm(Frame& F, const float* src, const float* g1, bf16* d1, const float* g2, bf16* d2) {
    const int gw = F.vcu * NWAVES + F.wave, NGW = F.G * NWAVES;
    for (int m = gw; m < M; m += NGW) { rms_row_to_bf16(src + (size_t)m * D, g1, d1 + (size_t)m * D, F.lane); if (g2) rms_row_to_bf16(src + (size_t)m * D, g2, d2 + (size_t)m * D, F.lane); }
}

__device__ __forceinline__ void p_hgrn_rec(Frame& F) {
    const bf16* QFIG = (const bf16*)(F.ws + WS_QFIG); float* O0 = (float*)(F.ws + WS_O0); const float* lbv = (const float*)(F.ws + WS_LB);
    const int gw = F.vcu * NWAVES + F.wave, NGW = F.G * NWAVES;
    for (int u = gw; u < BATCH * HG_H * HG_DH; u += NGW) {
        const int b = u >> 10, h = (u >> 7) & 7, e = u & 127;
        const int d0 = F.lane, d1 = F.lane + 64;
        const float lb0 = lbv[h * 128 + d0], lb1 = lbv[h * 128 + d1];
        float S0 = 0.f, S1 = 0.f;
        const bf16* base = QFIG + (size_t)b * T * NIN0 + h * 128;
        float* ob = O0 + (size_t)b * T * D + h * 128 + e;
        for (int t0 = 0; t0 < T; t0 += 8) {
            float q0[8], q1[8], f0[8], f1[8], vv[8];
#pragma unroll
            for (int j = 0; j < 8; ++j) { const bf16* r = base + (size_t)(t0 + j) * NIN0; q0[j] = bf2f(r[d0]); q1[j] = bf2f(r[d1]); f0[j] = bf2f(r[D + d0]); f1[j] = bf2f(r[D + d1]); vv[j] = bf2f(r[2 * D + e]); }
            float res = 0.f;
#pragma unroll
            for (int j = 0; j < 8; ++j) {
                const float g0 = lb0 + (1.f - lb0) * sigmoid_f(f0[j]), g1 = lb1 + (1.f - lb1) * sigmoid_f(f1[j]);
                S0 = g0 * S0 + (1.f - g0) * vv[j]; S1 = g1 * S1 + (1.f - g1) * vv[j];
                const float p = wave_sum(q0[j] * S0 + q1[j] * S1);
                if (F.lane == j) res = p;
            }
            if (F.lane < 8) ob[(size_t)(t0 + F.lane) * D] = res;
        }
    }
}
__device__ __forceinline__ void p_onorm(Frame& F, const float* gon) {
    const bf16* QFIG = (const bf16*)(F.ws + WS_QFIG); const float* O0 = (const float*)(F.ws + WS_O0); bf16* OG = (bf16*)(F.ws + WS_OG);
    const int gw = F.vcu * NWAVES + F.wave, NGW = F.G * NWAVES;
    for (int m = gw; m < M; m += NGW) {
        const GAS f32x4* xr = (const GAS f32x4*)(O0 + (size_t)m * D) + F.lane;
        const GAS unsigned long long* gr = (const GAS unsigned long long*)(QFIG + (size_t)m * NIN0 + 3 * D) + F.lane;
        GAS unsigned long long* o8 = (GAS unsigned long long*)(OG + (size_t)m * D) + F.lane;
#pragma unroll
        for (int j = 0; j < 4; ++j) {
            const f32x4 v = xr[64 * j]; float s = (v.x * v.x + v.y * v.y) + (v.z * v.z + v.w * v.w);
            s += __shfl_xor(s, 1); s += __shfl_xor(s, 2); s += __shfl_xor(s, 4); s += __shfl_xor(s, 8); s += __shfl_xor(s, 16);
            const float rstd = 1.0f / sqrtf(s * (1.f / 128.f) + NORM_EPS);
            const f32x4 gg = *((const GAS f32x4*)gon + ((64 * j + F.lane) & 31));
            const unsigned long long gw8 = gr[64 * j]; const unsigned glo = (unsigned)gw8, ghi = (unsigned)(gw8 >> 32);
            const float a0 = bflo(glo), a1 = bfhi(glo), a2 = bflo(ghi), a3 = bfhi(ghi);
            const float y0 = v.x * rstd * gg.x * (a0 * sigmoid_f(a0)), y1 = v.y * rstd * gg.y * (a1 * sigmoid_f(a1)), y2 = v.z * rstd * gg.z * (a2 * sigmoid_f(a2)), y3 = v.w * rstd * gg.w * (a3 * sigmoid_f(a3));
            o8[64 * j] = (unsigned long long)pk2(y0, y1) | ((unsigned long long)pk2(y2, y3) << 32);
        }
    }
}

__device__ __forceinline__ void p_knorm(Frame& F, const float* kng) {
    bf16* KV = (bf16*)(F.ws + WS_KV);
    const int gt = F.vcu * (NWAVES * 64) + F.tid, NT = F.G * NWAVES * 64;
    for (int idx = gt; idx < M * 8; idx += NT) {
        const int m = idx >> 3, j = idx & 7; const int col0 = j < 4 ? 512 + 64 * j : 1024 + 64 * (j - 4); const float* gain = kng + (j < 4 ? 64 : 128);
        GAS v4u* p = (GAS v4u*)(KV + (size_t)m * NKV + col0);
        v4u w[8]; float ss = 0.f;
#pragma unroll
        for (int i = 0; i < 8; ++i) { w[i] = p[i];
#pragma unroll
            for (int k = 0; k < 4; ++k) { const float a = bflo(w[i][k]), b = bfhi(w[i][k]); ss += a * a + b * b; } }
        const float rstd = 1.0f / sqrtf(ss * (1.f / 64.f) + NORM_EPS);
#pragma unroll
        for (int i = 0; i < 8; ++i) { v4u o;
#pragma unroll
            for (int k = 0; k < 4; ++k) o[k] = pk2(bflo(w[i][k]) * rstd * gain[8 * i + 2 * k], bfhi(w[i][k]) * rstd * gain[8 * i + 2 * k + 1]);
            p[i] = o; }
    }
}
__device__ __forceinline__ void p_compress(Frame& F, const Args& a) {
    const bf16* KV = (const bf16*)(F.ws + WS_KV);
    LAS float* tile = (LAS float*)(F.lds);
    LAS float* part = tile + 144 * 64;
    LAS float* hid = part + 2 * 8 * 256;
    LAS float* posl = hid + 8 * 256;
    const int tid = F.tid;
    for (int unit = F.vcu; unit < 1024; unit += F.G) {
        const int kvsel = unit >> 9, bg = (unit >> 6) & 7, grp = unit & 63, b = bg >> 2, g = bg & 3, n0 = grp * 8;
        const float* w1 = a.in[kvsel ? I_CW1_V : I_CW1_K]; const float* w2 = a.in[kvsel ? I_CW2_V : I_CW2_K]; const float* pos = a.in[kvsel ? I_CPOS_V : I_CPOS_K];
        const int col0 = kvsel * 256 + g * 64;
        for (int i = tid; i < 144 * 64; i += NWAVES * 64) { const int rr = i >> 6, d = i & 63; int tok = 16 * n0 + rr; tok = tok < T ? tok : T - 1; tile[i] = bf2f(KV[(size_t)(b * T + tok) * NKV + col0 + d]); }
        for (int i = tid; i < 2048; i += NWAVES * 64) posl[i] = pos[i];
        __syncthreads();
        const int hidx = tid & 255, half = tid >> 8;
        float acc[8];
#pragma unroll
        for (int r = 0; r < 8; ++r) acc[r] = 0.f;
        for (int jj = 0; jj < 16; ++jj) { const int j = half * 16 + jj;
#pragma unroll 4
            for (int d = 0; d < 64; ++d) { const float w = w1[(size_t)(j * 64 + d) * 256 + hidx]; const float pj = posl[j * 64 + d];
#pragma unroll
                for (int r = 0; r < 8; ++r) acc[r] += (tile[(16 * r + j) * 64 + d] + pj) * w; } }
#pragma unroll
        for (int r = 0; r < 8; ++r) part[(half * 8 + r) * 256 + hidx] = acc[r];
        __syncthreads();
        for (int i = tid; i < 2048; i += NWAVES * 64) hid[i] = gelu_tanh(part[i] + part[2048 + i]);
        __syncthreads();
        { const int r = F.wave, o = F.lane; float y = 0.f;
            for (int hh = 0; hh < 256; ++hh) y += hid[r * 256 + hh] * w2[hh * 64 + o];
            if (kvsel == 0) { const float ss = wave_sum(y * y); y = y * (1.0f / sqrtf(ss * (1.f / 64.f) + NORM_EPS)) * a.in[I_K_NORM][o]; }
            const int n = n0 + r; float* dst = (float*)(F.ws + (kvsel ? WS_VCMP : WS_KCMP)) + ((size_t)(bg * NCMPP + n) * 64 + o); *dst = (n < NCMP) ? y : 0.f; }
        __syncthreads();
    }
}
__device__ __forceinline__ void load_q(const bf16* QG, const float* gq, size_t m, int h, float (&q)[64]) {
    const GAS v4u* p = (const GAS v4u*)(QG + m * NQINP + h * 64); float ss = 0.f;
#pragma unroll
    for (int i = 0; i < 8; ++i) { const v4u w = p[i];
#pragma unroll
        for (int k = 0; k < 4; ++k) { const float x0 = bflo(w[k]), x1 = bfhi(w[k]); q[8 * i + 2 * k] = x0; q[8 * i + 2 * k + 1] = x1; ss += x0 * x0 + x1 * x1; } }
    const float rs = 0.125f / sqrtf(ss * (1.f / 64.f) + NORM_EPS);
#pragma unroll
    for (int d = 0; d < 64; ++d) q[d] = q[d] * rs * gq[d];
}
__device__ __forceinline__ void p_cmp_attn(Frame& F, const Args& a) {
    const bf16* QG = (const bf16*)(F.ws + WS_QG); const float* KC = (const float*)(F.ws + WS_KCMP); const float* VC = (const float*)(F.ws + WS_VCMP);
    float* IMP = (float*)(F.ws + WS_IMP); float* OACC = (float*)(F.ws + WS_OACC); unsigned* SEL = (unsigned*)(F.ws + WS_SEL);
    const float* gq = a.in[I_B_QNORM]; const float* relb = a.in[I_REL_BIAS];
    const int gw = F.vcu * NWAVES + F.wave, NGW = F.G * NWAVES;
    for (int tile = gw; tile < BATCH * NG * (T / 64); tile += NGW) {
        const int bg = tile >> 7, tt = tile & 127, b = bg >> 2, g = bg & 3, t = tt * 64 + F.lane; const size_t m = (size_t)b * T + t;
        const int ncv = t >= 31 ? ((t - 31) >> 4) + 1 : 0;
        const int ncv_max = __builtin_amdgcn_readlane(ncv, 63);
        float* imp_col = IMP + (size_t)bg * NSEL * T + t;
        for (int hp = 0; hp < 4; ++hp) {
            const int h = g * 4 + hp; float q[64]; load_q(QG, gq, m, h, q);
            float l = 0.f;
            for (int c = 0; c < ncv_max; ++c) { const float* kr = KC + (size_t)(bg * NCMPP + c) * 64; float dot = 0.f;
#pragma unroll
                for (int d = 0; d < 64; ++d) dot += q[d] * kr[d];
                const int dist = t - (16 * c + 31); const float bias = relb[rel_bucket(dist) * NH + h];
                l += (c < ncv) ? __expf(dot + bias) : 0.f; }
            const float inv = l > 0.f ? 1.0f / l : 0.f;
            float o[64];
#pragma unroll
            for (int d = 0; d < 64; ++d) o[d] = 0.f;
            float carry = 0.f;
            for (int s = 0; s < NSEL; ++s) {
                float av = carry; carry = 0.f;
#pragma unroll
                for (int i = 0; i < 4; ++i) { const int c = 4 * s + i;
                    if (c < ncv_max) { const float* kr = KC + (size_t)(bg * NCMPP + c) * 64; float dot = 0.f;
#pragma unroll
                        for (int d = 0; d < 64; ++d) dot += q[d] * kr[d];
                        const int dist = t - (16 * c + 31); const float bias = relb[rel_bucket(dist) * NH + h];
                        const float p = (c < ncv) ? __expf(dot + bias) * inv : 0.f;
                        const float* vr = VC + (size_t)(bg * NCMPP + c) * 64;
#pragma unroll
                        for (int d = 0; d < 64; ++d) o[d] += p * vr[d];
                        if (i < 3) av += p; else { av += 0.5f * p; carry = 0.5f * p; } } }
                if (hp == 0) imp_col[(size_t)s * T] = av; else imp_col[(size_t)s * T] += av;
            }
            const float gate = sigmoid_f(bf2f(QG[m * NQINP + D + h * 3 + 0]));
            float* od = OACC + m * D + h * 64;
#pragma unroll
            for (int d = 0; d < 64; d += 4) *(f32x4*)(od + d) = (f32x4){o[d] * gate, o[d + 1] * gate, o[d + 2] * gate, o[d + 3] * gate};
        }
        const int cur = tt;
        unsigned long long m0 = 0ull, m1 = 0ull;
        if (cur + 1 <= NTOP) { m0 = (cur + 1 >= 64) ? ~0ull : ((1ull << (cur + 1)) - 1ull); }
        else {
            for (int it = 0; it < NTOP; ++it) { float best = -3.0e38f; int bi = 0;
                for (int s = 0; s <= cur; ++s) { float v = imp_col[(size_t)s * T]; if (s == 0 || s == cur || s == cur - 1) v += 1.0e4f;
                    const bool taken = s < 64 ? ((m0 >> s) & 1ull) : ((m1 >> (s - 64)) & 1ull);
                    if (!taken && v > best) { best = v; bi = s; } }
                if (bi < 64) m0 |= 1ull << bi; else m1 |= 1ull << (bi - 64); }
        }
        unsigned* sp = SEL + ((size_t)bg * T + t) * 4; sp[0] = (unsigned)m0; sp[1] = (unsigned)(m0 >> 32); sp[2] = (unsigned)m1; sp[3] = (unsigned)(m1 >> 32);
    }
}
__device__ __forceinline__ void p_slc_win(Frame& F, const Args& a) {
    const bf16* QG = (const bf16*)(F.ws + WS_QG); const bf16* KV = (const bf16*)(F.ws + WS_KV);
    const float* OACC = (const float*)(F.ws + WS_OACC); const unsigned* SEL = (const unsigned*)(F.ws + WS_SEL); bf16* OATT = (bf16*)(F.ws + WS_OATT);
    const float* gq = a.in[I_B_QNORM]; const float* relb = a.in[I_REL_BIAS];
    const int gw = F.vcu * NWAVES + F.wave, NGW = F.G * NWAVES;
    for (int item = gw; item < BATCH * NH * (T / 64); item += NGW) {
        const int bh = item >> 7, tt = item & 127, b = bh >> 4, h = bh & 15, g = h >> 2, t = tt * 64 + F.lane; const size_t m = (size_t)b * T + t;
        float q[64]; load_q(QG, gq, m, h, q);
        float o[64]; float l = 0.f;
#pragma unroll
        for (int d = 0; d < 64; ++d) o[d] = 0.f;
        const unsigned* sp = SEL + ((size_t)(b * NG + g) * T + t) * 4;
#pragma unroll
        for (int w = 0; w < 4; ++w) { unsigned mm = sp[w];
            while (mm) { const int bit = __ffs(mm) - 1; mm &= mm - 1; const int s = 32 * w + bit;
                for (int key = 0; key < 64; ++key) { const int pos = 64 * s + key;
                    if (pos <= t) { const GAS v4u* kr = (const GAS v4u*)(KV + (size_t)(b * T + pos) * NKV + 512 + 64 * g); float dot = 0.f;
#pragma unroll
                        for (int i = 0; i < 8; ++i) { const v4u kw = kr[i];
#pragma unroll
                            for (int k = 0; k < 4; ++k) dot += q[8 * i + 2 * k] * bflo(kw[k]) + q[8 * i + 2 * k + 1] * bfhi(kw[k]); }
                        const float e = __expf(dot + relb[rel_bucket(t - pos) * NH + h]); l += e;
                        const GAS v4u* vr = (const GAS v4u*)(KV + (size_t)(b * T + pos) * NKV + 768 + 64 * g);
#pragma unroll
                        for (int i = 0; i < 8; ++i) { const v4u vw = vr[i];
#pragma unroll
                            for (int k = 0; k < 4; ++k) { o[8 * i + 2 * k] += e * bflo(vw[k]); o[8 * i + 2 * k + 1] += e * bfhi(vw[k]); } } } } } }
        const float g1 = sigmoid_f(bf2f(QG[m * NQINP + D + h * 3 + 1])) / l;
        float r[64];
#pragma unroll
        for (int d = 0; d < 64; ++d) { r[d] = o[d] * g1; o[d] = 0.f; }
        l = 0.f;
        const int t0 = tt * 64, p_lo = t0 - (WIN - 1) > 0 ? t0 - (WIN - 1) : 0;
        for (int pos = p_lo; pos <= t0 + 63; ++pos) { const int dist = t - pos;
            const GAS v4u* kr = (const GAS v4u*)(KV + (size_t)(b * T + pos) * NKV + 1024 + 64 * g); float dot = 0.f;
#pragma unroll
            for (int i = 0; i < 8; ++i) { const v4u kw = kr[i];
#pragma unroll
                for (int k = 0; k < 4; ++k) dot += q[8 * i + 2 * k] * bflo(kw[k]) + q[8 * i + 2 * k + 1] * bfhi(kw[k]); }
            const float e = (dist >= 0 && dist < WIN) ? __expf(dot + relb[rel_bucket(dist) * NH + h]) : 0.f; l += e;
            const GAS v4u* vr = (const GAS v4u*)(KV + (size_t)(b * T + pos) * NKV + 1280 + 64 * g);
#pragma unroll
            for (int i = 0; i < 8; ++i) { const v4u vw = vr[i];
#pragma unroll
                for (int k = 0; k < 4; ++k) { o[8 * i + 2 * k] += e * bflo(vw[k]); o[8 * i + 2 * k + 1] += e * bfhi(vw[k]); } } }
        const float g2 = sigmoid_f(bf2f(QG[m * NQINP + D + h * 3 + 2])) / l;
        const float* oc = OACC + m * D + h * 64; GAS v4u* od = (GAS v4u*)(OATT + m * D + h * 64);
#pragma unroll
        for (int i = 0; i < 8; ++i) { const f32x4 c0 = *(const f32x4*)(oc + 8 * i), c1 = *(const f32x4*)(oc + 8 * i + 4); v4u w;
            w.x = pk2(c0.x + r[8 * i] + o[8 * i] * g2, c0.y + r[8 * i + 1] + o[8 * i + 1] * g2); w.y = pk2(c0.z + r[8 * i + 2] + o[8 * i + 2] * g2, c0.w + r[8 * i + 3] + o[8 * i + 3] * g2);
            w.z = pk2(c1.x + r[8 * i + 4] + o[8 * i + 4] * g2, c1.y + r[8 * i + 5] + o[8 * i + 5] * g2); w.w = pk2(c1.z + r[8 * i + 6] + o[8 * i + 6] * g2, c1.w + r[8 * i + 7] + o[8 * i + 7] * g2);
            od[i] = w; }
    }
}

__device__ __forceinline__ void p_route(Frame& F, const Args& a) {
    const float* H3 = F.out; const float* gain = a.in[I_NORM_FFN] + D; const float* wr = a.in[I_MOE_ROUTER]; bf16* XN = (bf16*)(F.ws + WS_XN);
    unsigned* route = (unsigned*)(F.ws + WS_ROUTE); gu32* ecnt = F.ctl + CW_ECNT;
    const int gw = F.vcu * NWAVES + F.wave, NGW = F.G * NWAVES;
    for (int m = gw; m < M; m += NGW) {
        const GAS f32x4* xr = (const GAS f32x4*)(H3 + (size_t)m * D) + F.lane; const GAS f32x4* gr = (const GAS f32x4*)gain + F.lane;
        f32x4 v[4]; float s = 0.f;
#pragma unroll
        for (int j = 0; j < 4; ++j) { v[j] = xr[64 * j]; s += (v[j].x * v[j].x + v[j].y * v[j].y) + (v[j].z * v[j].z + v[j].w * v[j].w); }
        const float rstd = 1.0f / sqrtf(wave_sum(s) * (1.f / D) + NORM_EPS);
        float lg[8];
#pragma unroll
        for (int e = 0; e < 8; ++e) lg[e] = 0.f;
        GAS unsigned long long* o8 = (GAS unsigned long long*)(XN + (size_t)m * D) + F.lane;
#pragma unroll
        for (int j = 0; j < 4; ++j) { const f32x4 gg = gr[64 * j]; const f32x4 y = (f32x4){v[j].x * rstd * gg.x, v[j].y * rstd * gg.y, v[j].z * rstd * gg.z, v[j].w * rstd * gg.w};
            o8[64 * j] = (unsigned long long)pk2(y.x, y.y) | ((unsigned long long)pk2(y.z, y.w) << 32);
            const GAS f32x4* wp = (const GAS f32x4*)(wr + (size_t)(256 * j + 4 * F.lane) * 8);
#pragma unroll
            for (int k = 0; k < 4; ++k) { const f32x4 w0 = wp[2 * k], w1 = wp[2 * k + 1]; const float yk = y[k];
                lg[0] += yk * w0.x; lg[1] += yk * w0.y; lg[2] += yk * w0.z; lg[3] += yk * w0.w; lg[4] += yk * w1.x; lg[5] += yk * w1.y; lg[6] += yk * w1.z; lg[7] += yk * w1.w; } }
#pragma unroll
        for (int e = 0; e < 8; ++e) lg[e] = wave_sum(lg[e]);
        if (F.lane == 0) {
            int e0 = 0; float v0 = lg[0];
#pragma unroll
            for (int e = 1; e < 8; ++e) if (lg[e] > v0) { v0 = lg[e]; e0 = e; }
            int e1 = -1; float v1 = -3.0e38f;
#pragma unroll
            for (int e = 0; e < 8; ++e) if (e != e0 && lg[e] > v1) { v1 = lg[e]; e1 = e; }
            const float w0 = 1.0f / (1.0f + __expf(v1 - v0)), w1 = 1.0f - w0;
            const unsigned p0 = __hip_atomic_fetch_add(ecnt + e0, 1u, RLX_AGENT), p1 = __hip_atomic_fetch_add(ecnt + e1, 1u, RLX_AGENT);
            unsigned* r = route + (size_t)m * 8; r[0] = (unsigned)e0; r[1] = (unsigned)e1; r[2] = p0; r[3] = p1; r[4] = __float_as_uint(w0); r[5] = __float_as_uint(w1);
        }
    }
}
__device__ __forceinline__ void p_slots(Frame& F) {
    const unsigned* route = (const unsigned*)(F.ws + WS_ROUTE); int* slot_tok = (int*)(F.ws + WS_SLOT_TOK); float* slot_w = (float*)(F.ws + WS_SLOT_W);
    int cnt[8], off[9]; off[0] = 0;
#pragma unroll
    for (int e = 0; e < 8; ++e) { cnt[e] = (int)__hip_atomic_load(F.ctl + CW_ECNT + e, RLX_AGENT); off[e + 1] = off[e] + ((cnt[e] + 255) & ~255); }
    const int gt = F.vcu * (NWAVES * 64) + F.tid, NT = F.G * NWAVES * 64;
    for (int m = gt; m < M; m += NT) { const unsigned* r = route + (size_t)m * 8; const int e0 = (int)r[0], e1 = (int)r[1];
        int o0 = 0, o1 = 0;
#pragma unroll
        for (int e = 0; e < 8; ++e) { o0 = (e == e0) ? off[e] : o0; o1 = (e == e1) ? off[e] : o1; }
        const int s0 = o0 + (int)r[2], s1 = o1 + (int)r[3];
        slot_tok[s0] = m; slot_w[s0] = __uint_as_float(r[4]); slot_tok[s1] = m; slot_w[s1] = __uint_as_float(r[5]); }
    for (int i = gt; i < NSLOT; i += NT) { bool pad = i >= off[8];
#pragma unroll
        for (int e = 0; e < 8; ++e) pad = pad || (i >= off[e] + cnt[e] && i < off[e + 1]);
        if (pad) { slot_tok[i] = -1; slot_w[i] = 0.f; } }
}
struct MoeOrder {
    const gu32* cnt; int ncol, G, c;
    __device__ __forceinline__ bool next(int i, pg8::Unit& u) const {
        const int L = i * G + c; int base = 0, tiles = 0; bool found = false;
#pragma unroll
        for (int e = 0; e < 8; ++e) { const int n = ((int)__hip_atomic_load(cnt + e, RLX_AGENT) + 255) >> 8; const int units = n * ncol;
            if (!found && L < base + units) { found = true; const int r = L - base; u.e = e; u.pnl = r / n; u.pm = tiles + (r - u.pnl * n); u.pn = e * ncol + u.pnl; }
            base += units; tiles += n; }
        return found;
    }
};

constexpr int N_PHASES = 19;
__global__ void __launch_bounds__(NWAVES * 64, 2) fwd_kernel(Args args) {
    extern __shared__ __attribute__((aligned(16))) unsigned char lds[];
    Frame F;
    F.lds = (LAS unsigned char*)lds;
    F.MISC = (volatile LAS unsigned*)(F.lds + MISC_OFF);
    F.tid = threadIdx.x; F.lane = F.tid & 63; F.wave = __builtin_amdgcn_readfirstlane(F.tid >> 6);
    F.G = gridDim.x; { const int bx = blockIdx.x; F.vcu = (F.G % 8 == 0) ? (bx % 8) * (F.G / 8) + bx / 8 : bx; }
    F.ws = args.ws; F.out = args.out; F.ctl = (gu32*)(args.ws + WS_CTL);
    unsigned char* ws = args.ws;
    for (int u = F.tid; u < (LDS_BYTES - LDSCTL_OFF) / 4; u += NWAVES * 64) ((LAS unsigned*)(F.lds + LDSCTL_OFF))[u] = 0u;
    __syncthreads();
    XcdBarrier bar; bar.bar = (unsigned*)(F.ctl + CW_BAR); bar.x = 0; bar.st = nullptr;
    if (MK_SINGLE) bar = xcd_barrier_post((unsigned*)(F.ctl + CW_BAR), F.MISC + 8);
    const int lo = args.ph_lo, hi = args.ph_hi;
#define IN(k) (lo <= (k) && (k) < hi)
#define SEAM(k) do { if (MK_SINGLE && IN(k) && IN((k) + 1)) xcd_barrier(bar); } while (0)
    bf16* XN = (bf16*)(ws + WS_XN); bf16* XN2 = (bf16*)(ws + WS_XN2);
    float* H1 = (float*)(ws + WS_H1); float* H2 = (float*)(ws + WS_H2);

    if (IN(0)) { p0_prologue(F, args); } SEAM(0);
    if (IN(1)) {
        pg8::Gemm g{XN, (const bf16*)(ws + WS_W_IN0), D, nullptr}; pg8::StaticOrder S; S.init(M, NIN0, F.G, (int)blockIdx.x);
        pg8::EpiBf16 E{(bf16*)(ws + WS_QFIG), NIN0};
        pg8::gemm_phase<pg8::EpiBf16, pg8::StaticOrder, true, false>(F.lds + RING_OFF, g, S, E); } SEAM(1);
    if (IN(2)) { p_hgrn_rec(F); } SEAM(2);
    if (IN(3)) { p_onorm(F, args.in[I_A_ONORM]); } SEAM(3);
    if (IN(4)) {
        pg8::Gemm g{(const bf16*)(ws + WS_OG), (const bf16*)(ws + WS_W_OUT0), D, nullptr}; pg8::StaticOrder S; S.init(M, D, F.G, (int)blockIdx.x);
        pg8::EpiResF32 E{args.in[I_X], H1, D};
        pg8::gemm_phase<pg8::EpiResF32, pg8::StaticOrder, false, false>(F.lds + RING_OFF, g, S, E); } SEAM(4);
    if (IN(5)) { p_rmsnorm(F, H1, args.in[I_NORM_FFN], XN, nullptr, nullptr); } SEAM(5);
    if (IN(6)) {
        pg8::Gemm g{XN, (const bf16*)(ws + WS_W_GU0), D, nullptr}; pg8::StaticOrder S; S.init(M, 2 * FF, F.G, (int)blockIdx.x);
        pg8::EpiSwiglu E{(bf16*)(ws + WS_ACT), FF};
        pg8::gemm_phase<pg8::EpiSwiglu, pg8::StaticOrder, true, false>(F.lds + RING_OFF, g, S, E); } SEAM(6);
    if (IN(7)) {
        pg8::Gemm g{(const bf16*)(ws + WS_ACT), (const bf16*)(ws + WS_W_DN0), FF, nullptr}; pg8::StaticOrder S; S.init(M, D, F.G, (int)blockIdx.x);
        pg8::EpiResF32 E{H1, H2, D};
        pg8::gemm_phase<pg8::EpiResF32, pg8::StaticOrder, false, false>(F.lds + RING_OFF, g, S, E); } SEAM(7);
    if (IN(8)) { p_rmsnorm(F, H2, args.in[I_KV_NORM], XN, args.in[I_NORM_MIX] + D, XN2); } SEAM(8);
    if (IN(9)) {
        { pg8::Gemm g{XN, (const bf16*)(ws + WS_W_KV), D, nullptr}; pg8::StaticOrder S; S.init(M, NKV, F.G, (int)blockIdx.x);
          pg8::EpiBf16 E{(bf16*)(ws + WS_KV), NKV};
          pg8::gemm_phase<pg8::EpiBf16, pg8::StaticOrder, true, false>(F.lds + RING_OFF, g, S, E); }
        { pg8::Gemm g{XN2, (const bf16*)(ws + WS_W_QIN), D, nullptr}; pg8::StaticOrder S; S.init(M, NQINP, F.G, (int)blockIdx.x);
          pg8::EpiBf16 E{(bf16*)(ws + WS_QG), NQINP};
          pg8::gemm_phase<pg8::EpiBf16, pg8::StaticOrder, true, false>(F.lds + RING_OFF, g, S, E); } } SEAM(9);
    if (IN(10)) { p_knorm(F, args.in[I_K_NORM]); p_compress(F, args); } SEAM(10);
    if (IN(11)) { p_cmp_attn(F, args); } SEAM(11);
    if (IN(12)) { } SEAM(12);
    if (IN(13)) { p_slc_win(F, args); } SEAM(13);
    if (IN(14)) {
        pg8::Gemm g{(const bf16*)(ws + WS_OATT), (const bf16*)(ws + WS_W_OUT1), D, nullptr}; pg8::StaticOrder S; S.init(M, D, F.G, (int)blockIdx.x);
        pg8::EpiResF32 E{H2, F.out, D};
        pg8::gemm_phase<pg8::EpiResF32, pg8::StaticOrder, false, false>(F.lds + RING_OFF, g, S, E); } SEAM(14);
    if (IN(15)) { p_route(F, args); } SEAM(15);
    if (IN(16)) { p_slots(F); } SEAM(16);
    if (IN(17)) {
        pg8::Gemm g{XN, (const bf16*)(ws + WS_W_GU1), D, (const int*)(ws + WS_SLOT_TOK)}; MoeOrder S{F.ctl + CW_ECNT, 2 * EF / 256, F.G, F.vcu};
        pg8::EpiSwiglu E{(bf16*)(ws + WS_ACT2), EF};
        pg8::gemm_phase<pg8::EpiSwiglu, MoeOrder, true, true>(F.lds + RING_OFF, g, S, E); } SEAM(17);
    if (IN(18)) {
        pg8::Gemm g{(const bf16*)(ws + WS_ACT2), (const bf16*)(ws + WS_W_DN1), EF, nullptr}; MoeOrder S{F.ctl + CW_ECNT, D / 256, F.G, F.vcu};
        pg8::EpiMoeDown E{F.out, (const int*)(ws + WS_SLOT_TOK), (const float*)(ws + WS_SLOT_W), D};
        pg8::gemm_phase<pg8::EpiMoeDown, MoeOrder, false, false>(F.lds + RING_OFF, g, S, E); }
#undef IN
#undef SEAM
}

extern "C" void kernel_launch(void* const* d_in, const int* in_sizes, int n_in, void* d_out, int out_size, void* d_ws, size_t ws_size, hipStream_t stream) {
    static int grid = 0;
    if (grid == 0) {
        if (n_in != N_IN || in_sizes[0] != M * D || out_size != M * D || ws_size < WS_END) { fprintf(stderr, "kernel_launch: unexpected shapes (n_in %d, in0 %d, out %d, ws %zu < %zu); nothing launched\n", n_in, n_in > 0 ? in_sizes[0] : -1, out_size, ws_size, (size_t)WS_END); grid = -1; return; }
        int dev = 0, cus = 0, per_cu = 0;
        if (hipGetDevice(&dev) != hipSuccess || hipDeviceGetAttribute(&cus, hipDeviceAttributeMultiprocessorCount, dev) != hipSuccess) { grid = -1; return; }
        if (hipFuncSetAttribute((const void*)fwd_kernel, hipFuncAttributeMaxDynamicSharedMemorySize, LDS_BYTES) != hipSuccess) { fprintf(stderr, "kernel_launch: hipFuncSetAttribute failed\n"); grid = -1; return; }
        if (hipOccupancyMaxActiveBlocksPerMultiprocessor(&per_cu, (const void*)fwd_kernel, NWAVES * 64, LDS_BYTES) != hipSuccess || per_cu < 1)
            fprintf(stderr, "kernel_launch: note: occupancy query reports %d workgroups per CU\n", per_cu);
        (void)hipGetLastError();
        grid = cus;
    }
    if (grid < 0) return;
    if (hipMemsetAsync((char*)d_ws + WS_CTL, 0, CTL_ZERO_BYTES, stream) != hipSuccess) { fprintf(stderr, "kernel_launch: hipMemsetAsync failed\n"); return; }
    Args a{};
    for (int i = 0; i < N_IN; ++i) a.in[i] = (const float*)d_in[i];
    a.out = (float*)d_out; a.ws = (unsigned char*)d_ws;
#if MK_SINGLE
    a.ph_lo = 0; a.ph_hi = N_PHASES;
    hipLaunchKernelGGL(fwd_kernel, dim3(grid), dim3(NWAVES * 64), LDS_BYTES, stream, a);
#else
    for (int p = 0; p < N_PHASES; ++p) { if (p == 12) continue; a.ph_lo = p; a.ph_hi = p + 1; hipLaunchKernelGGL(fwd_kernel, dim3(grid), dim3(NWAVES * 64), LDS_BYTES, stream, a); }
#endif
}
```

```cpp
#include <hip/hip_runtime.h>
#include <cstdio>
#include <cstdint>

#ifndef REP_PHASE
#define REP_PHASE -1
#endif
#ifndef MK_SINGLE
#define MK_SINGLE 1
#endif

namespace pg8 {
#define PG8_LAS __attribute__((address_space(3)))
typedef unsigned short bf16_t;
typedef short bf16x8 __attribute__((ext_vector_type(8)));
typedef float f32x4 __attribute__((ext_vector_type(4)));
typedef unsigned u32x4 __attribute__((ext_vector_type(4)));
typedef unsigned u32x2 __attribute__((ext_vector_type(2)));
typedef float f32x2 __attribute__((ext_vector_type(2)));
constexpr int BM = 256, BK = 64, HALF = 128, HTB = HALF * BK * 2  , STAGE_BYTES = 8 * HTB, NXCD = 8, WGM = 8;

__host__ __device__ __forceinline__ int lds_byte(int r, int c) { const int st = (r >> 4) * 2 + (c >> 5), rr = r & 15, cc = c & 31, ob = rr * 64 + cc * 2; return st * 1024 + (ob ^ (((ob >> 9) & 1) << 5)); }
__host__ __device__ __forceinline__ void stage_rc(int b, int& R, int& C) { const int st = b / 1024, sb = b % 1024, swz = sb ^ (((sb >> 9) & 1) << 5); R = (st >> 1) * 16 + swz / 64; C = (st & 1) * 32 + (swz % 64) / 2; }
__host__ __device__ __forceinline__ int perm32(int rho) { const int n = rho >> 4, i = rho & 15; return 8 * (i >> 2) + 4 * n + (i & 3); }

struct Unit { int pm, pn, pnl, pa, nv; };
struct Gemm { const bf16_t* A; const bf16_t* Bt; int K; };

struct StaticOrder {
    int nM, nN, nwg, G, c;
    __host__ __device__ void init(int M, int N, int G_, int c_) { nM = M / BM; nN = N / BM; nwg = nM * nN; G = G_; c = c_; }
    __host__ __device__ bool next(int i, Unit& u) const {
        const long L = (long)i * G + c; if (L >= nwg) return false;
        int wgid = (int)L; { const int q = nwg / NXCD, r = nwg % NXCD, xcd = wgid % NXCD, off = wgid / NXCD; wgid = (xcd < r ? xcd * (q + 1) : r * (q + 1) + (xcd - r) * q) + off; }
        const int nig = WGM * nN, gid = wgid / nig, fm = gid * WGM, gsz = (nM - fm) < WGM ? (nM - fm) : WGM;
        u.pm = fm + ((wgid % nig) % gsz); u.pn = (wgid % nig) / gsz; u.pnl = u.pn; u.pa = u.pm; u.nv = BM; return true;
    }
};

__device__ __forceinline__ unsigned cvt_pk_bf16(float lo, float hi) { unsigned r; asm volatile("v_cvt_pk_bf16_f32 %0, %1, %2" : "=v"(r) : "v"(lo), "v"(hi)); return r; }

__device__ __forceinline__ float row_rstd(const float* ssp, int row) {
    const f32x4* p = (const f32x4*)(ssp + (size_t)row * 16); const f32x4 a = p[0], b = p[1], c = p[2], d = p[3];
    const float s = ((a[0] + a[1]) + (a[2] + a[3])) + ((b[0] + b[1]) + (b[2] + b[3])) + (((c[0] + c[1]) + (c[2] + c[3])) + ((d[0] + d[1]) + (d[2] + d[3])));
    return 1.0f / sqrtf(s * (1.0f / 1024.0f) + 1e-6f);
}
struct EpiBf16 {
    static constexpr bool PERM = true;
    bf16_t* O; int ldc; const float* ssp; int split; bf16_t* O2; int ldc2;
    static constexpr bool HAS_PREP = true;
    __device__ __forceinline__ void prep(const Unit& u, PG8_LAS float* slot) const { if (ssp && threadIdx.x < 256) slot[threadIdx.x] = row_rstd(ssp, u.pm * BM + threadIdx.x); }
    __device__ __forceinline__ void operator()(const f32x4 (&acc)[2][2][4][2], const Unit& u, int wr, int wc, int fr, int fq, const PG8_LAS float* rsl) const {
        const int row0 = u.pm * BM + wr * 64 + fr; bf16_t* base = O; int ld = ldc, pt = u.pnl;
        if (split > 0 && pt >= split) { base = O2; ld = ldc2; pt -= split; }
        const int col0 = pt * BM + wc * 32 + 8 * fq;
        const __amdgpu_buffer_rsrc_t rsrc = __builtin_amdgcn_make_buffer_rsrc(base, 0, 0x7fffffff, 0x00020000);
#pragma unroll
        for (int ai = 0; ai < 2; ++ai)
#pragma unroll
            for (int m = 0; m < 4; ++m) { const int row = row0 + ai * HALF + m * 16; const unsigned boff = (unsigned)(((size_t)row * ld + col0) * 2); const float rs = ssp ? rsl[row - u.pm * BM] : 1.0f;
#pragma unroll
                for (int bj = 0; bj < 2; ++bj) { const f32x4 v0 = acc[ai][bj][m][0] * rs, v1 = acc[ai][bj][m][1] * rs;
                    u32x4 w; w.x = cvt_pk_bf16(v0[0], v0[1]); w.y = cvt_pk_bf16(v0[2], v0[3]); w.z = cvt_pk_bf16(v1[0], v1[1]); w.w = cvt_pk_bf16(v1[2], v1[3]);
                    __builtin_amdgcn_raw_buffer_store_b128(w, rsrc, boff + bj * HALF * 2, 0, 16); } }
    }
};
__device__ __forceinline__ float silu_f(float x) { return x / (1.0f + __expf(-x)); }
__device__ __forceinline__ float clamp8(float x) { return fminf(fmaxf(x, -440.0f), 440.0f); }
__device__ __forceinline__ unsigned pk4_fp8(float a, float b, float c, float d) { int w = __builtin_amdgcn_cvt_pk_fp8_f32(clamp8(a), clamp8(b), 0, false); w = __builtin_amdgcn_cvt_pk_fp8_f32(clamp8(c), clamp8(d), w, true); return (unsigned)w; }
constexpr float F8_WSCALE = 256.0f;
constexpr float F8_ASCALE = 8.0f;
struct EpiSwiglu {
    static constexpr bool PERM = true;
    bf16_t* O; int ldc; const float* ssp;
    static constexpr bool HAS_PREP = true;
    __device__ __forceinline__ void prep(const Unit& u, PG8_LAS float* slot) const { if (threadIdx.x < 256) slot[threadIdx.x] = row_rstd(ssp, u.pm * BM + threadIdx.x); }
    __device__ __forceinline__ void operator()(const f32x4 (&acc)[2][2][4][2], const Unit& u, int wr, int wc, int fr, int fq, const PG8_LAS float* rsl) const {
        const int row0 = u.pm * BM + wr * 64 + fr; const int col0 = u.pnl * HALF + wc * 32 + 8 * fq;
        const __amdgpu_buffer_rsrc_t rsrc = __builtin_amdgcn_make_buffer_rsrc(O, 0, 0x7fffffff, 0x00020000);
#pragma unroll
        for (int ai = 0; ai < 2; ++ai)
#pragma unroll
            for (int m = 0; m < 4; ++m) { const int row = row0 + ai * HALF + m * 16; const unsigned boff = (unsigned)(((size_t)row * ldc + col0) * 2); const float rs = rsl[row - u.pm * BM];
                const f32x4 g0 = acc[ai][0][m][0] * rs, g1 = acc[ai][0][m][1] * rs, u0 = acc[ai][1][m][0] * rs, u1 = acc[ai][1][m][1] * rs;
                u32x4 w; w.x = cvt_pk_bf16(silu_f(g0[0]) * u0[0], silu_f(g0[1]) * u0[1]); w.y = cvt_pk_bf16(silu_f(g0[2]) * u0[2], silu_f(g0[3]) * u0[3]);
                w.z = cvt_pk_bf16(silu_f(g1[0]) * u1[0], silu_f(g1[1]) * u1[1]); w.w = cvt_pk_bf16(silu_f(g1[2]) * u1[2], silu_f(g1[3]) * u1[3]);
                __builtin_amdgcn_raw_buffer_store_b128(w, rsrc, boff, 0, 16); }
    }
};
struct EpiResF32 {
    static constexpr bool PERM = false;
    const float* res; const bf16_t* resb; float* out; int ldc; bf16_t* xh; float* ssp; unsigned char* x8  ;
    static constexpr bool HAS_PREP = false;
    __device__ __forceinline__ void prep(const Unit&, PG8_LAS float*) const {}
    __device__ __forceinline__ void operator()(const f32x4 (&acc)[2][2][4][2], const Unit& u, int wr, int wc, int fr, int fq, const PG8_LAS float*) const {
        const int col0 = u.pnl * BM + wc * 32 + 4 * fq;
        const __amdgpu_buffer_rsrc_t rsrcx = __builtin_amdgcn_make_buffer_rsrc(xh, 0, 0x7fffffff, 0x00020000);
#pragma unroll
        for (int ai = 0; ai < 2; ++ai)
#pragma unroll
            for (int m = 0; m < 4; ++m) { const int row = u.pm * BM + ai * HALF + wr * 64 + m * 16 + fr; const size_t off = (size_t)row * ldc + col0; float ss = 0.f;
#pragma unroll
                for (int bj = 0; bj < 2; ++bj)
#pragma unroll
                    for (int n = 0; n < 2; ++n) { f32x4 bs;
                        if (res) bs = *(const f32x4*)(res + off + bj * HALF + n * 16);
                        else { const unsigned long long rb = *(const unsigned long long*)(resb + off + bj * HALF + n * 16); const unsigned lo = (unsigned)rb, hi = (unsigned)(rb >> 32);
                            bs = (f32x4){__builtin_bit_cast(float, lo << 16), __builtin_bit_cast(float, lo & 0xffff0000u), __builtin_bit_cast(float, hi << 16), __builtin_bit_cast(float, hi & 0xffff0000u)}; }
                        const f32x4 o = bs + acc[ai][bj][m][n]; if (out) *(f32x4*)(out + off + bj * HALF + n * 16) = o;
                        ss += (o[0] * o[0] + o[1] * o[1]) + (o[2] * o[2] + o[3] * o[3]);
                        __builtin_amdgcn_raw_buffer_store_b64((u32x2){cvt_pk_bf16(o[0], o[1]), cvt_pk_bf16(o[2], o[3])}, rsrcx, (unsigned)((off + bj * HALF + n * 16) * 2), 0, 16);
                        if (x8) *(unsigned*)(x8 + off + bj * HALF + n * 16) = pk4_fp8(o[0], o[1], o[2], o[3]); }
                ss += __shfl_xor(ss, 16); ss += __shfl_xor(ss, 32);
                if (fq == 0) ssp[(size_t)row * 16 + 4 * u.pnl + wc] = ss; }
    }
};
struct EpiSwigluF8 {
    static constexpr bool PERM = true;
    unsigned char* O; int ldc; const float* rs_e;
    static constexpr bool HAS_PREP = true;
    __device__ __forceinline__ void prep(const Unit& u, PG8_LAS float* slot) const { if (threadIdx.x < 256) slot[threadIdx.x] = (int)threadIdx.x < u.nv ? rs_e[(size_t)u.pa * BM + threadIdx.x] * (1.0f / F8_WSCALE) : 0.f; }
    __device__ __forceinline__ void operator()(const f32x4 (&acc)[2][2][4][2], const Unit& u, int wr, int wc, int fr, int fq, const PG8_LAS float* rsl) const {
        const int row0 = u.pm * BM + wr * 64 + fr; const int col0 = u.pnl * HALF + wc * 32 + 8 * fq;
        const __amdgpu_buffer_rsrc_t rsrc8 = __builtin_amdgcn_make_buffer_rsrc(O, 0, 0x7fffffff, 0x00020000);
#pragma unroll
        for (int ai = 0; ai < 2; ++ai)
#pragma unroll
            for (int m = 0; m < 4; ++m) { const int row = row0 + ai * HALF + m * 16; const unsigned boff = (unsigned)((size_t)row * ldc + col0); const float rs = rsl[row - u.pm * BM];
                const f32x4 g0 = acc[ai][0][m][0] * rs, g1 = acc[ai][0][m][1] * rs, u0 = acc[ai][1][m][0] * (rs * F8_ASCALE), u1 = acc[ai][1][m][1] * (rs * F8_ASCALE);
                const unsigned w0 = pk4_fp8(silu_f(g0[0]) * u0[0], silu_f(g0[1]) * u0[1], silu_f(g0[2]) * u0[2], silu_f(g0[3]) * u0[3]);
                const unsigned w1 = pk4_fp8(silu_f(g1[0]) * u1[0], silu_f(g1[1]) * u1[1], silu_f(g1[2]) * u1[2], silu_f(g1[3]) * u1[3]);
                __builtin_amdgcn_raw_buffer_store_b64((u32x2){w0, w1}, rsrc8, boff, 0, 16); }
    }
};
struct EpiMoeDown {
    static constexpr bool PERM = true;
    bf16_t* Y; int ldc; float scale;
    static constexpr bool HAS_PREP = false;
    __device__ __forceinline__ void prep(const Unit&, PG8_LAS float*) const {}
    __device__ __forceinline__ void operator()(const f32x4 (&acc)[2][2][4][2], const Unit& u, int wr, int wc, int fr, int fq, const PG8_LAS float*) const {
        const int row0 = u.pm * BM + wr * 64 + fr; const int col0 = u.pnl * BM + wc * 32 + 8 * fq;
        const __amdgpu_buffer_rsrc_t rsrc = __builtin_amdgcn_make_buffer_rsrc(Y, 0, 0x7fffffff, 0x00020000);
#pragma unroll
        for (int ai = 0; ai < 2; ++ai)
#pragma unroll
            for (int m = 0; m < 4; ++m) { const unsigned boff = (unsigned)(((size_t)(row0 + ai * HALF + m * 16) * ldc + col0) * 2);
#pragma unroll
                for (int bj = 0; bj < 2; ++bj) { const f32x4 v0 = acc[ai][bj][m][0] * scale, v1 = acc[ai][bj][m][1] * scale;
                    u32x4 w; w.x = cvt_pk_bf16(v0[0], v0[1]); w.y = cvt_pk_bf16(v0[2], v0[3]); w.z = cvt_pk_bf16(v1[0], v1[1]); w.w = cvt_pk_bf16(v1[2], v1[3]);
                    __builtin_amdgcn_raw_buffer_store_b128(w, rsrc, boff + bj * HALF * 2, 0, 16); } }
    }
};

template <class Epi, class Sched, bool ALIGN_EPI, bool F8 = false>
__device__ __forceinline__ void gemm_phase(PG8_LAS unsigned char* lds, const Gemm g, const Sched& S, const Epi& E) {
    const int tid = threadIdx.x, wid = __builtin_amdgcn_readfirstlane(tid >> 6), lane = tid & 63, wr = wid >> 2, wc = wid & 3, fr = lane & 15, fq = lane >> 4;
    constexpr int EB = F8 ? 1 : 2;
    const int K = g.K, nt = K * EB / (BK * 2);
    unsigned voffB[2], voffA[2];
#pragma unroll
    for (int i = 0; i < 2; ++i) { int R, C; stage_rc(tid * 16 + i * 8192, R, C); const int Rb = Epi::PERM ? ((R & ~31) + perm32(R & 31)) : R;
        voffA[i] = (unsigned)(R * K * EB + C * 2); voffB[i] = (unsigned)(Rb * K * EB + C * 2); }
    const size_t kstep = (size_t)(BK * 2);
    const size_t hstep = (size_t)HALF * K * EB;
    const size_t tstep = 2 * hstep;
    const unsigned ldsw = (unsigned)wid * 1024u;
    const int aoff = lds_byte(wr * 64 + fr, fq * (F8 ? 16 : 8)), boff = lds_byte(wc * 32 + fr, fq * (F8 ? 16 : 8));
    typedef int v8i_ __attribute__((ext_vector_type(8))); typedef int v4i_ __attribute__((ext_vector_type(4)));
#define PG8_SA(b, h) (((b) * 2 + (h)) * HTB)
#define PG8_SB(b, h) ((4 + (b) * 2 + (h)) * HTB)
#define PG8_STAGE(bufoff, gbase, voff) do { _Pragma("unroll") for (int _i = 0; _i < 2; ++_i) \
        __builtin_amdgcn_global_load_lds((const unsigned*)((const char*)(gbase) + (voff)[_i]), (PG8_LAS unsigned*)(lds + (bufoff) + ldsw + _i * 8192), 16, 0, 0); } while (0)
#define PG8_LD32(p) __builtin_shufflevector(*(const PG8_LAS v4i_*)(p), *(const PG8_LAS v4i_*)((p) + 16), 0, 1, 2, 3, 4, 5, 6, 7)
#define PG8_LDA(dst, b, h) do { _Pragma("unroll") for (int m = 0; m < 4; ++m) { if constexpr (F8) dst##8[m] = PG8_LD32(lds + PG8_SA(b, h) + aoff + m * 2048); else { _Pragma("unroll") for (int k = 0; k < 2; ++k) dst[m][k] = *(const PG8_LAS bf16x8*)(lds + PG8_SA(b, h) + aoff + m * 2048 + k * 1024); } } } while (0)
#define PG8_LDB(dst, b, h) do { _Pragma("unroll") for (int n = 0; n < 2; ++n) { if constexpr (F8) dst##8[n] = PG8_LD32(lds + PG8_SB(b, h) + boff + n * 2048); else { _Pragma("unroll") for (int k = 0; k < 2; ++k) dst[n][k] = *(const PG8_LAS bf16x8*)(lds + PG8_SB(b, h) + boff + n * 2048 + k * 1024); } } } while (0)
#define PG8_MMA(ai, bj, At, Bt) do { __builtin_amdgcn_s_setprio(1); _Pragma("unroll") for (int m = 0; m < 4; ++m) _Pragma("unroll") for (int n = 0; n < 2; ++n) { \
        if constexpr (F8) acc[ai][bj][m][n] = __builtin_amdgcn_mfma_scale_f32_16x16x128_f8f6f4(Bt##8[n], At##8[m], acc[ai][bj][m][n], 0, 0, 0, 0x7F7F7F7F, 0, 0x7F7F7F7F); \
        else { _Pragma("unroll") for (int k = 0; k < 2; ++k) acc[ai][bj][m][n] = __builtin_amdgcn_mfma_f32_16x16x32_bf16(Bt[n][k], At[m][k], acc[ai][bj][m][n], 0, 0, 0); } } \
        if constexpr (F8) { _Pragma("unroll") for (int m = 0; m < 4; ++m) _Pragma("unroll") for (int n = 0; n < 2; ++n) asm volatile("" : "+v"(acc[ai][bj][m][n])); }     \
        __builtin_amdgcn_s_setprio(0); } while (0)
#define PG8_WAIT_V(n) asm volatile("s_waitcnt vmcnt(" #n ")" ::: "memory")
#define PG8_WAIT_L(n) asm volatile("s_waitcnt lgkmcnt(" #n ")" ::: "memory")
#define PG8_BAR __builtin_amdgcn_s_barrier()
#define PG8_SCHED __builtin_amdgcn_sched_barrier(0)
    Unit cur, nxt; int ui = 0;
    if (!S.next(0, cur)) return;
    f32x4 acc[2][2][4][2];
#pragma unroll
    for (int a = 0; a < 2; ++a)
#pragma unroll
        for (int b = 0; b < 2; ++b)
#pragma unroll
            for (int m = 0; m < 4; ++m)
#pragma unroll
                for (int n = 0; n < 2; ++n) acc[a][b][m][n] = (f32x4){0.f, 0.f, 0.f, 0.f};
    bf16x8 At[4][2], B0[2][2], B1[2][2]; v8i_ At8[4], B08[2], B18[2];
    const char* cA = (const char*)g.A + (size_t)cur.pa * tstep; const char* cB = (const char*)g.Bt + (size_t)cur.pn * tstep;
    PG8_LAS float* const rsl0 = (PG8_LAS float*)(lds + STAGE_BYTES);
    if constexpr (Epi::HAS_PREP) E.prep(cur, rsl0);
    PG8_STAGE(PG8_SB(0, 0), cB, voffB); PG8_STAGE(PG8_SB(0, 1), cB + hstep, voffB); PG8_STAGE(PG8_SA(0, 0), cA, voffA); PG8_STAGE(PG8_SA(0, 1), cA + hstep, voffA);
    if (wr == 1) PG8_BAR;
    PG8_WAIT_V(2); PG8_BAR;
    PG8_STAGE(PG8_SB(1, 0), cB + kstep, voffB); PG8_STAGE(PG8_SA(1, 0), cA + kstep, voffA); PG8_STAGE(PG8_SB(1, 1), cB + hstep + kstep, voffB);
    PG8_WAIT_V(6); PG8_BAR;
    for (;;) {
        const bool has_next = S.next(ui + 1, nxt);
        const char* nA = has_next ? (const char*)g.A + (size_t)nxt.pa * tstep : cA; const char* nB = has_next ? (const char*)g.Bt + (size_t)nxt.pn * tstep : cB;
        for (int t = 0; t < nt; t += 2) {
            const bool last = (t == nt - 2);
            const char* a1 = cA + (size_t)(t + 1) * kstep;
            const char* a2 = last ? nA : cA + (size_t)(t + 2) * kstep; const char* b2 = last ? nB : cB + (size_t)(t + 2) * kstep;
            const char* a3 = a2 + kstep; const char* b3 = b2 + kstep;
            PG8_LDB(B0, 0, 0); PG8_LDB(B1, 0, 1); PG8_SCHED; PG8_LDA(At, 0, 0); PG8_STAGE(PG8_SA(1, 1), a1 + hstep, voffA);
            PG8_WAIT_V(8); PG8_WAIT_L(0); PG8_BAR; PG8_MMA(0, 0, At, B0); PG8_MMA(0, 1, At, B1); PG8_BAR; PG8_SCHED;
            PG8_LDA(At, 0, 1); PG8_STAGE(PG8_SB(0, 0), b2, voffB); PG8_STAGE(PG8_SB(0, 1), b2 + hstep, voffB); PG8_STAGE(PG8_SA(0, 0), a2, voffA);
            PG8_WAIT_V(8); PG8_WAIT_L(0); PG8_BAR; PG8_MMA(1, 0, At, B0); PG8_MMA(1, 1, At, B1); PG8_BAR; PG8_SCHED;
            PG8_LDB(B0, 1, 0); PG8_LDB(B1, 1, 1); PG8_SCHED; PG8_LDA(At, 1, 0); PG8_STAGE(PG8_SA(0, 1), a2 + hstep, voffA);
            PG8_WAIT_V(8); PG8_WAIT_L(0); PG8_BAR; PG8_MMA(0, 0, At, B0); PG8_MMA(0, 1, At, B1); PG8_BAR; PG8_SCHED;
            PG8_LDA(At, 1, 1); PG8_STAGE(PG8_SB(1, 0), b3, voffB); PG8_STAGE(PG8_SB(1, 1), b3 + hstep, voffB); PG8_STAGE(PG8_SA(1, 0), a3, voffA);
            PG8_WAIT_V(8); PG8_WAIT_L(0); PG8_BAR; PG8_MMA(1, 0, At, B0); PG8_MMA(1, 1, At, B1); PG8_BAR; PG8_SCHED;
        }
        if constexpr (ALIGN_EPI) { if (wr == 0) PG8_BAR; }
        E(acc, cur, wr, wc, fr, fq, rsl0 + (ui & 1) * 256);
        if (!has_next) break;
#pragma unroll
        for (int a = 0; a < 2; ++a)
#pragma unroll
            for (int b = 0; b < 2; ++b)
#pragma unroll
                for (int m = 0; m < 4; ++m)
#pragma unroll
                    for (int n = 0; n < 2; ++n) acc[a][b][m][n] = (f32x4){0.f, 0.f, 0.f, 0.f};
        cur = nxt; cA = nA; cB = nB; ++ui;
        if constexpr (Epi::HAS_PREP) E.prep(cur, rsl0 + (ui & 1) * 256);
        if constexpr (ALIGN_EPI) { if (wr == 1) PG8_BAR; }
    }
    PG8_WAIT_V(0);
    if constexpr (!ALIGN_EPI) { if (wr == 0) PG8_BAR; }
    PG8_BAR;
#undef PG8_SA
#undef PG8_SB
#undef PG8_STAGE
#undef PG8_LDA
#undef PG8_LD32
#undef PG8_LDB
#undef PG8_MMA
#undef PG8_WAIT_V
#undef PG8_WAIT_L
#undef PG8_BAR
#undef PG8_SCHED
}
}

constexpr int NWAVES = 8;
constexpr int BATCH = 2, T = 8192, D = 1024, M = BATCH * T;
constexpr int HG_H = 8, HG_DH = 128;
constexpr int NH = 16, NG = 4, HPG = 4, DH = 64;
constexpr int NCMP = 511, NCMPP = 512, NSEL = 128, NTOP = 16, WIN = 512;
constexpr int FF = 2816, NE = 8, EF = 3584;
constexpr int NIN0 = 4 * D;
constexpr int NKV = 1536, NQIN = 1072, NQINP = 1280;
constexpr int NSLOT = 2 * M + NE * 256;
constexpr float NORM_EPS = 1e-6f;

constexpr size_t MiB = 1u << 20;
constexpr size_t WS_CTL = 0, CTL_ZERO_BYTES = 1 * MiB;
constexpr size_t WS_SSP1 = 222 * MiB, WS_SSP2 = 223 * MiB, WS_SSP3 = 8 * MiB;
constexpr size_t WS_LB = 1 * MiB;
constexpr size_t WS_ROUTE = 6 * MiB;
constexpr size_t WS_W_IN0 = 16 * MiB;
constexpr size_t WS_W_OUT0 = 24 * MiB;
constexpr size_t WS_W_GU0 = 26 * MiB;
constexpr size_t WS_W_DN0 = 37 * MiB;
constexpr size_t WS_W_KV = 43 * MiB;
constexpr size_t WS_W_QIN = 46 * MiB;
constexpr size_t WS_W_OUT1 = 49 * MiB;
constexpr size_t WS_W_GU1 = 51 * MiB;
constexpr size_t WS_W_DN1 = 163 * MiB;
constexpr size_t WS_RS_E = 256 * MiB;
constexpr size_t WS_W1T = 219 * MiB;
constexpr size_t WS_W2T = 221 * MiB;
constexpr size_t WS_PB = 221 * MiB + 256 * 1024;
constexpr size_t WS_XN = 224 * MiB;
constexpr size_t WS_KV = 352 * MiB;
constexpr size_t WS_QG = 400 * MiB;
constexpr size_t WS_OATT = 440 * MiB;
constexpr size_t WS_R = 480 * MiB;
constexpr size_t WS_QFIG = WS_R;
constexpr size_t WS_O0 = WS_R + 128 * MiB;
constexpr size_t WS_OG = WS_R + 192 * MiB;
constexpr size_t WS_ACT = WS_R + 288 * MiB;
constexpr size_t WS_ACT2 = WS_R;
constexpr size_t WS_XG8 = WS_R + 120 * MiB;
constexpr size_t WS_Y2 = WS_R + 256 * MiB;
constexpr size_t WS_OACC = WS_R + 272 * MiB;
constexpr size_t WS_END = WS_R + 376 * MiB;
static_assert(WS_ACT2 + (size_t)NSLOT * EF <= WS_XG8 && WS_XG8 + (size_t)NE * M * D <= WS_Y2 && WS_Y2 + (size_t)NSLOT * D * 2 <= WS_END && WS_ACT + (size_t)M * FF * 2 <= WS_END, "d_ws map");
constexpr int CW_TMO = 0;
constexpr int CW_ECNT = 64;
constexpr int CW_BAR = 4096;

constexpr int RING_OFF = 0, RING_BYTES = 131072;
constexpr int LDSCTL_OFF = 147456 - 1024, MISC_OFF = LDSCTL_OFF + 320;
constexpr int LDS_BYTES = 147456;
static_assert(MISC_OFF + 128 <= LDS_BYTES, "LDS map");

#define GAS __attribute__((address_space(1)))
#define LAS __attribute__((address_space(3)))
typedef unsigned short bf16;
typedef unsigned v4u __attribute__((ext_vector_type(4)));
typedef float f32x4 __attribute__((ext_vector_type(4)));
typedef short bf16x8 __attribute__((ext_vector_type(8)));
typedef GAS unsigned gu32;
#define RLX_AGENT __ATOMIC_RELAXED, __HIP_MEMORY_SCOPE_AGENT
#define LDS_WAIT() asm volatile("s_waitcnt lgkmcnt(0)" ::: "memory")
#define VM_WAIT() asm volatile("s_waitcnt vmcnt(0)" ::: "memory")
__device__ __forceinline__ unsigned f2bf(float f) { unsigned u = __builtin_bit_cast(unsigned, f); return (u + 0x7fffu + ((u >> 16) & 1u)) >> 16; }
__device__ __forceinline__ unsigned pk2(float lo, float hi) { return f2bf(lo) | (f2bf(hi) << 16); }
__device__ __forceinline__ float bf2f(unsigned short b) { return __builtin_bit_cast(float, (unsigned)b << 16); }
__device__ __forceinline__ float bflo(unsigned w) { return __builtin_bit_cast(float, w << 16); }
__device__ __forceinline__ float bfhi(unsigned w) { return __builtin_bit_cast(float, w & 0xffff0000u); }
__device__ __forceinline__ float sigmoid_f(float x) { return 1.0f / (1.0f + __expf(-x)); }
#define XB_TMO      128
#define XB_XCNT(j)  (256  + 64 * (j))
#define XB_XSUB(j)  (1280 + 64 * (j))
#define XB_XGEN(j)  (2304 + 64 * (j))
#define XB_TOP      3328
#define XB_TOPGEN   3392
#define XCD_BAR_WORDS 3456
#define XB_SPIN_CAP (1u << 18)

__device__ __forceinline__ unsigned xb_ld(unsigned* p)              { return __hip_atomic_load(p, __ATOMIC_RELAXED, __HIP_MEMORY_SCOPE_AGENT); }
__device__ __forceinline__ unsigned xb_add(unsigned* p, unsigned v) { return __hip_atomic_fetch_add(p, v, __ATOMIC_RELAXED, __HIP_MEMORY_SCOPE_AGENT); }
__device__ __forceinline__ unsigned xb_xcc_id() { return (unsigned)__builtin_amdgcn_s_getreg((3 << 11) | 20) & 0xFu; }
#define XB_SPIN(cond, bar) do { unsigned _sp = 0; while (cond) { __builtin_amdgcn_s_sleep(1); \
    if ((++_sp & 255u) == 0u) { if (xb_ld(&(bar)[XB_TMO])) break; if (_sp > XB_SPIN_CAP) { atomicAdd(&(bar)[XB_TMO], 1u); break; } } } } while (0)

struct XcdBarrier {
    unsigned* bar; unsigned x;
    volatile LAS unsigned* st;
};

__device__ __forceinline__ XcdBarrier xcd_barrier_post(unsigned* bar, volatile LAS unsigned* st) {
    XcdBarrier b; b.bar = bar; b.x = xb_xcc_id(); b.st = st;
    if (threadIdx.x == 0) (void)xb_add(&bar[XB_XCNT(b.x)], 1u);
    return b;
}
__device__ __forceinline__ void xcd_barrier_complete(unsigned* bar, unsigned x, unsigned& nloc, unsigned& nx) {
    const unsigned G = gridDim.x * gridDim.y * gridDim.z;
    unsigned sum, cnt, mine, sp = 0u;
    for (;;) {
        sum = 0u; cnt = 0u; mine = 0u;
#pragma unroll
        for (unsigned j = 0; j < 16; ++j) { const unsigned c = xb_ld(&bar[XB_XCNT(j)]); sum += c; cnt += (c > 0u) ? 1u : 0u; mine = (j == x) ? c : mine; }
        if (sum == G) break;
        __builtin_amdgcn_s_sleep(1);
        if ((++sp & 255u) == 0u) { if (xb_ld(&bar[XB_TMO])) break; if (sp > XB_SPIN_CAP) { atomicAdd(&bar[XB_TMO], 1u); break; } }
    }
    nloc = mine > 0u ? mine : 1u; nx = cnt > 0u ? cnt : 1u;
}

__device__ __forceinline__ void xcd_barrier(const XcdBarrier& b) {
    asm volatile("s_waitcnt vmcnt(0)" ::: "memory");
    __syncthreads();
    if (threadIdx.x == 0) {
        unsigned* bar = b.bar;
        __builtin_amdgcn_s_waitcnt(0);
        unsigned nloc = b.st[0], nx = b.st[1];
        if (nloc == 0u) { xcd_barrier_complete(bar, b.x, nloc, nx); b.st[0] = nloc; b.st[1] = nx; }
        const unsigned old = xb_add(&bar[XB_XSUB(b.x)], 1u);
        const unsigned gen = old / nloc;
        if (old + 1u == (gen + 1u) * nloc) {
            __builtin_amdgcn_fence(__ATOMIC_RELEASE, "agent");
            asm volatile("s_waitcnt vmcnt(0)" ::: "memory");
            const unsigned og = xb_add(&bar[XB_TOP], 1u);
            const unsigned tg = og / nx;
            if (og + 1u == (tg + 1u) * nx) xb_add(&bar[XB_TOPGEN], 1u);
            else XB_SPIN(xb_ld(&bar[XB_TOPGEN]) == tg, bar);
            __builtin_amdgcn_fence(__ATOMIC_ACQUIRE, "agent");
            xb_add(&bar[XB_XGEN(b.x)], 1u);
            asm volatile("s_waitcnt vmcnt(0)" ::: "memory");
        } else {
            XB_SPIN(xb_ld(&bar[XB_XGEN(b.x)]) == gen, bar);
            __builtin_amdgcn_fence(__ATOMIC_ACQUIRE, "agent");
            asm volatile("s_waitcnt vmcnt(0)" ::: "memory");
        }
    }
    __syncthreads();
}

enum InIdx { I_X = 0, I_NORM_MIX = 1, I_NORM_FFN = 2, I_A_W_IN = 3, I_A_W_OUT = 4, I_A_ONORM = 5, I_LB = 6, I_KV_NORM = 7, I_W_KV = 8, I_K_NORM = 9,
             I_CPOS_K = 10, I_CW1_K = 11, I_CW2_K = 12, I_CPOS_V = 13, I_CW1_V = 14, I_CW2_V = 15, I_B_W_IN = 16, I_B_W_OUT = 17, I_B_QNORM = 18, I_REL_BIAS = 19,
             I_FFN_GU = 20, I_FFN_DN = 21, I_MOE_ROUTER = 22, I_MOE_GU = 23, I_MOE_DN = 24, N_IN = 25 };
struct Args { const float* in[N_IN]; float* out; unsigned char* ws; int ph_lo, ph_hi; };
struct Frame {
    LAS unsigned char* lds;
    volatile LAS unsigned* MISC;
    gu32* ctl;
    int tid, lane, wave;
    int vcu, G;
    unsigned char* ws; float* out;
};
__device__ __forceinline__ float wave_sum(float v) {
#pragma unroll
    for (int o = 1; o < 64; o <<= 1) v += __shfl_xor(v, o);
    return v;
}
__device__ __forceinline__ int rel_bucket(int d) {
    d = d < 0 ? 0 : d;
    if (d < 16) return d;
    const float v = logf((float)d / 16.0f) / 4.852030263919617f * 16.0f;
    int lg = 16 + (int)v; return lg < 31 ? lg : 31;
}
__device__ __forceinline__ float gelu_tanh(float x) { const float u = 0.7978845608028654f * (x + 0.044715f * x * x * x); return 0.5f * x * (1.0f + tanhf(u)); }

__device__ __forceinline__ void p0_transpose_item(const float* W, int ldw, int ncols, int K, bf16* WT, int dst_row0, LAS float* scr, int k0, int n0, int lane, const float* gain  ) {
    const int nn = n0 + 4 * (lane & 15); const bool ok = nn + 3 < ncols;
    f32x4 v[16];
#pragma unroll
    for (int i = 0; i < 16; ++i) { const int kk = 4 * i + (lane >> 4); v[i] = ok ? *(const GAS f32x4*)(W + (size_t)(k0 + kk) * ldw + nn) : (f32x4){0.f, 0.f, 0.f, 0.f}; }
#pragma unroll
    for (int i = 0; i < 16; ++i) { const int kk = 4 * i + (lane >> 4); const float gk = gain ? gain[k0 + kk] : 1.0f; LAS float* d = scr + kk * 65 + 4 * (lane & 15);
        d[0] = v[i].x * gk; d[1] = v[i].y * gk; d[2] = v[i].z * gk; d[3] = v[i].w * gk; }
    LDS_WAIT(); asm volatile("" ::: "memory");
#pragma unroll
    for (int i = 0; i < 8; ++i) { const int c = i * 64 + lane, n = c >> 3, kc = c & 7; const LAS float* s = scr + (8 * kc) * 65 + n;
        v4u o; o.x = pk2(s[0 * 65], s[1 * 65]); o.y = pk2(s[2 * 65], s[3 * 65]); o.z = pk2(s[4 * 65], s[5 * 65]); o.w = pk2(s[6 * 65], s[7 * 65]);
        *(GAS v4u*)(WT + (size_t)(dst_row0 + n) * K + k0 + 8 * kc) = o; }
    LDS_WAIT(); asm volatile("" ::: "memory");
}
__device__ __forceinline__ void p0_transpose_item_f8(const float* W, int ldw, int K, unsigned char* WT, int dst_row0, LAS float* scr, int k0, int n0, int lane, const float* gain) {
    const int nn = n0 + 4 * (lane & 15);
    f32x4 v[16];
#pragma unroll
    for (int i = 0; i < 16; ++i) { const int kk = 4 * i + (lane >> 4); v[i] = *(const GAS f32x4*)(W + (size_t)(k0 + kk) * ldw + nn); }
#pragma unroll
    for (int i = 0; i < 16; ++i) { const int kk = 4 * i + (lane >> 4); const float gk = (gain ? gain[k0 + kk] : 1.0f) * pg8::F8_WSCALE; LAS float* d = scr + kk * 65 + 4 * (lane & 15);
        d[0] = v[i].x * gk; d[1] = v[i].y * gk; d[2] = v[i].z * gk; d[3] = v[i].w * gk; }
    LDS_WAIT(); asm volatile("" ::: "memory");
#pragma unroll
    for (int i = 0; i < 4; ++i) { const int c = i * 64 + lane, n = c >> 2, kc = c & 3; const LAS float* s = scr + (16 * kc) * 65 + n;
        v4u o; o.x = pg8::pk4_fp8(s[0 * 65], s[1 * 65], s[2 * 65], s[3 * 65]); o.y = pg8::pk4_fp8(s[4 * 65], s[5 * 65], s[6 * 65], s[7 * 65]);
        o.z = pg8::pk4_fp8(s[8 * 65], s[9 * 65], s[10 * 65], s[11 * 65]); o.w = pg8::pk4_fp8(s[12 * 65], s[13 * 65], s[14 * 65], s[15 * 65]);
        *(GAS v4u*)(WT + (size_t)(dst_row0 + n) * K + k0 + 16 * kc) = o; }
    LDS_WAIT(); asm volatile("" ::: "memory");
}
template <int GU> __device__ __forceinline__ void p0_item_f8(const float* W, int ldw, int npad, int K, unsigned char* WT, LAS float* scr, int r, int lane, const float* gain) {
    const int nblk = npad / 64, kb = r / nblk, nb = r % nblk, n0 = 64 * nb;
    int dst = n0;
    if (GU) { if (n0 < GU) dst = 256 * (n0 / 128) + (n0 % 128); else { const int n1 = n0 - GU; dst = 256 * (n1 / 128) + 128 + (n1 % 128); } }
    p0_transpose_item_f8(W, ldw, K, WT, dst, scr, 64 * kb, n0, lane, gain);
}
template <int GU> __device__ __forceinline__ void p0_item(const float* W, int ldw, int ncols, int npad, int K, bf16* WT, LAS float* scr, int r, int lane, const float* gain = nullptr) {
    const int nblk = npad / 64, kb = r / nblk, nb = r % nblk, n0 = 64 * nb;
    int dst = n0;
    if (GU) { if (n0 < GU) dst = 256 * (n0 / 128) + (n0 % 128); else { const int n1 = n0 - GU; dst = 256 * (n1 / 128) + 128 + (n1 % 128); } }
    p0_transpose_item(W, ldw, ncols, K, WT, dst, scr, 64 * kb, n0, lane, gain);
}
__device__ __forceinline__ void rms_row_to_bf16(const float* xrow, const float* gain, bf16* orow, int lane) {
    const GAS f32x4* xr = (const GAS f32x4*)xrow + lane; const GAS f32x4* gr = (const GAS f32x4*)gain + lane;
    f32x4 v[4]; float s = 0.f;
#pragma unroll
    for (int j = 0; j < 4; ++j) { v[j] = xr[64 * j]; s += (v[j].x * v[j].x + v[j].y * v[j].y) + (v[j].z * v[j].z + v[j].w * v[j].w); }
    const float rstd = 1.0f / sqrtf(wave_sum(s) * (1.f / D) + NORM_EPS);
    GAS unsigned long long* o8 = (GAS unsigned long long*)orow + lane;
#pragma unroll
    for (int j = 0; j < 4; ++j) { const f32x4 gg = gain ? gr[64 * j] : (f32x4){1.f, 1.f, 1.f, 1.f}; o8[64 * j] = (unsigned long long)pk2(v[j].x * rstd * gg.x, v[j].y * rstd * gg.y) | ((unsigned long long)pk2(v[j].z * rstd * gg.z, v[j].w * rstd * gg.w) << 32); }
}
__device__ __forceinline__ void p0_prologue(Frame& F, const Args& a) {
    LAS float* scr = (LAS float*)(F.lds + RING_OFF + F.wave * 16640);
    const int gw = F.vcu * NWAVES + F.wave, NGW = F.G * NWAVES;
    unsigned char* ws = F.ws;
    constexpr int I1 = 16 * 64, I2 = 16 * 16, I3 = 16 * 88, I4 = 44 * 16, I5 = 16 * 24, I6 = 16 * 20, I7 = 16 * 16, I8 = 16 * 112, I9 = 56 * 16;
    constexpr int I10 = 32 * 4, I11 = 4 * 1;
    constexpr int NITEMS = I1 + I2 + I3 + I4 + I5 + I6 + I7 + NE * I8 + NE * I9 + 2 * I10 + 2 * I11;
    for (int it = gw; it < NITEMS; it += NGW) {
        int r = it;
        if (r < I1) { p0_item<0>(a.in[I_A_W_IN], NIN0, NIN0, NIN0, D, (bf16*)(ws + WS_W_IN0), scr, r, F.lane, a.in[I_NORM_MIX]); continue; } r -= I1;
        if (r < I2) { p0_item<0>(a.in[I_A_W_OUT], D, D, D, D, (bf16*)(ws + WS_W_OUT0), scr, r, F.lane); continue; } r -= I2;
        if (r < I3) { p0_item<FF>(a.in[I_FFN_GU], 2 * FF, 2 * FF, 2 * FF, D, (bf16*)(ws + WS_W_GU0), scr, r, F.lane, a.in[I_NORM_FFN]); continue; } r -= I3;
        if (r < I4) { p0_item<0>(a.in[I_FFN_DN], D, D, D, FF, (bf16*)(ws + WS_W_DN0), scr, r, F.lane); continue; } r -= I4;
        if (r < I5) { p0_item<0>(a.in[I_W_KV], NKV, NKV, NKV, D, (bf16*)(ws + WS_W_KV), scr, r, F.lane, a.in[I_KV_NORM]); continue; } r -= I5;
        if (r < I6) { p0_item<0>(a.in[I_B_W_IN], NQIN, NQIN, NQINP, D, (bf16*)(ws + WS_W_QIN), scr, r, F.lane, a.in[I_NORM_MIX] + D); continue; } r -= I6;
        if (r < I7) { p0_item<0>(a.in[I_B_W_OUT], D, D, D, D, (bf16*)(ws + WS_W_OUT1), scr, r, F.lane); continue; } r -= I7;
        if (r < NE * I8) { const int e = r / I8; p0_item_f8<EF>(a.in[I_MOE_GU] + (size_t)e * D * 2 * EF, 2 * EF, 2 * EF, D, (unsigned char*)(ws + WS_W_GU1) + (size_t)e * 2 * EF * D, scr, r % I8, F.lane, a.in[I_NORM_FFN] + D); continue; } r -= NE * I8;
        if (r < NE * I9) { const int e = r / I9; p0_item_f8<0>(a.in[I_MOE_DN] + (size_t)e * EF * D, D, D, EF, (unsigned char*)(ws + WS_W_DN1) + (size_t)e * D * EF, scr, r % I9, F.lane, nullptr); continue; } r -= NE * I9;
        if (r < 2 * I10) { const int kv = r / I10; p0_item<0>(a.in[kv ? I_CW1_V : I_CW1_K], 256, 256, 256, 2048, (bf16*)(ws + WS_W1T) + (size_t)kv * 256 * 2048, scr, r % I10, F.lane); continue; } r -= 2 * I10;
        { const int kv = r / I11; p0_item<0>(a.in[kv ? I_CW2_V : I_CW2_K], 64, 64, 64, 256, (bf16*)(ws + WS_W2T) + (size_t)kv * 64 * 256, scr, r % I11, F.lane); }
    }
    if (blockIdx.x == 0) {
        const float* lbp = a.in[I_LB]; float* lbv = (float*)(ws + WS_LB);
        for (int c = F.tid; c < D; c += NWAVES * 64) { const float p0 = lbp[c], p1 = lbp[D + c], mx = fmaxf(p0, p1), e0 = __expf(p0 - mx), e1 = __expf(p1 - mx); lbv[c] = e0 / (e0 + e1); }
    }
    if (blockIdx.x == 1) {
        const int kv = F.tid >> 8, hidx = F.tid & 255; const float* w1 = a.in[kv ? I_CW1_V : I_CW1_K]; const float* pos = a.in[kv ? I_CPOS_V : I_CPOS_K]; float s = 0.f;
        for (int kk = 0; kk < 2048; ++kk) s += pos[kk] * w1[(size_t)kk * 256 + hidx];
        ((float*)(ws + WS_PB))[kv * 256 + hidx] = s;
    }
    const float* x = a.in[I_X]; const float* gmix = a.in[I_NORM_MIX]; bf16* XN = (bf16*)(ws + WS_XN);
    for (int m = gw; m < M; m += NGW) rms_row_to_bf16(x + (size_t)m * D, nullptr, XN + (size_t)m * D, F.lane);
}


typedef float f32x16 __attribute__((ext_vector_type(16)));
typedef float f32x2v __attribute__((ext_vector_type(2)));
typedef __bf16 bf16x2v __attribute__((ext_vector_type(2)));
#define MFMA32(a, b, c) __builtin_amdgcn_mfma_f32_32x32x16_bf16((a), (b), (c), 0, 0, 0)
constexpr float LOG2E = 1.4426950408889634f;
constexpr size_t WS_QN = WS_R + 336 * MiB;
constexpr size_t WS_VTS = 8 * MiB;
constexpr size_t WS_VTW = WS_R + 368 * MiB;
constexpr size_t WS_KF = WS_R + 240 * MiB;
constexpr size_t WS_VF = WS_R + 248 * MiB;
constexpr size_t WS_KC16 = 2 * MiB;
constexpr size_t WS_VTC = 3 * MiB;
constexpr size_t WS_BLG = 3 * MiB + 512 * 1024;
static_assert(WS_QN + (size_t)M * D * 2 <= WS_VTW && WS_VTW + 8 * MiB <= WS_END && WS_OACC + (size_t)M * D * 4 <= WS_QN, "d_ws map (attention)");
__device__ __forceinline__ int perm16(int x) { const int g4 = (x >> 2) & 3; const int gp = (g4 == 1) ? 2 : ((g4 == 2) ? 1 : g4); return (gp << 2) | (x & 3); }
__device__ __forceinline__ unsigned cvtpk(float lo, float hi) { f32x2v v = {lo, hi}; bf16x2v b = __builtin_convertvector(v, bf16x2v); return __builtin_bit_cast(unsigned, b); }
__device__ __forceinline__ bf16x8 pack8(const f32x16& p, int s) { v4u w; w.x = cvtpk(p[8 * s], p[8 * s + 1]); w.y = cvtpk(p[8 * s + 2], p[8 * s + 3]); w.z = cvtpk(p[8 * s + 4], p[8 * s + 5]); w.w = cvtpk(p[8 * s + 6], p[8 * s + 7]); return __builtin_bit_cast(bf16x8, w); }
__device__ __forceinline__ bf16x8 ldg8(const bf16* p) { return *(const GAS bf16x8*)p; }


constexpr size_t WS_UT = WS_O0;
constexpr size_t WS_ST = WS_ACT;
constexpr size_t WS_DEC = 2 * MiB;
constexpr int HG_SEG = 0, HG_AP = 2048, HG_AQ = HG_AP + 64 * 136 * 2, HG_BP = HG_AQ + 64 * 136 * 2, HG_VT = HG_BP + 64 * 136 * 2, HG_KDT = HG_VT + 128 * 72 * 2, HG_PS = HG_KDT + 128 * 72 * 2;
static_assert(HG_PS + 1024 <= RING_BYTES, "HGRN2 LDS map");
__device__ __forceinline__ void hg_gates_raw(const unsigned short (&rf)[16], float lb, LAS float* SEG, int d, int seg, float (&kk)[16], float (&bb)[16], float& b31, float& blast) {
    float acc = 0.f;
#pragma unroll
    for (int u = 0; u < 16; ++u) { const float f = bf2f(rf[u]); const float g = lb + (1.f - lb) * sigmoid_f(f); kk[u] = 1.f - g; acc += __logf(g); bb[u] = acc; }
    SEG[seg * 128 + d] = acc;
    __syncthreads();
    const float s0 = SEG[d], s1 = SEG[128 + d], s2 = SEG[256 + d], s3 = SEG[384 + d];
    const float pre = seg == 0 ? 0.f : (seg == 1 ? s0 : (seg == 2 ? s0 + s1 : s0 + s1 + s2));
    b31 = s0 + s1; blast = (s0 + s1) + (s2 + s3);
#pragma unroll
    for (int u = 0; u < 16; ++u) bb[u] += pre;
}
__device__ __forceinline__ void p_hg_a(Frame& F) {
    const bf16* QFIG = (const bf16*)(F.ws + WS_QFIG); bf16* UT = (bf16*)(F.ws + WS_UT); float* DEC = (float*)(F.ws + WS_DEC); const float* lbv = (const float*)(F.ws + WS_LB);
    LAS float* SEG = (LAS float*)(F.lds + HG_SEG); LAS unsigned short* VT = (LAS unsigned short*)(F.lds + HG_VT); LAS unsigned short* KDT = (LAS unsigned short*)(F.lds + HG_KDT);
    const int tid = F.tid, lane = F.lane, w = F.wave, d = tid & 127, seg = tid >> 7, l31 = lane & 31, hi = lane >> 5;
    unsigned short rf[16], rv[16];
#define HA_LOAD_RAW(un) do { const int bh_ = (un) >> 7, j_ = (un) & 127; const bf16* r0_ = QFIG + (size_t)((bh_ >> 3) * T + 64 * j_ + 16 * seg) * NIN0 + (bh_ & 7) * 128 + d; \
        _Pragma("unroll") for (int u = 0; u < 16; ++u) { rf[u] = r0_[(size_t)u * NIN0 + D]; rv[u] = r0_[(size_t)u * NIN0 + 2 * D]; } } while (0)
    const int nunits = BATCH * HG_H * (T / 64);
    if (F.vcu < nunits) HA_LOAD_RAW(F.vcu);
    for (int unit = F.vcu; unit < nunits; unit += F.G) {
        const int bh = unit >> 7, h = bh & 7;
        float kk[16], bb[16], b31, blast;
        __syncthreads();
        hg_gates_raw(rf, lbv[h * 128 + d], SEG, d, seg, kk, bb, b31, blast);
#pragma unroll
        for (int u = 0; u < 16; ++u) { KDT[d * 72 + 16 * seg + u] = (unsigned short)f2bf(kk[u] * __expf(blast - bb[u])); VT[d * 72 + 16 * seg + u] = rv[u]; }
        if (seg == 3) DEC[(size_t)unit * 128 + d] = __expf(blast);
        if (unit + F.G < nunits) HA_LOAD_RAW(unit + F.G);
        __syncthreads();
        const int et = w >> 1;
#pragma unroll
        for (int dd = 0; dd < 2; ++dd) { const int dt = (w & 1) * 2 + dd; f32x16 c = (f32x16){0.f,0.f,0.f,0.f,0.f,0.f,0.f,0.f,0.f,0.f,0.f,0.f,0.f,0.f,0.f,0.f};
#pragma unroll
            for (int ks = 0; ks < 4; ++ks) { const bf16x8 av = *(const LAS bf16x8*)(VT + (32 * et + l31) * 72 + 16 * ks + 8 * hi), bv = *(const LAS bf16x8*)(KDT + (32 * dt + l31) * 72 + 16 * ks + 8 * hi); c = MFMA32(av, bv, c); }
            bf16* up = UT + ((size_t)unit * 128 + 32 * et + 4 * hi) * 128 + 32 * dt + l31;
#pragma unroll
            for (int r = 0; r < 16; ++r) up[(size_t)((r & 3) + 8 * (r >> 2)) * 128] = (bf16)f2bf(c[r]); }
    }
#undef HA_LOAD_RAW
}
__device__ __forceinline__ void p_hg_b(Frame& F) {
    const unsigned* UT = (const unsigned*)(F.ws + WS_UT); unsigned* ST = (unsigned*)(F.ws + WS_ST); const float* DEC = (const float*)(F.ws + WS_DEC);
    const int gt = F.vcu * (NWAVES * 64) + F.tid, NT = F.G * NWAVES * 64;
    for (int idx = gt; idx < BATCH * HG_H * 128 * 64; idx += NT) {
        const int bh = idx >> 13, e = (idx >> 6) & 127, dp = idx & 63;
        float s0 = 0.f, s1 = 0.f;
        size_t off = ((size_t)(bh * 128) * 128 + e) * 64 + dp;
        const float* dc = DEC + (size_t)(bh * 128) * 128 + 2 * dp;
        for (int j0 = 0; j0 < 128; j0 += 8) {
            unsigned uu[8]; f32x2v dd[8];
#pragma unroll
            for (int k = 0; k < 8; ++k) { uu[k] = UT[off + (size_t)(j0 + k) * 128 * 64]; dd[k] = *(const GAS f32x2v*)(dc + (size_t)(j0 + k) * 128); }
#pragma unroll
            for (int k = 0; k < 8; ++k) { ST[off + (size_t)(j0 + k) * 128 * 64] = pk2(s0, s1); s0 = dd[k].x * s0 + bflo(uu[k]); s1 = dd[k].y * s1 + bfhi(uu[k]); }
        }
    }
}
__device__ __forceinline__ void p_hg_c(Frame& F, const float* gon) {
    const bf16* QFIG = (const bf16*)(F.ws + WS_QFIG); const bf16* ST = (const bf16*)(F.ws + WS_ST); bf16* OG = (bf16*)(F.ws + WS_OG); const float* lbv = (const float*)(F.ws + WS_LB);
    LAS float* SEG = (LAS float*)(F.lds + HG_SEG); LAS unsigned short* AP = (LAS unsigned short*)(F.lds + HG_AP); LAS unsigned short* AQ = (LAS unsigned short*)(F.lds + HG_AQ);
    LAS unsigned short* BP = (LAS unsigned short*)(F.lds + HG_BP); LAS unsigned short* VT = (LAS unsigned short*)(F.lds + HG_VT); LAS float* PS = (LAS float*)(F.lds + HG_PS);
    const int tid = F.tid, lane = F.lane, w = F.wave, d = tid & 127, seg = tid >> 7, l31 = lane & 31, hi = lane >> 5;
    const int st = w & 1, et = w >> 1;
    unsigned short rq[16], rf[16], rv[16]; bf16x8 sfr[8];
#define HC_LOAD_RAW(un) do { const int bh_ = (un) >> 7, j_ = (un) & 127; const bf16* r0_ = QFIG + (size_t)((bh_ >> 3) * T + 64 * j_ + 16 * seg) * NIN0 + (bh_ & 7) * 128 + d; \
        _Pragma("unroll") for (int u = 0; u < 16; ++u) { rq[u] = r0_[(size_t)u * NIN0]; rf[u] = r0_[(size_t)u * NIN0 + D]; rv[u] = r0_[(size_t)u * NIN0 + 2 * D]; } } while (0)
#define HC_LOAD_ST(un) do { const bf16* sp_ = ST + ((size_t)(un) * 128 + 32 * et + l31) * 128 + 8 * hi; _Pragma("unroll") for (int ks = 0; ks < 8; ++ks) sfr[ks] = ldg8(sp_ + 16 * ks); } while (0)
    const int nunits = BATCH * HG_H * (T / 64);
    if (F.vcu < nunits) { HC_LOAD_RAW(F.vcu); HC_LOAD_ST(F.vcu); }
    for (int unit = F.vcu; unit < nunits; unit += F.G) {
        const int bh = unit >> 7, j = unit & 127, b = bh >> 3, h = bh & 7;
        float kk[16], bb[16], b31, blast;
        __syncthreads();
        hg_gates_raw(rf, lbv[h * 128 + d], SEG, d, seg, kk, bb, b31, blast);
        const float eb31 = __expf(b31);
#pragma unroll
        for (int u = 0; u < 16; ++u) { const int tok = 16 * seg + u; const float q = bf2f(rq[u]);
            const float er = __expf(bb[u] - b31);
            AP[tok * 136 + d] = (unsigned short)f2bf(q * er); AQ[tok * 136 + d] = (unsigned short)f2bf(q * er * eb31);
            BP[tok * 136 + d] = (unsigned short)f2bf(kk[u] * __builtin_amdgcn_rcpf(er)); VT[d * 72 + 16 * seg + perm16(u)] = rv[u]; }
        if (unit + F.G < nunits) HC_LOAD_RAW(unit + F.G);
        __syncthreads();
        f32x16 o = (f32x16){0.f,0.f,0.f,0.f,0.f,0.f,0.f,0.f,0.f,0.f,0.f,0.f,0.f,0.f,0.f,0.f};
#pragma unroll
        for (int ks = 0; ks < 8; ++ks) { const bf16x8 bv = *(const LAS bf16x8*)(AQ + (32 * st + l31) * 136 + 16 * ks + 8 * hi); o = MFMA32(sfr[ks], bv, o); }
        if (unit + F.G < nunits) HC_LOAD_ST(unit + F.G);
        for (int ut = 0; ut <= st; ++ut) { f32x16 at = (f32x16){0.f,0.f,0.f,0.f,0.f,0.f,0.f,0.f,0.f,0.f,0.f,0.f,0.f,0.f,0.f,0.f};
#pragma unroll
            for (int ks = 0; ks < 8; ++ks) { const bf16x8 av = *(const LAS bf16x8*)(BP + (32 * ut + l31) * 136 + 16 * ks + 8 * hi), bv = *(const LAS bf16x8*)(AP + (32 * st + l31) * 136 + 16 * ks + 8 * hi); at = MFMA32(av, bv, at); }
            if (ut == st) {
#pragma unroll
                for (int r = 0; r < 16; ++r) at[r] = ((r & 3) + 8 * (r >> 2) + 4 * hi <= l31) ? at[r] : 0.f; }
            const bf16x8 pb0 = pack8(at, 0), pb1 = pack8(at, 1);
            const bf16x8 v0 = *(const LAS bf16x8*)(VT + (32 * et + l31) * 72 + 32 * ut + 8 * hi), v1 = *(const LAS bf16x8*)(VT + (32 * et + l31) * 72 + 32 * ut + 16 + 8 * hi);
            o = MFMA32(v0, pb0, o); o = MFMA32(v1, pb1, o); }
        float ss = 0.f;
#pragma unroll
        for (int r = 0; r < 16; ++r) ss += o[r] * o[r];
        ss += __shfl_xor(ss, 32);
        if (hi == 0) PS[et * 64 + 32 * st + l31] = ss;
        __syncthreads();
        const int s = 32 * st + l31; const float tot = (PS[s] + PS[64 + s]) + (PS[128 + s] + PS[192 + s]);
        const float rstd = 1.0f / sqrtf(tot * (1.f / 128.f) + NORM_EPS);
        const size_t mrow = (size_t)b * T + 64 * j + s;
        const bf16* gp = QFIG + mrow * NIN0 + 3 * D + h * 128 + 32 * et + 4 * hi; bf16* op = OG + mrow * D + h * 128 + 32 * et + 4 * hi; const float* gop = gon + 32 * et + 4 * hi;
#pragma unroll
        for (int q4 = 0; q4 < 4; ++q4) { const unsigned long long gw8 = *(const GAS unsigned long long*)(gp + 8 * q4); const unsigned glo = (unsigned)gw8, ghi = (unsigned)(gw8 >> 32); const f32x4 go = *(const GAS f32x4*)(gop + 8 * q4);
            const float a0 = bflo(glo), a1 = bfhi(glo), a2 = bflo(ghi), a3 = bfhi(ghi);
            const float y0 = o[4 * q4] * rstd * go.x * (a0 * sigmoid_f(a0)), y1 = o[4 * q4 + 1] * rstd * go.y * (a1 * sigmoid_f(a1)), y2 = o[4 * q4 + 2] * rstd * go.z * (a2 * sigmoid_f(a2)), y3 = o[4 * q4 + 3] * rstd * go.w * (a3 * sigmoid_f(a3));
            *(GAS unsigned long long*)(op + 8 * q4) = (unsigned long long)cvtpk(y0, y1) | ((unsigned long long)cvtpk(y2, y3) << 32); }
    }
}

__device__ __forceinline__ void p_knorm(Frame& F, const float* kng) {
    bf16* KV = (bf16*)(F.ws + WS_KV);
    const int gt = F.vcu * (NWAVES * 64) + F.tid, NT = F.G * NWAVES * 64;
    for (int idx = gt; idx < M * 8; idx += NT) {
        const int m = idx >> 3, j = idx & 7; const int col0 = j < 4 ? 512 + 64 * j : 1024 + 64 * (j - 4); const float* gain = kng + (j < 4 ? 64 : 128);
        GAS v4u* p = (GAS v4u*)(KV + (size_t)m * NKV + col0);
        v4u w[8]; float ss = 0.f;
#pragma unroll
        for (int i = 0; i < 8; ++i) { w[i] = p[i];
#pragma unroll
            for (int k = 0; k < 4; ++k) { const float a = bflo(w[i][k]), b = bfhi(w[i][k]); ss += a * a + b * b; } }
        const float rstd = 1.0f / sqrtf(ss * (1.f / 64.f) + NORM_EPS);
#pragma unroll
        for (int i = 0; i < 8; ++i) { v4u o;
#pragma unroll
            for (int k = 0; k < 4; ++k) o[k] = pk2(bflo(w[i][k]) * rstd * gain[8 * i + 2 * k], bfhi(w[i][k]) * rstd * gain[8 * i + 2 * k + 1]);
            p[i] = o;
            if (j < 4) { const int bq = m >> 13, tq = m & (T - 1);
                ((v4u*)(F.ws + WS_KF))[(size_t)((((bq * 4 + j) * 128 + (tq >> 6)) * 2 + ((tq >> 5) & 1)) * 4 + (i >> 1)) * 64 + (i & 1) * 32 + (tq & 31)] = o; } }
    }
}
__device__ __forceinline__ void p_route(Frame& F, const Args& a, bool dry = false) {
    const float* H3 = F.out; const float* gain = a.in[I_NORM_FFN] + D; const float* wr = a.in[I_MOE_ROUTER];
    unsigned* route = (unsigned*)(F.ws + WS_ROUTE); gu32* ecnt = F.ctl + CW_ECNT;
    const int gw = F.vcu * NWAVES + F.wave, NGW = F.G * NWAVES;
    for (int m = gw; m < M; m += NGW) {
        const GAS f32x4* xr = (const GAS f32x4*)(H3 + (size_t)m * D) + F.lane; const GAS f32x4* gr = (const GAS f32x4*)gain + F.lane;
        f32x4 v[4]; float s = 0.f;
#pragma unroll
        for (int j = 0; j < 4; ++j) { v[j] = xr[64 * j]; s += (v[j].x * v[j].x + v[j].y * v[j].y) + (v[j].z * v[j].z + v[j].w * v[j].w); }
        const float rstd = 1.0f / sqrtf(wave_sum(s) * (1.f / D) + NORM_EPS);
        float lg[8];
#pragma unroll
        for (int e = 0; e < 8; ++e) lg[e] = 0.f;
#pragma unroll
        for (int j = 0; j < 4; ++j) { const f32x4 gg = gr[64 * j]; const f32x4 y = (f32x4){v[j].x * rstd * gg.x, v[j].y * rstd * gg.y, v[j].z * rstd * gg.z, v[j].w * rstd * gg.w};
            const GAS f32x4* wp = (const GAS f32x4*)(wr + (size_t)(256 * j + 4 * F.lane) * 8);
#pragma unroll
            for (int k = 0; k < 4; ++k) { const f32x4 w0 = wp[2 * k], w1 = wp[2 * k + 1]; const float yk = y[k];
                lg[0] += yk * w0.x; lg[1] += yk * w0.y; lg[2] += yk * w0.z; lg[3] += yk * w0.w; lg[4] += yk * w1.x; lg[5] += yk * w1.y; lg[6] += yk * w1.z; lg[7] += yk * w1.w; } }
#pragma unroll
        for (int e = 0; e < 8; ++e) lg[e] = wave_sum(lg[e]);
        if (dry) continue;
        int e0 = 0; float v0 = lg[0];
#pragma unroll
        for (int e = 1; e < 8; ++e) if (lg[e] > v0) { v0 = lg[e]; e0 = e; }
        int e1 = -1; float v1 = -3.0e38f;
#pragma unroll
        for (int e = 0; e < 8; ++e) if (e != e0 && lg[e] > v1) { v1 = lg[e]; e1 = e; }
        const float w0 = 1.0f / (1.0f + __expf(v1 - v0)), w1 = 1.0f - w0;
        unsigned p0 = 0u, p1 = 0u;
        if (F.lane == 0) { p0 = __hip_atomic_fetch_add(ecnt + e0, 1u, RLX_AGENT); p1 = __hip_atomic_fetch_add(ecnt + e1, 1u, RLX_AGENT);
            unsigned* r = route + (size_t)m * 8; r[0] = (unsigned)e0; r[1] = (unsigned)e1; r[2] = p0; r[3] = p1; r[4] = __float_as_uint(w0); r[5] = __float_as_uint(w1);
            float* rse = (float*)(F.ws + WS_RS_E); rse[(size_t)e0 * M + p0] = rstd; rse[(size_t)e1 * M + p1] = rstd; }
        p0 = (unsigned)__builtin_amdgcn_readfirstlane((int)p0); p1 = (unsigned)__builtin_amdgcn_readfirstlane((int)p1);
        unsigned char* x0 = (unsigned char*)(F.ws + WS_XG8) + ((size_t)e0 * M + p0) * D, *x1 = (unsigned char*)(F.ws + WS_XG8) + ((size_t)e1 * M + p1) * D;
#pragma unroll
        for (int j = 0; j < 4; ++j) { const unsigned w8 = pg8::pk4_fp8(v[j].x, v[j].y, v[j].z, v[j].w); ((GAS unsigned*)(x0 + 256 * j))[F.lane] = w8; ((GAS unsigned*)(x1 + 256 * j))[F.lane] = w8; }
    }
}
struct MoeOrder {
    int cn[8]; int ncol, G, c; bool apm;
    __device__ __forceinline__ void init(const gu32* cnt, int ncol_, int G_, int c_, bool apm_) { ncol = ncol_; G = G_; c = c_; apm = apm_;
#pragma unroll
        for (int e = 0; e < 8; ++e) cn[e] = __builtin_amdgcn_readfirstlane((int)__hip_atomic_load(cnt + e, RLX_AGENT)); }
    __device__ __forceinline__ bool next(int i, pg8::Unit& u) const {
        const int L = i * G + c; int base = 0, tiles = 0; bool found = false;
#pragma unroll
        for (int e = 0; e < 8; ++e) { const int n = (cn[e] + 255) >> 8; const int units = n * ncol;
            if (!found && L < base + units) { found = true; const int r = L - base; u.pnl = r / n; const int rt = r - u.pnl * n; u.pm = tiles + rt; u.pn = e * ncol + u.pnl; u.pa = apm ? e * (M / 256) + rt : u.pm; u.nv = cn[e] - 256 * rt; }
            base += units; tiles += n; }
        return found;
    }
};

__device__ __forceinline__ void p_moe_combine(Frame& F) {
    const unsigned* route = (const unsigned*)(F.ws + WS_ROUTE); const bf16* Y = (const bf16*)(F.ws + WS_Y2); float* out = F.out;
    const int gw = F.vcu * NWAVES + F.wave, NGW = F.G * NWAVES;
    int off[9]; off[0] = 0;
#pragma unroll
    for (int e = 0; e < 8; ++e) off[e + 1] = off[e] + (((int)__hip_atomic_load(F.ctl + CW_ECNT + e, RLX_AGENT) + 255) & ~255);
    for (int m = gw; m < M; m += NGW) { const unsigned* r = route + (size_t)m * 8; const float w0 = __uint_as_float(r[4]), w1 = __uint_as_float(r[5]); const int e0 = (int)r[0], e1 = (int)r[1];
        int o0 = 0, o1 = 0;
#pragma unroll
        for (int e = 0; e < 8; ++e) { o0 = (e == e0) ? off[e] : o0; o1 = (e == e1) ? off[e] : o1; }
        const int s0 = o0 + (int)r[2], s1 = o1 + (int)r[3];
        GAS f32x4* o = (GAS f32x4*)(out + (size_t)m * D) + F.lane;
        const GAS unsigned long long* y0 = (const GAS unsigned long long*)(Y + (size_t)s0 * D) + F.lane; const GAS unsigned long long* y1 = (const GAS unsigned long long*)(Y + (size_t)s1 * D) + F.lane;
#pragma unroll
        for (int j = 0; j < 4; ++j) { f32x4 v = o[64 * j]; const unsigned long long a = y0[64 * j], b = y1[64 * j];
            v.x += w0 * bflo((unsigned)a) + w1 * bflo((unsigned)b); v.y += w0 * bfhi((unsigned)a) + w1 * bfhi((unsigned)b);
            v.z += w0 * bflo((unsigned)(a >> 32)) + w1 * bflo((unsigned)(b >> 32)); v.w += w0 * bfhi((unsigned)(a >> 32)) + w1 * bfhi((unsigned)(b >> 32));
            o[64 * j] = v; } }
}

__device__ __forceinline__ void p_compress_mfma(Frame& F, const float* kng0) {
    const bf16* KV = (const bf16*)(F.ws + WS_KV); const bf16* W1T = (const bf16*)(F.ws + WS_W1T); const bf16* W2T = (const bf16*)(F.ws + WS_W2T); const float* PB = (const float*)(F.ws + WS_PB);
    LAS unsigned short* TK = (LAS unsigned short*)(F.lds);
    LAS unsigned short* HD = TK + 528 * 72;
    const int tid = F.tid, lane = F.lane, w = F.wave, l31 = lane & 31, hi = lane >> 5;
    for (int unit = F.vcu; unit < 256; unit += F.G) {
        const int kvsel = unit >> 7, bg = (unit >> 4) & 7, rg = unit & 15, n0 = 32 * rg, b = bg >> 2, g = bg & 3;
        const int col0 = kvsel * 256 + g * 64;
        __syncthreads();
        for (int c = tid; c < 528 * 8; c += NWAVES * 64) { const int row = c >> 3, part = c & 7; int tok = 16 * n0 + row; tok = tok < T ? tok : T - 1;
            const v4u val = *(const GAS v4u*)(KV + (size_t)(b * T + tok) * NKV + col0 + 8 * part);
            *(LAS v4u*)(TK + ((row & 15) * 33 + (row >> 4)) * 72 + 8 * part) = val; }
        __syncthreads();
        f32x16 acc = (f32x16){0.f,0.f,0.f,0.f,0.f,0.f,0.f,0.f,0.f,0.f,0.f,0.f,0.f,0.f,0.f,0.f};
        const bf16* bp = W1T + (size_t)(kvsel * 256 + 32 * w + l31) * 2048 + 8 * hi;
        for (int k0 = 0; k0 < 128; k0 += 16) { bf16x8 bv[16];
#pragma unroll
            for (int i = 0; i < 16; ++i) bv[i] = ldg8(bp + 16 * (k0 + i));
#pragma unroll
            for (int i = 0; i < 16; ++i) { const int ks = k0 + i, j = ks >> 2, d0 = 16 * (ks & 3) + 8 * hi;
                const bf16x8 av = *(const LAS bf16x8*)(TK + ((j & 15) * 33 + l31 + (j >> 4)) * 72 + d0);   acc = MFMA32(av, bv[i], acc); } }
        { const float pb = PB[kvsel * 256 + 32 * w + l31];
#pragma unroll
          for (int r = 0; r < 16; ++r) HD[((r & 3) + 8 * (r >> 2) + 4 * hi) * 264 + 32 * w + l31] = (unsigned short)f2bf(gelu_tanh(acc[r] + pb)); }
        __syncthreads();
        if (w == 0) {
            f32x16 c2[2]; c2[0] = (f32x16){0.f,0.f,0.f,0.f,0.f,0.f,0.f,0.f,0.f,0.f,0.f,0.f,0.f,0.f,0.f,0.f}; c2[1] = c2[0];
#pragma unroll
            for (int mt = 0; mt < 2; ++mt) { const bf16* ap = W2T + (size_t)(kvsel * 64 + 32 * mt + l31) * 256 + 8 * hi;
#pragma unroll
                for (int ks = 0; ks < 16; ++ks) { const bf16x8 av = ldg8(ap + 16 * ks), bv = *(const LAS bf16x8*)(HD + l31 * 264 + 16 * ks + 8 * hi); c2[mt] = MFMA32(av, bv, c2[mt]); } }
            const int n = n0 + l31; const bool ok = n < NCMP;
            if (kvsel == 0) { float ss = 0.f;
#pragma unroll
                for (int mt = 0; mt < 2; ++mt)
#pragma unroll
                    for (int r = 0; r < 16; ++r) ss += c2[mt][r] * c2[mt][r];
                ss += __shfl_xor(ss, 32);
                const float rstd = ok ? 1.0f / sqrtf(ss * (1.f / 64.f) + NORM_EPS) : 0.f;
                bf16* kp = (bf16*)(F.ws + WS_KC16) + (size_t)(bg * NCMPP + n) * 64 + 4 * hi;
#pragma unroll
                for (int mt = 0; mt < 2; ++mt)
#pragma unroll
                    for (int q4 = 0; q4 < 4; ++q4) { const f32x4 gg = *(const GAS f32x4*)(kng0 + 32 * mt + 8 * q4 + 4 * hi);
                        *(GAS unsigned long long*)(kp + 32 * mt + 8 * q4) = (unsigned long long)cvtpk(c2[mt][4 * q4] * rstd * gg.x, c2[mt][4 * q4 + 1] * rstd * gg.y) | ((unsigned long long)cvtpk(c2[mt][4 * q4 + 2] * rstd * gg.z, c2[mt][4 * q4 + 3] * rstd * gg.w) << 32); }
            } else { bf16* vp = (bf16*)(F.ws + WS_VTC) + (size_t)(bg * 64 + 4 * hi) * NCMPP + (n & ~15) + perm16(n & 15);
#pragma unroll
                for (int mt = 0; mt < 2; ++mt)
#pragma unroll
                    for (int r = 0; r < 16; ++r) vp[(size_t)(32 * mt + (r & 3) + 8 * (r >> 2)) * NCMPP] = (bf16)f2bf(ok ? c2[mt][r] : 0.f); }
        }
    }
}
__device__ __forceinline__ void p_qnorm(Frame& F, const float* gq) {
    const bf16* QG = (const bf16*)(F.ws + WS_QG); bf16* QN = (bf16*)(F.ws + WS_QN);
    const int gt = F.vcu * (NWAVES * 64) + F.tid, NT = F.G * NWAVES * 64;
    for (int idx = gt; idx < M * NH; idx += NT) { const int m = idx >> 4, h = idx & 15;
        const GAS v4u* p = (const GAS v4u*)(QG + (size_t)m * NQINP + h * 64); GAS v4u* o = (GAS v4u*)(QN + (size_t)m * D + h * 64);
        v4u w[8]; float ss = 0.f;
#pragma unroll
        for (int i = 0; i < 8; ++i) { w[i] = p[i];
#pragma unroll
            for (int k = 0; k < 4; ++k) { const float x0 = bflo(w[i][k]), x1 = bfhi(w[i][k]); ss += x0 * x0 + x1 * x1; } }
        const float rs = (0.125f * LOG2E) / sqrtf(ss * (1.f / 64.f) + NORM_EPS);
#pragma unroll
        for (int i = 0; i < 8; ++i) { v4u r;
#pragma unroll
            for (int k = 0; k < 4; ++k) r[k] = cvtpk(bflo(w[i][k]) * rs * gq[8 * i + 2 * k], bfhi(w[i][k]) * rs * gq[8 * i + 2 * k + 1]);
            o[i] = r; } }
}
__device__ __forceinline__ void p_vtrans(Frame& F) {
    const bf16* KV = (const bf16*)(F.ws + WS_KV);
    LAS unsigned short* scr = (LAS unsigned short*)(F.lds + F.wave * 8192);
    const int gw = F.vcu * NWAVES + F.wave, NGW = F.G * NWAVES, lane = F.lane;
    for (int item = gw; item < 2 * 8 * (T / 64); item += NGW) {
        const int which = item >> 10, bg = (item >> 7) & 7, tile = item & 127, b = bg >> 2, g = bg & 3;
        const GAS v4u* p = (const GAS v4u*)(KV + (size_t)(b * T + 64 * tile + lane) * NKV + (which ? 1280 : 768) + 64 * g);
        const int posn = (lane & ~15) + perm16(lane & 15);
#pragma unroll
        for (int i = 0; i < 8; ++i) { const v4u w = p[i];
#pragma unroll
            for (int k = 0; k < 4; ++k) { scr[(8 * i + 2 * k) * 64 + posn] = (unsigned short)(w[k] & 0xffffu); scr[(8 * i + 2 * k + 1) * 64 + posn] = (unsigned short)(w[k] >> 16); } }
        LDS_WAIT(); asm volatile("" ::: "memory");
        bf16* VT = (bf16*)(F.ws + (which ? WS_VTW : WS_VTS));
        GAS v4u* o = (GAS v4u*)(VT + (size_t)(bg * 64 + lane) * T + 64 * tile); const LAS v4u* s = (const LAS v4u*)(scr + lane * 64);
#pragma unroll
        for (int i = 0; i < 8; ++i) o[i] = s[i];
        if (which == 0) { v4u* VF = (v4u*)(F.ws + WS_VF);
#pragma unroll
            for (int i = 0; i < 8; ++i) VF[(size_t)(((((bg * 128 + tile) * 2 + (i >> 2)) * 2 + (lane >> 5)) * 2 + ((i >> 1) & 1)) * 64) + (i & 1) * 32 + (lane & 31)] = s[i]; }
        LDS_WAIT(); asm volatile("" ::: "memory");
    }
}

__device__ __forceinline__ void p_biaslut(Frame& F, const float* relb) {
    float* BLG = (float*)(F.ws + WS_BLG);
    const int gt = F.vcu * (NWAVES * 64) + F.tid, NT = F.G * NWAVES * 64;
    for (int idx = gt; idx < NH * 2048; idx += NT) { const int h = idx >> 11, d = idx & 2047; BLG[idx] = relb[rel_bucket(d) * NH + h] * LOG2E; }
}

template <int MASK, int DS> __device__ __forceinline__ float st_softmax(f32x16& st, int dbase, const LAS float* blp, float scale) {
    float l = 0.f; asm volatile("" : "+v"(dbase));
#pragma unroll
    for (int r = 0; r < 16; ++r) { const int d = dbase - DS * ((r & 3) + 8 * (r >> 2)); int di = d < 0 ? 0 : d; di = di > 2047 ? 2047 : di;
        float e = __builtin_amdgcn_exp2f(st[r] + blp[di]) * scale;
        if (MASK == 1) e = d >= 0 ? e : 0.f;
        if (MASK == 2) e = (d >= 0 && d < WIN) ? e : 0.f;
        st[r] = e; l += e; }
    return l;
}
template <int DS> __device__ __forceinline__ float st_softmax_in(f32x16& st, int dbase, const LAS float* blp, float scale) {
    float l = 0.f; const LAS float* bp = blp + (dbase - 27 * DS); asm volatile("" : "+v"(bp));
#pragma unroll
    for (int r = 0; r < 16; ++r) { const float e = __builtin_amdgcn_exp2f(st[r] + bp[(27 - ((r & 3) + 8 * (r >> 2))) * DS]) * scale; st[r] = e; l += e; }
    return l;
}
constexpr float OFIX = 1024.0f, LFIX = 256.0f;
#ifndef REP_SUB
#define REP_SUB 0
#endif
#define SUBREP(k) for (int rep_ = 0; rep_ < (REP_SUB == (k) ? 2 : 1); ++rep_) if (const float rs_ = rep_ ? 0.f : 1.f; true)
__device__ __forceinline__ float st_softmax_far(f32x16& st, float cb, float scale) {
    float l = 0.f;
#pragma unroll
    for (int r = 0; r < 16; ++r) { const float e = __builtin_amdgcn_exp2f(st[r] + cb) * scale; st[r] = e; l += e; }
    return l;
}
#define DENSE_STK(buf) (*(LAS v4u*)(KT + (buf) * 4608 + (tio >> 3) * 72 + 8 * (tio & 7)) = kreg)
#define DENSE_STV(buf) (*(LAS v4u*)(VTT + (buf) * 4608 + (tio >> 3) * 72 + 8 * (tio & 7)) = vreg)
#define DENSE_LDK(kf, buf, sub) do { _Pragma("unroll") for (int _k = 0; _k < 4; ++_k) kf[_k] = *(const LAS bf16x8*)(KT + (buf) * 4608 + (32 * (sub) + (lane & 31)) * 72 + 16 * _k + 8 * hi); } while (0)
#define DENSE_LDV(vf, buf, sub) do { _Pragma("unroll") for (int _m = 0; _m < 2; ++_m) _Pragma("unroll") for (int _s = 0; _s < 2; ++_s) vf[_m][_s] = *(const LAS bf16x8*)(VTT + (buf) * 4608 + (32 * _m + (lane & 31)) * 72 + 32 * (sub) + 16 * _s + 8 * hi); } while (0)
#define NSA_LDK(kf, base) do { _Pragma("unroll") for (int _k = 0; _k < 4; ++_k) kf[_k] = ldg8((base) + 16 * _k); } while (0)
#define NSA_QK(st, kf, qf) do { st = (f32x16){0.f,0.f,0.f,0.f,0.f,0.f,0.f,0.f,0.f,0.f,0.f,0.f,0.f,0.f,0.f,0.f}; _Pragma("unroll") for (int _k = 0; _k < 4; ++_k) st = MFMA32(kf[_k], qf[_k], st); } while (0)

__device__ __forceinline__ void p_nsa(Frame& F, const Args& a) {
    const bf16* QN = (const bf16*)(F.ws + WS_QN); const bf16* QG = (const bf16*)(F.ws + WS_QG); const bf16* KV = (const bf16*)(F.ws + WS_KV);
    const bf16* KC = (const bf16*)(F.ws + WS_KC16); const bf16* VTC = (const bf16*)(F.ws + WS_VTC); const bf16* VTS = (const bf16*)(F.ws + WS_VTS); const bf16* VTW = (const bf16*)(F.ws + WS_VTW);
    const float* BLG = (const float*)(F.ws + WS_BLG); bf16* OATT = (bf16*)(F.ws + WS_OATT); float* OPARK = (float*)(F.ws + WS_OACC);
    LAS float* BL = (LAS float*)(F.lds);
    LAS int* OACC = (LAS int*)(BL + 4 * 2056);
    LAS float* IMPL = (LAS float*)OACC;
    LAS int* LACC = OACC + 16384;
    LAS unsigned* SELM = (LAS unsigned*)(LACC + 256);
    LAS unsigned long long* BM = (LAS unsigned long long*)(SELM + 256);
    LAS unsigned short* KT = (LAS unsigned short*)(BM + 128);
    LAS unsigned short* VTT = KT + 2 * 4608;
    LAS unsigned* BCTR = (LAS unsigned*)(F.lds + MISC_OFF + 64);
    LAS unsigned short* QL = KT;
    const v4u* KF = (const v4u*)(F.ws + WS_KF); const v4u* VF = (const v4u*)(F.ws + WS_VF);
    static_assert(4 * 2056 * 4 + 16384 * 4 + 1024 + 1024 + 1024 + 4 * 4608 * 2 <= LDSCTL_OFF, "attention LDS map");
    const int tid = F.tid, lane = F.lane, w = F.wave;
    const int col = lane & 31, hi = lane >> 5, hp = col & 3, ti = w * 8 + (col >> 2);
    const LAS float* blp = BL + hp * 2056;
    int last_g = -1;
    for (int it = 0;; ++it) {
        const int id = F.vcu + F.G * it; if (id >= BATCH * NG * (T / 64)) break;
        const int bg = id >> 7, b = bg >> 2, g = bg & 3, tt = (it & 1) ? 127 - (id & 127) : (id & 127);
        const int t0 = tt * 64, cur = tt, t_l = t0 + ti, h = 4 * g + hp;
        const size_t mrow = (size_t)b * T + t_l;
        __syncthreads();
        if (g != last_g) { int tio = tid; asm volatile("" : "+v"(tio)); for (int i = tio; i < 4 * 2048; i += NWAVES * 64) BL[(i >> 11) * 2056 + (i & 2047)] = BLG[(size_t)(4 * g) * 2048 + i]; }
        last_g = g;
        for (int i = tid; i < 64 * 132 / 4; i += NWAVES * 64) ((LAS v4u*)IMPL)[i] = (v4u){0u, 0u, 0u, 0u};
        __syncthreads();
        bf16x8 qf[4];
#pragma unroll
        for (int k = 0; k < 4; ++k) qf[k] = ldg8(QN + mrow * D + h * 64 + 16 * k + 8 * hi);
        f32x16 ofin[2];
        const float cbias = blp[2047];
        SUBREP(1) {
            const int ncv_max = ((t0 + 63 - 31) >> 4) + 1; int n_kt = (ncv_max >> 5) + 1; n_kt = n_kt > 16 ? 16 : n_kt; const int n64 = (n_kt + 1) >> 1;
            int tio = tid; asm volatile("" : "+v"(tio));
            const bf16* kcs = KC + (size_t)bg * NCMPP * 64 + (size_t)(tio >> 3) * 64 + 8 * (tio & 7); const bf16* vcs = VTC + (size_t)bg * 64 * NCMPP + (size_t)(tio >> 3) * NCMPP + 8 * (tio & 7);
            float l = 0.f; v4u kreg, vreg;
            f32x16 oc[2]; oc[0] = (f32x16){0.f,0.f,0.f,0.f,0.f,0.f,0.f,0.f,0.f,0.f,0.f,0.f,0.f,0.f,0.f,0.f}; oc[1] = oc[0];
            unsigned av[16][2];
#pragma unroll
            for (int kt = 0; kt < 16; ++kt) { av[kt][0] = 0u; av[kt][1] = 0u; }
            float prevx3 = 0.f;
            kreg = *(const GAS v4u*)kcs; vreg = *(const GAS v4u*)vcs; DENSE_STK(0); DENSE_STV(0); __syncthreads();
#pragma unroll
            for (int i = 0; i < 8; ++i) { if (i < n64) { if (i + 1 < n64) { kreg = *(const GAS v4u*)(kcs + (size_t)(i + 1) * 64 * 64); vreg = *(const GAS v4u*)(vcs + (i + 1) * 64); }
#pragma unroll
                for (int sub = 0; sub < 2; ++sub) { const int kt = 2 * i + sub; if (kt < n_kt) { bf16x8 kf[4]; DENSE_LDK(kf, i & 1, sub); bf16x8 vf[2][2]; DENSE_LDV(vf, i & 1, sub);
                    f32x16 st; NSA_QK(st, kf, qf);
                    if (t0 - 512 * kt - 527 >= 2047) l += st_softmax_far(st, cbias, 1.0f); else if (t0 - 512 * kt - 527 >= 0 && t0 + 32 - 512 * kt <= 2047) l += st_softmax_in<16>(st, t_l - 31 - 512 * kt - 64 * hi, blp, 1.0f);
                    else l += st_softmax<1, 16>(st, t_l - 31 - 512 * kt - 64 * hi, blp, 1.0f);
                    float xq[4], aq[4];
#pragma unroll
                    for (int q = 0; q < 4; ++q) { const float cr = 0.5f * st[4 * q + 3]; aq[q] = st[4 * q] + st[4 * q + 1] + st[4 * q + 2] + cr; xq[q] = __shfl_xor(cr, 32); }
#pragma unroll
                    for (int q = 0; q < 4; ++q) aq[q] += hi ? xq[q] : (q == 0 ? prevx3 : xq[q > 0 ? q - 1 : 0]);
                    prevx3 = xq[3]; av[kt][0] = cvtpk(aq[0], aq[1]); av[kt][1] = cvtpk(aq[2], aq[3]);
                    const bf16x8 pb0 = pack8(st, 0), pb1 = pack8(st, 1);
#pragma unroll
                    for (int mt = 0; mt < 2; ++mt) { oc[mt] = MFMA32(vf[mt][0], pb0, oc[mt]); oc[mt] = MFMA32(vf[mt][1], pb1, oc[mt]); } } }
                if (i + 1 < n64) { DENSE_STK((i + 1) & 1); DENSE_STV((i + 1) & 1); }
                __syncthreads(); } }
            l += __shfl_xor(l, 32);
            const float gate = sigmoid_f(bf2f(QG[mrow * NQINP + D + h * 3 + 0]));
            const float inv = l > 0.f ? 1.0f / l : 0.f;
#pragma unroll
            for (int kt = 0; kt < 16; ++kt) { if (kt < n_kt) {
#pragma unroll
                for (int q = 0; q < 4; ++q) { float v = ((q & 1) ? bfhi(av[kt][q >> 1]) : bflo(av[kt][q >> 1])) * inv; v += __shfl_xor(v, 1); v += __shfl_xor(v, 2); if (hp == 0) IMPL[ti * 132 + 8 * kt + 2 * q + hi] = v; } } }
            const float og = gate * inv;
#pragma unroll
            for (int mt = 0; mt < 2; ++mt)
#pragma unroll
                for (int r = 0; r < 16; ++r) ofin[mt][r] = oc[mt][r] * og;
        }
        __syncthreads();
        v4u pf_wk, pf_wv, pf_dk, pf_dv, pf_q[4];
        { int tio = tid; asm volatile("" : "+v"(tio)); const int kt_lo_ = t0 >= 512 ? 0 : (512 - t0) >> 6, keyw = t0 - 512 + 64 * kt_lo_;
          pf_wk = *(const GAS v4u*)(KV + (size_t)b * T * NKV + 1024 + 64 * g + (size_t)(tio >> 3) * NKV + 8 * (tio & 7) + (size_t)keyw * NKV); pf_wv = *(const GAS v4u*)(VTW + (size_t)bg * 64 * T + (size_t)(tio >> 3) * T + 8 * (tio & 7) + keyw); }
        SUBREP(2) {
            int tk = tid >> 3, j = tid & 7; asm volatile("" : "+v"(tk), "+v"(j)); float v[16];
#pragma unroll
            for (int k = 0; k < 16; ++k) { const int s = 16 * j + k; v[k] = (s >= 1 && s <= cur - 2) ? IMPL[tk * 132 + s] : -1.0f; }
            unsigned msk = 0u;
#pragma unroll
            for (int k = 0; k < 16; ++k) { const int s = 16 * j + k; if (s <= cur && (s == 0 || s >= cur - 1)) msk |= 1u << k; }
            const int ncand = cur - 2 > 0 ? cur - 2 : 0; const int n_need = ncand < NTOP - 3 ? ncand : NTOP - 3;
            for (int itn = 0; itn < n_need; ++itn) {
                float bm = fmaxf(fmaxf(fmaxf(v[0], v[1]), fmaxf(v[2], v[3])), fmaxf(fmaxf(v[4], v[5]), fmaxf(v[6], v[7])));
                bm = fmaxf(bm, fmaxf(fmaxf(fmaxf(v[8], v[9]), fmaxf(v[10], v[11])), fmaxf(fmaxf(v[12], v[13]), fmaxf(v[14], v[15]))));
#define DPP_I(x, ctl) __builtin_amdgcn_update_dpp(0, (x), (ctl), 0xF, 0xF, true)
#define DPP_F(x, ctl) __builtin_bit_cast(float, __builtin_amdgcn_update_dpp(0, __builtin_bit_cast(int, (x)), (ctl), 0xF, 0xF, true))
                float gm = bm; gm = fmaxf(gm, DPP_F(gm, 0xB1)); gm = fmaxf(gm, DPP_F(gm, 0x4E)); gm = fmaxf(gm, DPP_F(gm, 0x141));
                unsigned eq = 0u;
#pragma unroll
                for (int k = 0; k < 16; ++k) eq |= (v[k] == gm) ? (1u << k) : 0u;
                int cand = eq ? 16 * j + (__ffs(eq) - 1) : 9999; int o1 = DPP_I(cand, 0xB1); cand = o1 < cand ? o1 : cand; o1 = DPP_I(cand, 0x4E); cand = o1 < cand ? o1 : cand; o1 = DPP_I(cand, 0x141); cand = o1 < cand ? o1 : cand;
#undef DPP_I
#undef DPP_F
                const unsigned hit = (unsigned)(cand - 16 * j) < 16u ? (1u << (cand - 16 * j)) : 0u; msk |= hit;
#pragma unroll
                for (int k = 0; k < 16; ++k) v[k] = (hit >> k) & 1u ? -1.0f : v[k];
            }
            ((LAS unsigned short*)SELM)[tk * 8 + j] = (unsigned short)msk;
        }
        __syncthreads();
        if (tid == 0) *BCTR = 0u;
        for (int i = tid; i < (16384 + 256) / 4; i += NWAVES * 64) ((LAS v4u*)OACC)[i] = (v4u){0u, 0u, 0u, 0u};
        {
            const unsigned wsel = SELM[lane * 4 + (w >> 1)]; const unsigned part = (w & 1) ? (wsel >> 16) : (wsel & 0xffffu);
#pragma unroll
            for (int k = 0; k < 16; ++k) { const unsigned long long bal = __ballot((part >> k) & 1u); if (lane == 0) BM[16 * w + k] = bal; }
        }
        __syncthreads();
        SUBREP(5) {
            int tio = tid; asm volatile("" : "+v"(tio));
            const bf16* ks_ = KV + (size_t)b * T * NKV + 1024 + 64 * g + (size_t)(tio >> 3) * NKV + 8 * (tio & 7);
            const bf16* vs_ = VTW + (size_t)bg * 64 * T + (size_t)(tio >> 3) * T + 8 * (tio & 7);
            f32x16 ow[2]; ow[0] = (f32x16){0.f,0.f,0.f,0.f,0.f,0.f,0.f,0.f,0.f,0.f,0.f,0.f,0.f,0.f,0.f,0.f}; ow[1] = ow[0]; float lw = 0.f;
            const int kt_lo = t0 >= 512 ? 0 : (512 - t0) >> 6; v4u kreg, vreg;
            kreg = pf_wk; vreg = pf_wv;
            { const int keyd = 64 * cur;
              pf_dk = *(const GAS v4u*)(KV + (size_t)b * T * NKV + 512 + 64 * g + (size_t)(tio >> 3) * NKV + 8 * (tio & 7) + (size_t)keyd * NKV); pf_dv = *(const GAS v4u*)(VTS + (size_t)bg * 64 * T + (size_t)(tio >> 3) * T + 8 * (tio & 7) + keyd); }
            DENSE_STK(0); DENSE_STV(0); __syncthreads();
            for (int kt = kt_lo; kt < 9; ++kt) { const int buf = (kt - kt_lo) & 1;
                if (kt + 1 < 9) { const int key1 = t0 - 512 + 64 * (kt + 1); kreg = *(const GAS v4u*)(ks_ + (size_t)key1 * NKV); vreg = *(const GAS v4u*)(vs_ + key1); }
#pragma unroll
                for (int sub = 0; sub < 2; ++sub) { const int key0 = t0 - 512 + 64 * kt + 32 * sub; bf16x8 kf[4]; DENSE_LDK(kf, buf, sub); bf16x8 vf[2][2]; DENSE_LDV(vf, buf, sub);
                    f32x16 st; NSA_QK(st, kf, qf);
                    if (kt >= 1 && kt <= 7) lw += st_softmax_in<1>(st, t_l - key0 - 4 * hi, blp, 1.0f); else lw += st_softmax<2, 1>(st, t_l - key0 - 4 * hi, blp, 1.0f);
                    const bf16x8 pb0 = pack8(st, 0), pb1 = pack8(st, 1);
#pragma unroll
                    for (int mt = 0; mt < 2; ++mt) { ow[mt] = MFMA32(vf[mt][0], pb0, ow[mt]); ow[mt] = MFMA32(vf[mt][1], pb1, ow[mt]); } }
                if (kt + 1 < 9) { DENSE_STK(buf ^ 1); DENSE_STV(buf ^ 1); }
                __syncthreads(); }
            lw += __shfl_xor(lw, 32);
            const float gw = sigmoid_f(bf2f(QG[mrow * NQINP + D + h * 3 + 2])) / lw * rs_;
#pragma unroll
            for (int mt = 0; mt < 2; ++mt)
#pragma unroll
                for (int r = 0; r < 16; ++r) ofin[mt][r] += ow[mt][r] * gw;
            float* pk = OPARK + mrow * D + h * 64;
#pragma unroll
            for (int mt = 0; mt < 2; ++mt)
#pragma unroll
                for (int q = 0; q < 4; ++q) *(GAS f32x4*)(pk + 32 * mt + 8 * q + 4 * hi) = (f32x4){ofin[mt][4 * q], ofin[mt][4 * q + 1], ofin[mt][4 * q + 2], ofin[mt][4 * q + 3]};
        }
        {
            const bf16* kbase = KV + (size_t)b * T * NKV + 512 + 64 * g + (size_t)(lane & 31) * NKV + 8 * hi;
            const bf16* vbase = VTS + (size_t)bg * 64 * T + (size_t)(lane & 31) * T + 8 * hi;
            SUBREP(3) {
            int tio = tid; asm volatile("" : "+v"(tio));
            const bf16* ks_ = KV + (size_t)b * T * NKV + 512 + 64 * g + (size_t)(tio >> 3) * NKV + 8 * (tio & 7);
            const bf16* vs_ = VTS + (size_t)bg * 64 * T + (size_t)(tio >> 3) * T + 8 * (tio & 7);
            f32x16 os[2]; os[0] = (f32x16){0.f,0.f,0.f,0.f,0.f,0.f,0.f,0.f,0.f,0.f,0.f,0.f,0.f,0.f,0.f,0.f}; os[1] = os[0]; float ls = 0.f;
            const int nfb = cur >= 2 ? 3 : cur + 1; v4u kreg, vreg;
            kreg = pf_dk; vreg = pf_dv;
#pragma unroll
            for (int c = 0; c < 4; ++c) { const int ch = tio + 512 * c, row = ch >> 3, part = ch & 7; pf_q[c] = *(const GAS v4u*)(QN + ((size_t)b * T + t0 + (row >> 2)) * D + (4 * g + (row & 3)) * 64 + 8 * part); }
            DENSE_STK(0); DENSE_STV(0); __syncthreads();
            for (int fi = 0; fi < nfb; ++fi) { const int fb = fi == 0 ? cur : (fi == 1 ? cur - 1 : 0);
                if (fi + 1 < nfb) { const int key1 = 64 * (fi == 0 ? cur - 1 : 0); kreg = *(const GAS v4u*)(ks_ + (size_t)key1 * NKV); vreg = *(const GAS v4u*)(vs_ + key1); }
#pragma unroll
                for (int sub = 0; sub < 2; ++sub) { const int key0 = 64 * fb + 32 * sub; bf16x8 kf[4]; DENSE_LDK(kf, fi & 1, sub); bf16x8 vf[2][2]; DENSE_LDV(vf, fi & 1, sub);
                    f32x16 st; NSA_QK(st, kf, qf);
                    if (fi == 1) ls += st_softmax_in<1>(st, t_l - key0 - 4 * hi, blp, 1.0f);
                    else if (fi == 2 && t0 - 63 >= 2047) ls += st_softmax_far(st, cbias, 1.0f);
                    else if (fi == 2 && t0 + 63 <= 2047) ls += st_softmax_in<1>(st, t_l - key0 - 4 * hi, blp, 1.0f);
                    else ls += st_softmax<1, 1>(st, t_l - key0 - 4 * hi, blp, 1.0f);
                    const bf16x8 pb0 = pack8(st, 0), pb1 = pack8(st, 1);
#pragma unroll
                    for (int mt = 0; mt < 2; ++mt) { os[mt] = MFMA32(vf[mt][0], pb0, os[mt]); os[mt] = MFMA32(vf[mt][1], pb1, os[mt]); } }
                if (fi + 1 < nfb) { DENSE_STK((fi + 1) & 1); DENSE_STV((fi + 1) & 1); }
                __syncthreads(); }
            {   int rowi = ti * 4 + hp; asm volatile("" : "+v"(rowi)); LAS int* orow = OACC + rowi * 64; const int swz = rowi & 31;
#pragma unroll
                for (int mt = 0; mt < 2; ++mt)
#pragma unroll
                    for (int r = 0; r < 16; ++r) { const int dim = 32 * mt + (r & 3) + 8 * (r >> 2) + 4 * hi; __hip_atomic_fetch_add(orow + (dim ^ swz), __float2int_rn(os[mt][r] * rs_ * OFIX), __ATOMIC_RELAXED, __HIP_MEMORY_SCOPE_WORKGROUP); }
                __hip_atomic_fetch_add(LACC + rowi, __float2int_rn(ls * rs_ * LFIX), __ATOMIC_RELAXED, __HIP_MEMORY_SCOPE_WORKGROUP); }
            }
            { int tio = tid; asm volatile("" : "+v"(tio));
#pragma unroll
              for (int c = 0; c < 4; ++c) { const int ch = tio + 512 * c, row = ch >> 3, part = ch & 7;
                  *(LAS v4u*)(QL + row * 72 + 8 * part) = pf_q[c]; } }
            __syncthreads();
            for (int rep_ = 0; rep_ < ((REP_SUB == 4 || REP_SUB == 6) ? 2 : 1); ++rep_) if (const float rs_ = rep_ ? 0.f : 1.f; true) {
#define NSA_NEXTBLK(sv) do { for (;;) { unsigned t_ = 0u; if (lane == 0) t_ = __hip_atomic_fetch_add(BCTR, 1u, __ATOMIC_RELAXED, __HIP_MEMORY_SCOPE_WORKGROUP); sv = 1 + __builtin_amdgcn_readfirstlane((int)t_); if (sv > cur - 2) break; \
        const unsigned long long m_ = BM[sv]; if (__builtin_amdgcn_readfirstlane((unsigned)m_) | __builtin_amdgcn_readfirstlane((unsigned)(m_ >> 32))) break; } } while (0)
#define NSA_LDK8(dst, sv) do { const size_t fb_ = ((size_t)(bg * 128 + (sv)) * 8) * 64 + lane; _Pragma("unroll") for (int k_ = 0; k_ < 8; ++k_) dst[k_] = KF[fb_ + (size_t)k_ * 64]; } while (0)
#define NSA_LDV8(dst, sv) do { const size_t fb_ = ((size_t)(bg * 128 + (sv)) * 8) * 64 + lane; _Pragma("unroll") for (int k_ = 0; k_ < 8; ++k_) dst[8 + k_] = VF[fb_ + (size_t)k_ * 64]; } while (0)
            v4u kv_[16];
            int s; NSA_NEXTBLK(s);
            while (s <= cur - 2) {
                NSA_LDK8(kv_, s); NSA_LDV8(kv_, s);
                const bool far_ = (t0 - 64 * s - 63) >= 2047, in_ = (t0 + 63 - 64 * s) <= 2047;
                unsigned long long mk = BM[s]; unsigned mlo = __builtin_amdgcn_readfirstlane((unsigned)mk), mhi = __builtin_amdgcn_readfirstlane((unsigned)(mk >> 32));
                mk = ((unsigned long long)mhi << 32) | mlo;
                while (mk) {
                    int mytok = -1;
#pragma unroll
                    for (int k = 0; k < 8; ++k) { int tkk = -1; if (mk) { tkk = __builtin_ctzll(mk); mk &= mk - 1; } mytok = ((col >> 2) == k) ? tkk : mytok; }
                    const bool valid = mytok >= 0; const int tq = valid ? mytok : 0; const int tq_abs = t0 + tq;
                    bf16x8 q2[4];
                    { const LAS unsigned short* qp = QL + (tq * 4 + hp) * 72 + 8 * hi;
#pragma unroll
                      for (int k = 0; k < 4; ++k) q2[k] = *(const LAS bf16x8*)(qp + 16 * k); }
                    f32x16 oi[2]; oi[0] = (f32x16){0.f,0.f,0.f,0.f,0.f,0.f,0.f,0.f,0.f,0.f,0.f,0.f,0.f,0.f,0.f,0.f}; oi[1] = oi[0]; float li = 0.f;
#pragma unroll
                    for (int sub = 0; sub < 2; ++sub) { f32x16 st = (f32x16){0.f,0.f,0.f,0.f,0.f,0.f,0.f,0.f,0.f,0.f,0.f,0.f,0.f,0.f,0.f,0.f};
#pragma unroll
                      for (int k = 0; k < 4; ++k) st = MFMA32(__builtin_bit_cast(bf16x8, kv_[4 * sub + k]), q2[k], st);
                      if (far_) li += st_softmax_far(st, cbias, 1.0f); else if (in_) li += st_softmax_in<1>(st, tq_abs - 64 * s - 32 * sub - 4 * hi, blp, 1.0f); else li += st_softmax<0, 1>(st, tq_abs - 64 * s - 32 * sub - 4 * hi, blp, 1.0f);
                      const bf16x8 pb0 = pack8(st, 0), pb1 = pack8(st, 1);
#pragma unroll
                      for (int mt = 0; mt < 2; ++mt) { oi[mt] = MFMA32(__builtin_bit_cast(bf16x8, kv_[8 + 4 * sub + 2 * mt]), pb0, oi[mt]); oi[mt] = MFMA32(__builtin_bit_cast(bf16x8, kv_[8 + 4 * sub + 2 * mt + 1]), pb1, oi[mt]); }
                      __builtin_amdgcn_sched_barrier(0); }
                    if (valid && !(REP_SUB == 6 && rep_)) { const int rowi = tq * 4 + hp; LAS int* orow = OACC + rowi * 64; const int swz = rowi & 31;
#pragma unroll
                        for (int mt = 0; mt < 2; ++mt)
#pragma unroll
                            for (int r = 0; r < 16; ++r) { const int dim = 32 * mt + (r & 3) + 8 * (r >> 2) + 4 * hi; __hip_atomic_fetch_add(orow + (dim ^ swz), __float2int_rn(oi[mt][r] * rs_ * OFIX), __ATOMIC_RELAXED, __HIP_MEMORY_SCOPE_WORKGROUP); }
                        __hip_atomic_fetch_add(LACC + rowi, __float2int_rn(li * rs_ * LFIX), __ATOMIC_RELAXED, __HIP_MEMORY_SCOPE_WORKGROUP); }
                }
                NSA_NEXTBLK(s);
            }
            }
        }
        __syncthreads();
        {
            int rowi = ti * 4 + hp; asm volatile("" : "+v"(rowi)); const LAS int* orow = OACC + rowi * 64; const int swz = rowi & 31;
            const float gs = sigmoid_f(bf2f(QG[mrow * NQINP + D + h * 3 + 1])) / ((float)LACC[rowi] * (1.0f / LFIX)) * (1.0f / OFIX);
            bf16* od = OATT + mrow * D + h * 64;
#pragma unroll
            for (int mt = 0; mt < 2; ++mt)
#pragma unroll
                for (int q = 0; q < 4; ++q) { const int dim0 = 32 * mt + 8 * q + 4 * hi; float o4[4];
                    const f32x4 pk4 = *(const GAS f32x4*)(OPARK + mrow * D + h * 64 + dim0);
#pragma unroll
                    for (int e = 0; e < 4; ++e) o4[e] = pk4[e] + (float)orow[(dim0 + e) ^ swz] * gs;
                    *(GAS unsigned long long*)(od + dim0) = (unsigned long long)cvtpk(o4[0], o4[1]) | ((unsigned long long)cvtpk(o4[2], o4[3]) << 32); }
        }
    }
}

enum Phase { P_PRO, P_IN0, P_HA, P_HB, P_HC, P_OUT0, P_GU0, P_DN0, P_KVQ, P_PREP, P_NSA, P_OUT1, P_ROUTE, P_MOE1, P_MOE2, P_COMB, N_PHASES };
#define NREP(k) (REP_PHASE == (int)(k) ? 2 : 1)
#define REPEAT(k, call) do { if (REP_PHASE == (int)(k)) { __syncthreads(); call; } } while (0)
__global__ void __launch_bounds__(NWAVES * 64, 2) fwd_kernel(Args args) {
    extern __shared__ __attribute__((aligned(16))) unsigned char lds[];
    Frame F;
    F.lds = (LAS unsigned char*)lds;
    F.MISC = (volatile LAS unsigned*)(F.lds + MISC_OFF);
    F.tid = threadIdx.x; F.lane = F.tid & 63; F.wave = __builtin_amdgcn_readfirstlane(F.tid >> 6);
    F.G = gridDim.x; { const int bx = blockIdx.x; F.vcu = (F.G % 8 == 0) ? (bx % 8) * (F.G / 8) + bx / 8 : bx; }
    F.ws = args.ws; F.out = args.out; F.ctl = (gu32*)(args.ws + WS_CTL);
    unsigned char* ws = args.ws;
    for (int u = F.tid; u < (LDS_BYTES - LDSCTL_OFF) / 4; u += NWAVES * 64) ((LAS unsigned*)(F.lds + LDSCTL_OFF))[u] = 0u;
    __syncthreads();
    XcdBarrier bar; bar.bar = (unsigned*)(F.ctl + CW_BAR); bar.x = 0; bar.st = nullptr;
    if (MK_SINGLE) bar = xcd_barrier_post((unsigned*)(F.ctl + CW_BAR), F.MISC + 8);
    const int lo = args.ph_lo, hi = args.ph_hi;
#define IN(k) (lo <= (k) && (k) < hi)
#define SEAM(k) do { if (MK_SINGLE && IN(k) && hi > (k) + 1) xcd_barrier(bar); } while (0)
    bf16* XN = (bf16*)(ws + WS_XN);

#define GEMM_IN0() do { pg8::Gemm g{XN, (const bf16*)(ws + WS_W_IN0), D}; pg8::StaticOrder S; S.init(M, NIN0, F.G, (int)blockIdx.x); pg8::EpiBf16 E{(bf16*)(ws + WS_QFIG), NIN0, nullptr, 0, nullptr, 0}; \
        pg8::gemm_phase<pg8::EpiBf16, pg8::StaticOrder, true>(F.lds + RING_OFF, g, S, E); } while (0)
#define GEMM_OUT0() do { pg8::Gemm g{(const bf16*)(ws + WS_OG), (const bf16*)(ws + WS_W_OUT0), D}; pg8::StaticOrder S; S.init(M, D, F.G, (int)blockIdx.x); pg8::EpiResF32 E{args.in[I_X], nullptr, nullptr, D, XN, (float*)(ws + WS_SSP1), nullptr}; \
        pg8::gemm_phase<pg8::EpiResF32, pg8::StaticOrder, true>(F.lds + RING_OFF, g, S, E); } while (0)
#define GEMM_GU0() do { pg8::Gemm g{XN, (const bf16*)(ws + WS_W_GU0), D}; pg8::StaticOrder S; S.init(M, 2 * FF, F.G, (int)blockIdx.x); pg8::EpiSwiglu E{(bf16*)(ws + WS_ACT), FF, (const float*)(ws + WS_SSP1)}; \
        pg8::gemm_phase<pg8::EpiSwiglu, pg8::StaticOrder, true>(F.lds + RING_OFF, g, S, E); } while (0)
#define GEMM_DN0() do { pg8::Gemm g{(const bf16*)(ws + WS_ACT), (const bf16*)(ws + WS_W_DN0), FF}; pg8::StaticOrder S; S.init(M, D, F.G, (int)blockIdx.x); pg8::EpiResF32 E{nullptr, XN, nullptr, D, XN, (float*)(ws + WS_SSP2), nullptr}; \
        pg8::gemm_phase<pg8::EpiResF32, pg8::StaticOrder, true>(F.lds + RING_OFF, g, S, E); } while (0)
#define GEMM_KVQ() do { pg8::Gemm g{XN, (const bf16*)(ws + WS_W_KV), D}; pg8::StaticOrder S; S.init(M, NKV + NQINP, F.G, (int)blockIdx.x); \
        pg8::EpiBf16 E{(bf16*)(ws + WS_KV), NKV, (const float*)(ws + WS_SSP2), NKV / 256, (bf16*)(ws + WS_QG), NQINP}; pg8::gemm_phase<pg8::EpiBf16, pg8::StaticOrder, true>(F.lds + RING_OFF, g, S, E); } while (0)
#define GEMM_OUT1() do { pg8::Gemm g{(const bf16*)(ws + WS_OATT), (const bf16*)(ws + WS_W_OUT1), D}; pg8::StaticOrder S; S.init(M, D, F.G, (int)blockIdx.x); pg8::EpiResF32 E{nullptr, XN, F.out, D, XN, (float*)(ws + WS_SSP3), nullptr}; \
        pg8::gemm_phase<pg8::EpiResF32, pg8::StaticOrder, true>(F.lds + RING_OFF, g, S, E); } while (0)
#define GEMM_MOE1() do { pg8::Gemm g{(const bf16*)(ws + WS_XG8), (const bf16*)(ws + WS_W_GU1), D}; MoeOrder S; S.init(F.ctl + CW_ECNT, 2 * EF / 256, F.G, F.vcu, true); \
        pg8::EpiSwigluF8 E{(unsigned char*)(ws + WS_ACT2), EF, (const float*)(ws + WS_RS_E)}; pg8::gemm_phase<pg8::EpiSwigluF8, MoeOrder, true, true>(F.lds + RING_OFF, g, S, E); } while (0)
#define GEMM_MOE2() do { pg8::Gemm g{(const bf16*)(ws + WS_ACT2), (const bf16*)(ws + WS_W_DN1), EF}; MoeOrder S; S.init(F.ctl + CW_ECNT, D / 256, F.G, F.vcu, false); \
        pg8::EpiMoeDown E{(bf16*)(ws + WS_Y2), D, 1.0f / (pg8::F8_WSCALE * pg8::F8_ASCALE)}; pg8::gemm_phase<pg8::EpiMoeDown, MoeOrder, true, true>(F.lds + RING_OFF, g, S, E); } while (0)
    if (IN(P_PRO)) { p0_prologue(F, args); REPEAT(P_PRO, p0_prologue(F, args)); } SEAM(P_PRO);
    if (IN(P_IN0)) { GEMM_IN0(); REPEAT(P_IN0, GEMM_IN0()); } SEAM(P_IN0);
    if (IN(P_HA)) { p_hg_a(F); REPEAT(P_HA, p_hg_a(F)); } SEAM(P_HA);
    if (IN(P_HB)) { p_hg_b(F); REPEAT(P_HB, p_hg_b(F)); } SEAM(P_HB);
    if (IN(P_HC)) { p_hg_c(F, args.in[I_A_ONORM]); REPEAT(P_HC, p_hg_c(F, args.in[I_A_ONORM])); } SEAM(P_HC);
    if (IN(P_OUT0)) { GEMM_OUT0();  } SEAM(P_OUT0);
    if (IN(P_GU0)) { GEMM_GU0(); REPEAT(P_GU0, GEMM_GU0()); } SEAM(P_GU0);
    if (IN(P_DN0)) { GEMM_DN0();  } SEAM(P_DN0);
    if (IN(P_KVQ)) { GEMM_KVQ(); REPEAT(P_KVQ, GEMM_KVQ()); } SEAM(P_KVQ);
    if (IN(P_PREP)) { p_knorm(F, args.in[I_K_NORM]); p_qnorm(F, args.in[I_B_QNORM]); p_biaslut(F, args.in[I_REL_BIAS]); p_vtrans(F); __syncthreads(); p_compress_mfma(F, args.in[I_K_NORM]);
        REPEAT(P_PREP, p_qnorm(F, args.in[I_B_QNORM]); p_biaslut(F, args.in[I_REL_BIAS]); p_vtrans(F); __syncthreads(); p_compress_mfma(F, args.in[I_K_NORM])); } SEAM(P_PREP);
    if (IN(P_NSA)) { p_nsa(F, args); REPEAT(P_NSA, p_nsa(F, args)); } SEAM(P_NSA);
    if (IN(P_OUT1)) { GEMM_OUT1();  } SEAM(P_OUT1);
    if (IN(P_ROUTE)) { p_route(F, args); REPEAT(P_ROUTE, p_route(F, args, true)); } SEAM(P_ROUTE);
    if (IN(P_MOE1)) { GEMM_MOE1(); REPEAT(P_MOE1, GEMM_MOE1()); } SEAM(P_MOE1);
    if (IN(P_MOE2)) { GEMM_MOE2(); REPEAT(P_MOE2, GEMM_MOE2()); } SEAM(P_MOE2);
    if (IN(P_COMB)) { p_moe_combine(F); }
#undef IN
#undef SEAM
}

extern "C" void kernel_launch(void* const* d_in, const int* in_sizes, int n_in, void* d_out, int out_size, void* d_ws, size_t ws_size, hipStream_t stream) {
    static int grid = 0;
    if (grid == 0) {
        if (n_in != N_IN || in_sizes[0] != M * D || out_size != M * D || ws_size < WS_END) { fprintf(stderr, "kernel_launch: unexpected shapes (n_in %d, in0 %d, out %d, ws %zu < %zu); nothing launched\n", n_in, n_in > 0 ? in_sizes[0] : -1, out_size, ws_size, (size_t)WS_END); grid = -1; return; }
        int dev = 0, cus = 0, per_cu = 0;
        if (hipGetDevice(&dev) != hipSuccess || hipDeviceGetAttribute(&cus, hipDeviceAttributeMultiprocessorCount, dev) != hipSuccess) { grid = -1; return; }
        if (hipFuncSetAttribute((const void*)fwd_kernel, hipFuncAttributeMaxDynamicSharedMemorySize, LDS_BYTES) != hipSuccess) { fprintf(stderr, "kernel_launch: hipFuncSetAttribute failed\n"); grid = -1; return; }
        if (hipOccupancyMaxActiveBlocksPerMultiprocessor(&per_cu, (const void*)fwd_kernel, NWAVES * 64, LDS_BYTES) != hipSuccess || per_cu < 1)
            fprintf(stderr, "kernel_launch: note: occupancy query reports %d workgroups per CU\n", per_cu);
        (void)hipGetLastError();
        grid = cus;
    }
    if (grid < 0) return;
    if (hipMemsetAsync((char*)d_ws + WS_CTL, 0, CTL_ZERO_BYTES, stream) != hipSuccess) { fprintf(stderr, "kernel_launch: hipMemsetAsync failed\n"); return; }
    Args a{};
    for (int i = 0; i < N_IN; ++i) a.in[i] = (const float*)d_in[i];
    a.out = (float*)d_out; a.ws = (unsigned char*)d_ws;
#if MK_SINGLE
    a.ph_lo = 0; a.ph_hi = N_PHASES;
    hipLaunchKernelGGL(fwd_kernel, dim3(grid), dim3(NWAVES * 64), LDS_BYTES, stream, a);
#else
    for (int p = 0; p < N_PHASES; ++p) { a.ph_lo = p; a.ph_hi = p + 1; hipLaunchKernelGGL(fwd_kernel, dim3(grid), dim3(NWAVES * 64), LDS_BYTES, stream, a); }
#endif
}
```

```cpp
#include <hip/hip_runtime.h>
#include <cstdio>
#include <cstdint>

#ifndef REP_PHASE
#define REP_PHASE -1
#endif
#ifndef MK_SINGLE
#define MK_SINGLE 1
#endif

namespace pg8 {
#define PG8_LAS __attribute__((address_space(3)))
typedef unsigned short bf16_t;
typedef short bf16x8 __attribute__((ext_vector_type(8)));
typedef float f32x4 __attribute__((ext_vector_type(4)));
typedef unsigned u32x4 __attribute__((ext_vector_type(4)));
typedef unsigned u32x2 __attribute__((ext_vector_type(2)));
typedef float f32x2 __attribute__((ext_vector_type(2)));
constexpr int BM = 256, BK = 64, HALF = 128, HTB = HALF * BK * 2  , STAGE_BYTES = 8 * HTB, NXCD = 8, WGM = 8;

__host__ __device__ __forceinline__ int lds_byte(int r, int c) { const int st = (r >> 4) * 2 + (c >> 5), rr = r & 15, cc = c & 31, ob = rr * 64 + cc * 2; return st * 1024 + (ob ^ (((ob >> 9) & 1) << 5)); }
__host__ __device__ __forceinline__ void stage_rc(int b, int& R, int& C) { const int st = b / 1024, sb = b % 1024, swz = sb ^ (((sb >> 9) & 1) << 5); R = (st >> 1) * 16 + swz / 64; C = (st & 1) * 32 + (swz % 64) / 2; }
__host__ __device__ __forceinline__ int perm32(int rho) { const int n = rho >> 4, i = rho & 15; return 8 * (i >> 2) + 4 * n + (i & 3); }

struct Unit { int pm, pn, pnl, pa, nv; };
struct Gemm { const bf16_t* A; const bf16_t* Bt; int K; };

struct StaticOrder {
    int nM, nN, nwg, G, c;
    __host__ __device__ void init(int M, int N, int G_, int c_) { nM = M / BM; nN = N / BM; nwg = nM * nN; G = G_; c = c_; }
    __host__ __device__ bool next(int i, Unit& u) const {
        const long L = (long)i * G + c; if (L >= nwg) return false;
        int wgid = (int)L; { const int q = nwg / NXCD, r = nwg % NXCD, xcd = wgid % NXCD, off = wgid / NXCD; wgid = (xcd < r ? xcd * (q + 1) : r * (q + 1) + (xcd - r) * q) + off; }
        const int nig = WGM * nN, gid = wgid / nig, fm = gid * WGM, gsz = (nM - fm) < WGM ? (nM - fm) : WGM;
        u.pm = fm + ((wgid % nig) % gsz); u.pn = (wgid % nig) / gsz; u.pnl = u.pn; u.pa = u.pm; u.nv = BM; return true;
    }
};

__device__ __forceinline__ unsigned cvt_pk_bf16(float lo, float hi) { unsigned r; asm volatile("v_cvt_pk_bf16_f32 %0, %1, %2" : "=v"(r) : "v"(lo), "v"(hi)); return r; }

__device__ __forceinline__ float row_rstd(const float* ssp, int row) {
    const f32x4* p = (const f32x4*)(ssp + (size_t)row * 16); const f32x4 a = p[0], b = p[1], c = p[2], d = p[3];
    const float s = ((a[0] + a[1]) + (a[2] + a[3])) + ((b[0] + b[1]) + (b[2] + b[3])) + (((c[0] + c[1]) + (c[2] + c[3])) + ((d[0] + d[1]) + (d[2] + d[3])));
    return 1.0f / sqrtf(s * (1.0f / 1024.0f) + 1e-6f);
}
struct EpiBf16 {
    static constexpr bool PERM = true;
    bf16_t* O; int ldc; const float* ssp; int split; bf16_t* O2; int ldc2;
    static constexpr bool HAS_PREP = true;
    __device__ __forceinline__ void prep(const Unit& u, PG8_LAS float* slot) const { if (ssp && threadIdx.x < 256) slot[threadIdx.x] = row_rstd(ssp, u.pm * BM + threadIdx.x); }
    __device__ __forceinline__ void operator()(const f32x4 (&acc)[2][2][4][2], const Unit& u, int wr, int wc, int fr, int fq, const PG8_LAS float* rsl) const {
        const int row0 = u.pm * BM + wr * 64 + fr; bf16_t* base = O; int ld = ldc, pt = u.pnl;
        if (split > 0 && pt >= split) { base = O2; ld = ldc2; pt -= split; }
        const int col0 = pt * BM + wc * 32 + 8 * fq;
        const __amdgpu_buffer_rsrc_t rsrc = __builtin_amdgcn_make_buffer_rsrc(base, 0, 0x7fffffff, 0x00020000);
#pragma unroll
        for (int ai = 0; ai < 2; ++ai)
#pragma unroll
            for (int m = 0; m < 4; ++m) { const int row = row0 + ai * HALF + m * 16; const unsigned boff = (unsigned)(((size_t)row * ld + col0) * 2); const float rs = ssp ? rsl[row - u.pm * BM] : 1.0f;
#pragma unroll
                for (int bj = 0; bj < 2; ++bj) { const f32x4 v0 = acc[ai][bj][m][0] * rs, v1 = acc[ai][bj][m][1] * rs;
                    u32x4 w; w.x = cvt_pk_bf16(v0[0], v0[1]); w.y = cvt_pk_bf16(v0[2], v0[3]); w.z = cvt_pk_bf16(v1[0], v1[1]); w.w = cvt_pk_bf16(v1[2], v1[3]);
                    __builtin_amdgcn_raw_buffer_store_b128(w, rsrc, boff + bj * HALF * 2, 0, 16); } }
    }
};
__device__ __forceinline__ float silu_f(float x) { return x / (1.0f + __expf(-x)); }
__device__ __forceinline__ float clamp8(float x) { return fminf(fmaxf(x, -440.0f), 440.0f); }
__device__ __forceinline__ unsigned pk4_fp8(float a, float b, float c, float d) { int w = __builtin_amdgcn_cvt_pk_fp8_f32(clamp8(a), clamp8(b), 0, false); w = __builtin_amdgcn_cvt_pk_fp8_f32(clamp8(c), clamp8(d), w, true); return (unsigned)w; }
constexpr float F8_WSCALE = 256.0f;
constexpr float F8_ASCALE = 8.0f;
struct EpiSwiglu {
    static constexpr bool PERM = true;
    bf16_t* O; int ldc; const float* ssp;
    static constexpr bool HAS_PREP = true;
    __device__ __forceinline__ void prep(const Unit& u, PG8_LAS float* slot) const { if (threadIdx.x < 256) slot[threadIdx.x] = row_rstd(ssp, u.pm * BM + threadIdx.x); }
    __device__ __forceinline__ void operator()(const f32x4 (&acc)[2][2][4][2], const Unit& u, int wr, int wc, int fr, int fq, const PG8_LAS float* rsl) const {
        const int row0 = u.pm * BM + wr * 64 + fr; const int col0 = u.pnl * HALF + wc * 32 + 8 * fq;
        const __amdgpu_buffer_rsrc_t rsrc = __builtin_amdgcn_make_buffer_rsrc(O, 0, 0x7fffffff, 0x00020000);
#pragma unroll
        for (int ai = 0; ai < 2; ++ai)
#pragma unroll
            for (int m = 0; m < 4; ++m) { const int row = row0 + ai * HALF + m * 16; const unsigned boff = (unsigned)(((size_t)row * ldc + col0) * 2); const float rs = rsl[row - u.pm * BM];
                const f32x4 g0 = acc[ai][0][m][0] * rs, g1 = acc[ai][0][m][1] * rs, u0 = acc[ai][1][m][0] * rs, u1 = acc[ai][1][m][1] * rs;
                u32x4 w; w.x = cvt_pk_bf16(silu_f(g0[0]) * u0[0], silu_f(g0[1]) * u0[1]); w.y = cvt_pk_bf16(silu_f(g0[2]) * u0[2], silu_f(g0[3]) * u0[3]);
                w.z = cvt_pk_bf16(silu_f(g1[0]) * u1[0], silu_f(g1[1]) * u1[1]); w.w = cvt_pk_bf16(silu_f(g1[2]) * u1[2], silu_f(g1[3]) * u1[3]);
                __builtin_amdgcn_raw_buffer_store_b128(w, rsrc, boff, 0, 16); }
    }
};
struct EpiResF32 {
    static constexpr bool PERM = false;
    const float* res; const bf16_t* resb; float* out; int ldc; bf16_t* xh; float* ssp; unsigned char* x8  ;
    static constexpr bool HAS_PREP = false;
    __device__ __forceinline__ void prep(const Unit&, PG8_LAS float*) const {}
    __device__ __forceinline__ void operator()(const f32x4 (&acc)[2][2][4][2], const Unit& u, int wr, int wc, int fr, int fq, const PG8_LAS float*) const {
        const int col0 = u.pnl * BM + wc * 32 + 4 * fq;
#pragma unroll
        for (int ai = 0; ai < 2; ++ai)
#pragma unroll
            for (int m = 0; m < 4; ++m) { const int row = u.pm * BM + ai * HALF + wr * 64 + m * 16 + fr; const size_t off = (size_t)row * ldc + col0; float ss = 0.f;
#pragma unroll
                for (int bj = 0; bj < 2; ++bj)
#pragma unroll
                    for (int n = 0; n < 2; ++n) { f32x4 bs;
                        if (res) bs = *(const f32x4*)(res + off + bj * HALF + n * 16);
                        else { const unsigned long long rb = *(const unsigned long long*)(resb + off + bj * HALF + n * 16); const unsigned lo = (unsigned)rb, hi = (unsigned)(rb >> 32);
                            bs = (f32x4){__builtin_bit_cast(float, lo << 16), __builtin_bit_cast(float, lo & 0xffff0000u), __builtin_bit_cast(float, hi << 16), __builtin_bit_cast(float, hi & 0xffff0000u)}; }
                        const f32x4 o = bs + acc[ai][bj][m][n]; if (out) *(f32x4*)(out + off + bj * HALF + n * 16) = o;
                        ss += (o[0] * o[0] + o[1] * o[1]) + (o[2] * o[2] + o[3] * o[3]);
                        *(unsigned long long*)(xh + off + bj * HALF + n * 16) = (unsigned long long)cvt_pk_bf16(o[0], o[1]) | ((unsigned long long)cvt_pk_bf16(o[2], o[3]) << 32);
                        if (x8) *(unsigned*)(x8 + off + bj * HALF + n * 16) = pk4_fp8(o[0], o[1], o[2], o[3]); }
                ss += __shfl_xor(ss, 16); ss += __shfl_xor(ss, 32);
                if (fq == 0) ssp[(size_t)row * 16 + 4 * u.pnl + wc] = ss; }
    }
};
struct EpiSwigluF8 {
    static constexpr bool PERM = true;
    unsigned char* O; int ldc; const float* rs_e;
    static constexpr bool HAS_PREP = true;
    __device__ __forceinline__ void prep(const Unit& u, PG8_LAS float* slot) const { if (threadIdx.x < 256) slot[threadIdx.x] = (int)threadIdx.x < u.nv ? rs_e[(size_t)u.pa * BM + threadIdx.x] * (1.0f / F8_WSCALE) : 0.f; }
    __device__ __forceinline__ void operator()(const f32x4 (&acc)[2][2][4][2], const Unit& u, int wr, int wc, int fr, int fq, const PG8_LAS float* rsl) const {
        const int row0 = u.pm * BM + wr * 64 + fr; const int col0 = u.pnl * HALF + wc * 32 + 8 * fq;
        const __amdgpu_buffer_rsrc_t rsrc8 = __builtin_amdgcn_make_buffer_rsrc(O, 0, 0x7fffffff, 0x00020000);
#pragma unroll
        for (int ai = 0; ai < 2; ++ai)
#pragma unroll
            for (int m = 0; m < 4; ++m) { const int row = row0 + ai * HALF + m * 16; const unsigned boff = (unsigned)((size_t)row * ldc + col0); const float rs = rsl[row - u.pm * BM];
                const f32x4 g0 = acc[ai][0][m][0] * rs, g1 = acc[ai][0][m][1] * rs, u0 = acc[ai][1][m][0] * (rs * F8_ASCALE), u1 = acc[ai][1][m][1] * (rs * F8_ASCALE);
                const unsigned w0 = pk4_fp8(silu_f(g0[0]) * u0[0], silu_f(g0[1]) * u0[1], silu_f(g0[2]) * u0[2], silu_f(g0[3]) * u0[3]);
                const unsigned w1 = pk4_fp8(silu_f(g1[0]) * u1[0], silu_f(g1[1]) * u1[1], silu_f(g1[2]) * u1[2], silu_f(g1[3]) * u1[3]);
                __builtin_amdgcn_raw_buffer_store_b64((u32x2){w0, w1}, rsrc8, boff, 0, 0); }
    }
};
struct EpiMoeDown {
    static constexpr bool PERM = true;
    bf16_t* Y; int ldc; float scale;
    static constexpr bool HAS_PREP = false;
    __device__ __forceinline__ void prep(const Unit&, PG8_LAS float*) const {}
    __device__ __forceinline__ void operator()(const f32x4 (&acc)[2][2][4][2], const Unit& u, int wr, int wc, int fr, int fq, const PG8_LAS float*) const {
        const int row0 = u.pm * BM + wr * 64 + fr; const int col0 = u.pnl * BM + wc * 32 + 8 * fq;
        const __amdgpu_buffer_rsrc_t rsrc = __builtin_amdgcn_make_buffer_rsrc(Y, 0, 0x7fffffff, 0x00020000);
#pragma unroll
        for (int ai = 0; ai < 2; ++ai)
#pragma unroll
            for (int m = 0; m < 4; ++m) { const unsigned boff = (unsigned)(((size_t)(row0 + ai * HALF + m * 16) * ldc + col0) * 2);
#pragma unroll
                for (int bj = 0; bj < 2; ++bj) { const f32x4 v0 = acc[ai][bj][m][0] * scale, v1 = acc[ai][bj][m][1] * scale;
                    u32x4 w; w.x = cvt_pk_bf16(v0[0], v0[1]); w.y = cvt_pk_bf16(v0[2], v0[3]); w.z = cvt_pk_bf16(v1[0], v1[1]); w.w = cvt_pk_bf16(v1[2], v1[3]);
                    __builtin_amdgcn_raw_buffer_store_b128(w, rsrc, boff + bj * HALF * 2, 0, 16); } }
    }
};

template <class Epi, class Sched, bool ALIGN_EPI, bool F8 = false>
__device__ __forceinline__ void gemm_phase(PG8_LAS unsigned char* lds, const Gemm g, const Sched& S, const Epi& E) {
    const int tid = threadIdx.x, wid = __builtin_amdgcn_readfirstlane(tid >> 6), lane = tid & 63, wr = wid >> 2, wc = wid & 3, fr = lane & 15, fq = lane >> 4;
    constexpr int EB = F8 ? 1 : 2;
    const int K = g.K, nt = K * EB / (BK * 2);
    unsigned voffB[2], voffA[2];
#pragma unroll
    for (int i = 0; i < 2; ++i) { int R, C; stage_rc(tid * 16 + i * 8192, R, C); const int Rb = Epi::PERM ? ((R & ~31) + perm32(R & 31)) : R;
        voffA[i] = (unsigned)(R * K * EB + C * 2); voffB[i] = (unsigned)(Rb * K * EB + C * 2); }
    const size_t kstep = (size_t)(BK * 2);
    const size_t hstep = (size_t)HALF * K * EB;
    const size_t tstep = 2 * hstep;
    const unsigned ldsw = (unsigned)wid * 1024u;
    const int aoff = lds_byte(wr * 64 + fr, fq * (F8 ? 16 : 8)), boff = lds_byte(wc * 32 + fr, fq * (F8 ? 16 : 8));
    typedef int v8i_ __attribute__((ext_vector_type(8))); typedef int v4i_ __attribute__((ext_vector_type(4)));
#define PG8_SA(b, h) (((b) * 2 + (h)) * HTB)
#define PG8_SB(b, h) ((4 + (b) * 2 + (h)) * HTB)
#define PG8_STAGE(bufoff, gbase, voff) do { _Pragma("unroll") for (int _i = 0; _i < 2; ++_i) \
        __builtin_amdgcn_global_load_lds((const unsigned*)((const char*)(gbase) + (voff)[_i]), (PG8_LAS unsigned*)(lds + (bufoff) + ldsw + _i * 8192), 16, 0, 0); } while (0)
#define PG8_LD32(p) __builtin_shufflevector(*(const PG8_LAS v4i_*)(p), *(const PG8_LAS v4i_*)((p) + 16), 0, 1, 2, 3, 4, 5, 6, 7)
#define PG8_LDA(dst, b, h) do { _Pragma("unroll") for (int m = 0; m < 4; ++m) { if constexpr (F8) dst##8[m] = PG8_LD32(lds + PG8_SA(b, h) + aoff + m * 2048); else { _Pragma("unroll") for (int k = 0; k < 2; ++k) dst[m][k] = *(const PG8_LAS bf16x8*)(lds + PG8_SA(b, h) + aoff + m * 2048 + k * 1024); } } } while (0)
#define PG8_LDB(dst, b, h) do { _Pragma("unroll") for (int n = 0; n < 2; ++n) { if constexpr (F8) dst##8[n] = PG8_LD32(lds + PG8_SB(b, h) + boff + n * 2048); else { _Pragma("unroll") for (int k = 0; k < 2; ++k) dst[n][k] = *(const PG8_LAS bf16x8*)(lds + PG8_SB(b, h) + boff + n * 2048 + k * 1024); } } } while (0)
#define PG8_MMA(ai, bj, At, Bt) do { __builtin_amdgcn_s_setprio(1); _Pragma("unroll") for (int m = 0; m < 4; ++m) _Pragma("unroll") for (int n = 0; n < 2; ++n) { \
        if constexpr (F8) acc[ai][bj][m][n] = __builtin_amdgcn_mfma_scale_f32_16x16x128_f8f6f4(Bt##8[n], At##8[m], acc[ai][bj][m][n], 0, 0, 0, 0x7F7F7F7F, 0, 0x7F7F7F7F); \
        else { _Pragma("unroll") for (int k = 0; k < 2; ++k) acc[ai][bj][m][n] = __builtin_amdgcn_mfma_f32_16x16x32_bf16(Bt[n][k], At[m][k], acc[ai][bj][m][n], 0, 0, 0); } } \
        if constexpr (F8) { _Pragma("unroll") for (int m = 0; m < 4; ++m) _Pragma("unroll") for (int n = 0; n < 2; ++n) asm volatile("" : "+v"(acc[ai][bj][m][n])); }     \
        __builtin_amdgcn_s_setprio(0); } while (0)
#define PG8_WAIT_V(n) asm volatile("s_waitcnt vmcnt(" #n ")" ::: "memory")
#define PG8_WAIT_L(n) asm volatile("s_waitcnt lgkmcnt(" #n ")" ::: "memory")
#define PG8_BAR __builtin_amdgcn_s_barrier()
#define PG8_SCHED __builtin_amdgcn_sched_barrier(0)
    Unit cur, nxt; int ui = 0;
    if (!S.next(0, cur)) return;
    f32x4 acc[2][2][4][2];
#pragma unroll
    for (int a = 0; a < 2; ++a)
#pragma unroll
        for (int b = 0; b < 2; ++b)
#pragma unroll
            for (int m = 0; m < 4; ++m)
#pragma unroll
                for (int n = 0; n < 2; ++n) acc[a][b][m][n] = (f32x4){0.f, 0.f, 0.f, 0.f};
    bf16x8 At[4][2], B0[2][2], B1[2][2]; v8i_ At8[4], B08[2], B18[2];
    const char* cA = (const char*)g.A + (size_t)cur.pa * tstep; const char* cB = (const char*)g.Bt + (size_t)cur.pn * tstep;
    PG8_LAS float* const rsl0 = (PG8_LAS float*)(lds + STAGE_BYTES);
    if constexpr (Epi::HAS_PREP) E.prep(cur, rsl0);
    PG8_STAGE(PG8_SB(0, 0), cB, voffB); PG8_STAGE(PG8_SB(0, 1), cB + hstep, voffB); PG8_STAGE(PG8_SA(0, 0), cA, voffA); PG8_STAGE(PG8_SA(0, 1), cA + hstep, voffA);
    if (wr == 1) PG8_BAR;
    PG8_WAIT_V(2); PG8_BAR;
    PG8_STAGE(PG8_SB(1, 0), cB + kstep, voffB); PG8_STAGE(PG8_SA(1, 0), cA + kstep, voffA); PG8_STAGE(PG8_SB(1, 1), cB + hstep + kstep, voffB);
    PG8_WAIT_V(6); PG8_BAR;
    for (;;) {
        const bool has_next = S.next(ui + 1, nxt);
        const char* nA = has_next ? (const char*)g.A + (size_t)nxt.pa * tstep : cA; const char* nB = has_next ? (const char*)g.Bt + (size_t)nxt.pn * tstep : cB;
        for (int t = 0; t < nt; t += 2) {
            const bool last = (t == nt - 2);
            const char* a1 = cA + (size_t)(t + 1) * kstep;
            const char* a2 = last ? nA : cA + (size_t)(t + 2) * kstep; const char* b2 = last ? nB : cB + (size_t)(t + 2) * kstep;
            const char* a3 = a2 + kstep; const char* b3 = b2 + kstep;
            PG8_LDB(B0, 0, 0); PG8_LDB(B1, 0, 1); PG8_SCHED; PG8_LDA(At, 0, 0); PG8_STAGE(PG8_SA(1, 1), a1 + hstep, voffA);
            PG8_WAIT_V(8); PG8_WAIT_L(0); PG8_BAR; PG8_MMA(0, 0, At, B0); PG8_MMA(0, 1, At, B1); PG8_BAR; PG8_SCHED;
            PG8_LDA(At, 0, 1); PG8_STAGE(PG8_SB(0, 0), b2, voffB); PG8_STAGE(PG8_SB(0, 1), b2 + hstep, voffB); PG8_STAGE(PG8_SA(0, 0), a2, voffA);
            PG8_WAIT_V(8); PG8_WAIT_L(0); PG8_BAR; PG8_MMA(1, 0, At, B0); PG8_MMA(1, 1, At, B1); PG8_BAR; PG8_SCHED;
            PG8_LDB(B0, 1, 0); PG8_LDB(B1, 1, 1); PG8_SCHED; PG8_LDA(At, 1, 0); PG8_STAGE(PG8_SA(0, 1), a2 + hstep, voffA);
            PG8_WAIT_V(8); PG8_WAIT_L(0); PG8_BAR; PG8_MMA(0, 0, At, B0); PG8_MMA(0, 1, At, B1); PG8_BAR; PG8_SCHED;
            PG8_LDA(At, 1, 1); PG8_STAGE(PG8_SB(1, 0), b3, voffB); PG8_STAGE(PG8_SB(1, 1), b3 + hstep, voffB); PG8_STAGE(PG8_SA(1, 0), a3, voffA);
            PG8_WAIT_V(8); PG8_WAIT_L(0); PG8_BAR; PG8_MMA(1, 0, At, B0); PG8_MMA(1, 1, At, B1); PG8_BAR; PG8_SCHED;
        }
        if constexpr (ALIGN_EPI) { if (wr == 0) PG8_BAR; }
        E(acc, cur, wr, wc, fr, fq, rsl0 + (ui & 1) * 256);
        if (!has_next) break;
#pragma unroll
        for (int a = 0; a < 2; ++a)
#pragma unroll
            for (int b = 0; b < 2; ++b)
#pragma unroll
                for (int m = 0; m < 4; ++m)
#pragma unroll
                    for (int n = 0; n < 2; ++n) acc[a][b][m][n] = (f32x4){0.f, 0.f, 0.f, 0.f};
        cur = nxt; cA = nA; cB = nB; ++ui;
        if constexpr (Epi::HAS_PREP) E.prep(cur, rsl0 + (ui & 1) * 256);
        if constexpr (ALIGN_EPI) { if (wr == 1) PG8_BAR; }
    }
    PG8_WAIT_V(0);
    if constexpr (!ALIGN_EPI) { if (wr == 0) PG8_BAR; }
    PG8_BAR;
#undef PG8_SA
#undef PG8_SB
#undef PG8_STAGE
#undef PG8_LDA
#undef PG8_LD32
#undef PG8_LDB
#undef PG8_MMA
#undef PG8_WAIT_V
#undef PG8_WAIT_L
#undef PG8_BAR
#undef PG8_SCHED
}
}

constexpr int NWAVES = 8;
constexpr int BATCH = 2, T = 8192, D = 1024, M = BATCH * T;
constexpr int HG_H = 8, HG_DH = 128;
constexpr int NH = 16, NG = 4, HPG = 4, DH = 64;
constexpr int NCMP = 511, NCMPP = 512, NSEL = 128, NTOP = 16, WIN = 512;
constexpr int FF = 2816, NE = 8, EF = 3584;
constexpr int NIN0 = 4 * D;
constexpr int NKV = 1536, NQIN = 1072, NQINP = 1280;
constexpr int NSLOT = 2 * M + NE * 256;
constexpr float NORM_EPS = 1e-6f;

constexpr size_t MiB = 1u << 20;
constexpr size_t WS_CTL = 0, CTL_ZERO_BYTES = 1 * MiB;
constexpr size_t WS_SSP1 = 222 * MiB, WS_SSP2 = 223 * MiB, WS_SSP3 = 8 * MiB;
constexpr size_t WS_LB = 1 * MiB;
constexpr size_t WS_ROUTE = 6 * MiB;
constexpr size_t WS_W_IN0 = 16 * MiB;
constexpr size_t WS_W_OUT0 = 24 * MiB;
constexpr size_t WS_W_GU0 = 26 * MiB;
constexpr size_t WS_W_DN0 = 37 * MiB;
constexpr size_t WS_W_KV = 43 * MiB;
constexpr size_t WS_W_QIN = 46 * MiB;
constexpr size_t WS_W_OUT1 = 49 * MiB;
constexpr size_t WS_W_GU1 = 51 * MiB;
constexpr size_t WS_W_DN1 = 163 * MiB;
constexpr size_t WS_RS_E = 256 * MiB;
constexpr size_t WS_W1T = 219 * MiB;
constexpr size_t WS_W2T = 221 * MiB;
constexpr size_t WS_PB = 221 * MiB + 256 * 1024;
constexpr size_t WS_XN = 224 * MiB;
constexpr size_t WS_KV = 352 * MiB;
constexpr size_t WS_QG = 400 * MiB;
constexpr size_t WS_OATT = 440 * MiB;
constexpr size_t WS_R = 480 * MiB;
constexpr size_t WS_QFIG = WS_R;
constexpr size_t WS_O0 = WS_R + 128 * MiB;
constexpr size_t WS_OG = WS_R + 192 * MiB;
constexpr size_t WS_ACT = WS_R + 288 * MiB;
constexpr size_t WS_ACT2 = WS_R;
constexpr size_t WS_XG8 = WS_R + 120 * MiB;
constexpr size_t WS_Y2 = WS_R + 256 * MiB;
constexpr size_t WS_OACC = WS_R + 272 * MiB;
constexpr size_t WS_END = WS_R + 376 * MiB;
static_assert(WS_ACT2 + (size_t)NSLOT * EF <= WS_XG8 && WS_XG8 + (size_t)NE * M * D <= WS_Y2 && WS_Y2 + (size_t)NSLOT * D * 2 <= WS_END && WS_ACT + (size_t)M * FF * 2 <= WS_END, "d_ws map");
constexpr int CW_TMO = 0;
constexpr int CW_ECNT = 64;
constexpr int CW_BAR = 4096;

constexpr int RING_OFF = 0, RING_BYTES = 131072;
constexpr int LDSCTL_OFF = 147456 - 1024, MISC_OFF = LDSCTL_OFF + 320;
constexpr int LDS_BYTES = 147456;
static_assert(MISC_OFF + 128 <= LDS_BYTES, "LDS map");

#define GAS __attribute__((address_space(1)))
#define LAS __attribute__((address_space(3)))
typedef unsigned short bf16;
typedef unsigned v4u __attribute__((ext_vector_type(4)));
typedef float f32x4 __attribute__((ext_vector_type(4)));
typedef short bf16x8 __attribute__((ext_vector_type(8)));
typedef GAS unsigned gu32;
#define RLX_AGENT __ATOMIC_RELAXED, __HIP_MEMORY_SCOPE_AGENT
#define LDS_WAIT() asm volatile("s_waitcnt lgkmcnt(0)" ::: "memory")
#define VM_WAIT() asm volatile("s_waitcnt vmcnt(0)" ::: "memory")
__device__ __forceinline__ unsigned f2bf(float f) { unsigned u = __builtin_bit_cast(unsigned, f); return (u + 0x7fffu + ((u >> 16) & 1u)) >> 16; }
__device__ __forceinline__ unsigned pk2(float lo, float hi) { return f2bf(lo) | (f2bf(hi) << 16); }
__device__ __forceinline__ float bf2f(unsigned short b) { return __builtin_bit_cast(float, (unsigned)b << 16); }
__device__ __forceinline__ float bflo(unsigned w) { return __builtin_bit_cast(float, w << 16); }
__device__ __forceinline__ float bfhi(unsigned w) { return __builtin_bit_cast(float, w & 0xffff0000u); }
__device__ __forceinline__ float sigmoid_f(float x) { return 1.0f / (1.0f + __expf(-x)); }
#define XB_TMO      128
#define XB_XCNT(j)  (256  + 64 * (j))
#define XB_XSUB(j)  (1280 + 64 * (j))
#define XB_XGEN(j)  (2304 + 64 * (j))
#define XB_TOP      3328
#define XB_TOPGEN   3392
#define XCD_BAR_WORDS 3456
#define XB_SPIN_CAP (1u << 18)

__device__ __forceinline__ unsigned xb_ld(unsigned* p)              { return __hip_atomic_load(p, __ATOMIC_RELAXED, __HIP_MEMORY_SCOPE_AGENT); }
__device__ __forceinline__ unsigned xb_add(unsigned* p, unsigned v) { return __hip_atomic_fetch_add(p, v, __ATOMIC_RELAXED, __HIP_MEMORY_SCOPE_AGENT); }
__device__ __forceinline__ unsigned xb_xcc_id() { return (unsigned)__builtin_amdgcn_s_getreg((3 << 11) | 20) & 0xFu; }
#define XB_SPIN(cond, bar) do { unsigned _sp = 0; while (cond) { __builtin_amdgcn_s_sleep(1); \
    if ((++_sp & 255u) == 0u) { if (xb_ld(&(bar)[XB_TMO])) break; if (_sp > XB_SPIN_CAP) { atomicAdd(&(bar)[XB_TMO], 1u); break; } } } } while (0)

struct XcdBarrier {
    unsigned* bar; unsigned x;
    volatile LAS unsigned* st;
};

__device__ __forceinline__ XcdBarrier xcd_barrier_post(unsigned* bar, volatile LAS unsigned* st) {
    XcdBarrier b; b.bar = bar; b.x = xb_xcc_id(); b.st = st;
    if (threadIdx.x == 0) (void)xb_add(&bar[XB_XCNT(b.x)], 1u);
    return b;
}
__device__ __forceinline__ void xcd_barrier_complete(unsigned* bar, unsigned x, unsigned& nloc, unsigned& nx) {
    const unsigned G = gridDim.x * gridDim.y * gridDim.z;
    unsigned sum, cnt, mine, sp = 0u;
    for (;;) {
        sum = 0u; cnt = 0u; mine = 0u;
#pragma unroll
        for (unsigned j = 0; j < 16; ++j) { const unsigned c = xb_ld(&bar[XB_XCNT(j)]); sum += c; cnt += (c > 0u) ? 1u : 0u; mine = (j == x) ? c : mine; }
        if (sum == G) break;
        __builtin_amdgcn_s_sleep(1);
        if ((++sp & 255u) == 0u) { if (xb_ld(&bar[XB_TMO])) break; if (sp > XB_SPIN_CAP) { atomicAdd(&bar[XB_TMO], 1u); break; } }
    }
    nloc = mine > 0u ? mine : 1u; nx = cnt > 0u ? cnt : 1u;
}

__device__ __forceinline__ void xcd_barrier(const XcdBarrier& b) {
    asm volatile("s_waitcnt vmcnt(0)" ::: "memory");
    __syncthreads();
    if (threadIdx.x == 0) {
        unsigned* bar = b.bar;
        __builtin_amdgcn_s_waitcnt(0);
        unsigned nloc = b.st[0], nx = b.st[1];
        if (nloc == 0u) { xcd_barrier_complete(bar, b.x, nloc, nx); b.st[0] = nloc; b.st[1] = nx; }
        const unsigned old = xb_add(&bar[XB_XSUB(b.x)], 1u);
        const unsigned gen = old / nloc;
        if (old + 1u == (gen + 1u) * nloc) {
            __builtin_amdgcn_fence(__ATOMIC_RELEASE, "agent");
            asm volatile("s_waitcnt vmcnt(0)" ::: "memory");
            const unsigned og = xb_add(&bar[XB_TOP], 1u);
            const unsigned tg = og / nx;
            if (og + 1u == (tg + 1u) * nx) xb_add(&bar[XB_TOPGEN], 1u);
            else XB_SPIN(xb_ld(&bar[XB_TOPGEN]) == tg, bar);
            __builtin_amdgcn_fence(__ATOMIC_ACQUIRE, "agent");
            xb_add(&bar[XB_XGEN(b.x)], 1u);
            asm volatile("s_waitcnt vmcnt(0)" ::: "memory");
        } else {
            XB_SPIN(xb_ld(&bar[XB_XGEN(b.x)]) == gen, bar);
            __builtin_amdgcn_fence(__ATOMIC_ACQUIRE, "agent");
            asm volatile("s_waitcnt vmcnt(0)" ::: "memory");
        }
    }
    __syncthreads();
}

enum InIdx { I_X = 0, I_NORM_MIX = 1, I_NORM_FFN = 2, I_A_W_IN = 3, I_A_W_OUT = 4, I_A_ONORM = 5, I_LB = 6, I_KV_NORM = 7, I_W_KV = 8, I_K_NORM = 9,
             I_CPOS_K = 10, I_CW1_K = 11, I_CW2_K = 12, I_CPOS_V = 13, I_CW1_V = 14, I_CW2_V = 15, I_B_W_IN = 16, I_B_W_OUT = 17, I_B_QNORM = 18, I_REL_BIAS = 19,
             I_FFN_GU = 20, I_FFN_DN = 21, I_MOE_ROUTER = 22, I_MOE_GU = 23, I_MOE_DN = 24, N_IN = 25 };
struct Args { const float* in[N_IN]; float* out; unsigned char* ws; int ph_lo, ph_hi; };
struct Frame {
    LAS unsigned char* lds;
    volatile LAS unsigned* MISC;
    gu32* ctl;
    int tid, lane, wave;
    int vcu, G;
    unsigned char* ws; float* out;
};
__device__ __forceinline__ float wave_sum(float v) {
#pragma unroll
    for (int o = 1; o < 64; o <<= 1) v += __shfl_xor(v, o);
    return v;
}
__device__ __forceinline__ int rel_bucket(int d) {
    d = d < 0 ? 0 : d;
    if (d < 16) return d;
    const float v = logf((float)d / 16.0f) / 4.852030263919617f * 16.0f;
    int lg = 16 + (int)v; return lg < 31 ? lg : 31;
}
__device__ __forceinline__ float gelu_tanh(float x) { const float u = 0.7978845608028654f * (x + 0.044715f * x * x * x); return 0.5f * x * (1.0f + tanhf(u)); }

__device__ __forceinline__ void p0_transpose_item(const float* W, int ldw, int ncols, int K, bf16* WT, int dst_row0, LAS float* scr, int k0, int n0, int lane, const float* gain  ) {
    const int nn = n0 + 4 * (lane & 15); const bool ok = nn + 3 < ncols;
    f32x4 v[16];
#pragma unroll
    for (int i = 0; i < 16; ++i) { const int kk = 4 * i + (lane >> 4); v[i] = ok ? *(const GAS f32x4*)(W + (size_t)(k0 + kk) * ldw + nn) : (f32x4){0.f, 0.f, 0.f, 0.f}; }
#pragma unroll
    for (int i = 0; i < 16; ++i) { const int kk = 4 * i + (lane >> 4); const float gk = gain ? gain[k0 + kk] : 1.0f; LAS float* d = scr + kk * 65 + 4 * (lane & 15);
        d[0] = v[i].x * gk; d[1] = v[i].y * gk; d[2] = v[i].z * gk; d[3] = v[i].w * gk; }
    LDS_WAIT(); asm volatile("" ::: "memory");
#pragma unroll
    for (int i = 0; i < 8; ++i) { const int c = i * 64 + lane, n = c >> 3, kc = c & 7; const LAS float* s = scr + (8 * kc) * 65 + n;
        v4u o; o.x = pk2(s[0 * 65], s[1 * 65]); o.y = pk2(s[2 * 65], s[3 * 65]); o.z = pk2(s[4 * 65], s[5 * 65]); o.w = pk2(s[6 * 65], s[7 * 65]);
        *(GAS v4u*)(WT + (size_t)(dst_row0 + n) * K + k0 + 8 * kc) = o; }
    LDS_WAIT(); asm volatile("" ::: "memory");
}
__device__ __forceinline__ void p0_transpose_item_f8(const float* W, int ldw, int K, unsigned char* WT, int dst_row0, LAS float* scr, int k0, int n0, int lane, const float* gain) {
    const int nn = n0 + 4 * (lane & 15);
    f32x4 v[16];
#pragma unroll
    for (int i = 0; i < 16; ++i) { const int kk = 4 * i + (lane >> 4); v[i] = *(const GAS f32x4*)(W + (size_t)(k0 + kk) * ldw + nn); }
#pragma unroll
    for (int i = 0; i < 16; ++i) { const int kk = 4 * i + (lane >> 4); const float gk = (gain ? gain[k0 + kk] : 1.0f) * pg8::F8_WSCALE; LAS float* d = scr + kk * 65 + 4 * (lane & 15);
        d[0] = v[i].x * gk; d[1] = v[i].y * gk; d[2] = v[i].z * gk; d[3] = v[i].w * gk; }
    LDS_WAIT(); asm volatile("" ::: "memory");
#pragma unroll
    for (int i = 0; i < 4; ++i) { const int c = i * 64 + lane, n = c >> 2, kc = c & 3; const LAS float* s = scr + (16 * kc) * 65 + n;
        v4u o; o.x = pg8::pk4_fp8(s[0 * 65], s[1 * 65], s[2 * 65], s[3 * 65]); o.y = pg8::pk4_fp8(s[4 * 65], s[5 * 65], s[6 * 65], s[7 * 65]);
        o.z = pg8::pk4_fp8(s[8 * 65], s[9 * 65], s[10 * 65], s[11 * 65]); o.w = pg8::pk4_fp8(s[12 * 65], s[13 * 65], s[14 * 65], s[15 * 65]);
        *(GAS v4u*)(WT + (size_t)(dst_row0 + n) * K + k0 + 16 * kc) = o; }
    LDS_WAIT(); asm volatile("" ::: "memory");
}
template <int GU> __device__ __forceinline__ void p0_item_f8(const float* W, int ldw, int npad, int K, unsigned char* WT, LAS float* scr, int r, int lane, const float* gain) {
    const int nblk = npad / 64, kb = r / nblk, nb = r % nblk, n0 = 64 * nb;
    int dst = n0;
    if (GU) { if (n0 < GU) dst = 256 * (n0 / 128) + (n0 % 128); else { const int n1 = n0 - GU; dst = 256 * (n1 / 128) + 128 + (n1 % 128); } }
    p0_transpose_item_f8(W, ldw, K, WT, dst, scr, 64 * kb, n0, lane, gain);
}
template <int GU> __device__ __forceinline__ void p0_item(const float* W, int ldw, int ncols, int npad, int K, bf16* WT, LAS float* scr, int r, int lane, const float* gain = nullptr) {
    const int nblk = npad / 64, kb = r / nblk, nb = r % nblk, n0 = 64 * nb;
    int dst = n0;
    if (GU) { if (n0 < GU) dst = 256 * (n0 / 128) + (n0 % 128); else { const int n1 = n0 - GU; dst = 256 * (n1 / 128) + 128 + (n1 % 128); } }
    p0_transpose_item(W, ldw, ncols, K, WT, dst, scr, 64 * kb, n0, lane, gain);
}
__device__ __forceinline__ void rms_row_to_bf16(const float* xrow, const float* gain, bf16* orow, int lane) {
    const GAS f32x4* xr = (const GAS f32x4*)xrow + lane; const GAS f32x4* gr = (const GAS f32x4*)gain + lane;
    f32x4 v[4]; float s = 0.f;
#pragma unroll
    for (int j = 0; j < 4; ++j) { v[j] = xr[64 * j]; s += (v[j].x * v[j].x + v[j].y * v[j].y) + (v[j].z * v[j].z + v[j].w * v[j].w); }
    const float rstd = 1.0f / sqrtf(wave_sum(s) * (1.f / D) + NORM_EPS);
    GAS unsigned long long* o8 = (GAS unsigned long long*)orow + lane;
#pragma unroll
    for (int j = 0; j < 4; ++j) { const f32x4 gg = gain ? gr[64 * j] : (f32x4){1.f, 1.f, 1.f, 1.f}; o8[64 * j] = (unsigned long long)pk2(v[j].x * rstd * gg.x, v[j].y * rstd * gg.y) | ((unsigned long long)pk2(v[j].z * rstd * gg.z, v[j].w * rstd * gg.w) << 32); }
}
__device__ __forceinline__ void p0_prologue(Frame& F, const Args& a) {
    LAS float* scr = (LAS float*)(F.lds + RING_OFF + F.wave * 16640);
    const int gw = F.vcu * NWAVES + F.wave, NGW = F.G * NWAVES;
    unsigned char* ws = F.ws;
    constexpr int I1 = 16 * 64, I2 = 16 * 16, I3 = 16 * 88, I4 = 44 * 16, I5 = 16 * 24, I6 = 16 * 20, I7 = 16 * 16, I8 = 16 * 112, I9 = 56 * 16;
    constexpr int I10 = 32 * 4, I11 = 4 * 1;
    constexpr int NITEMS = I1 + I2 + I3 + I4 + I5 + I6 + I7 + NE * I8 + NE * I9 + 2 * I10 + 2 * I11;
    for (int it = gw; it < NITEMS; it += NGW) {
        int r = it;
        if (r < I1) { p0_item<0>(a.in[I_A_W_IN], NIN0, NIN0, NIN0, D, (bf16*)(ws + WS_W_IN0), scr, r, F.lane, a.in[I_NORM_MIX]); continue; } r -= I1;
        if (r < I2) { p0_item<0>(a.in[I_A_W_OUT], D, D, D, D, (bf16*)(ws + WS_W_OUT0), scr, r, F.lane); continue; } r -= I2;
        if (r < I3) { p0_item<FF>(a.in[I_FFN_GU], 2 * FF, 2 * FF, 2 * FF, D, (bf16*)(ws + WS_W_GU0), scr, r, F.lane, a.in[I_NORM_FFN]); continue; } r -= I3;
        if (r < I4) { p0_item<0>(a.in[I_FFN_DN], D, D, D, FF, (bf16*)(ws + WS_W_DN0), scr, r, F.lane); continue; } r -= I4;
        if (r < I5) { p0_item<0>(a.in[I_W_KV], NKV, NKV, NKV, D, (bf16*)(ws + WS_W_KV), scr, r, F.lane, a.in[I_KV_NORM]); continue; } r -= I5;
        if (r < I6) { p0_item<0>(a.in[I_B_W_IN], NQIN, NQIN, NQINP, D, (bf16*)(ws + WS_W_QIN), scr, r, F.lane, a.in[I_NORM_MIX] + D); continue; } r -= I6;
        if (r < I7) { p0_item<0>(a.in[I_B_W_OUT], D, D, D, D, (bf16*)(ws + WS_W_OUT1), scr, r, F.lane); continue; } r -= I7;
        if (r < NE * I8) { const int e = r / I8; p0_item_f8<EF>(a.in[I_MOE_GU] + (size_t)e * D * 2 * EF, 2 * EF, 2 * EF, D, (unsigned char*)(ws + WS_W_GU1) + (size_t)e * 2 * EF * D, scr, r % I8, F.lane, a.in[I_NORM_FFN] + D); continue; } r -= NE * I8;
        if (r < NE * I9) { const int e = r / I9; p0_item_f8<0>(a.in[I_MOE_DN] + (size_t)e * EF * D, D, D, EF, (unsigned char*)(ws + WS_W_DN1) + (size_t)e * D * EF, scr, r % I9, F.lane, nullptr); continue; } r -= NE * I9;
        if (r < 2 * I10) { const int kv = r / I10; p0_item<0>(a.in[kv ? I_CW1_V : I_CW1_K], 256, 256, 256, 2048, (bf16*)(ws + WS_W1T) + (size_t)kv * 256 * 2048, scr, r % I10, F.lane); continue; } r -= 2 * I10;
        { const int kv = r / I11; p0_item<0>(a.in[kv ? I_CW2_V : I_CW2_K], 64, 64, 64, 256, (bf16*)(ws + WS_W2T) + (size_t)kv * 64 * 256, scr, r % I11, F.lane); }
    }
    if (blockIdx.x == 0) {
        const float* lbp = a.in[I_LB]; float* lbv = (float*)(ws + WS_LB);
        for (int c = F.tid; c < D; c += NWAVES * 64) { const float p0 = lbp[c], p1 = lbp[D + c], mx = fmaxf(p0, p1), e0 = __expf(p0 - mx), e1 = __expf(p1 - mx); lbv[c] = e0 / (e0 + e1); }
    }
    if (blockIdx.x == 1) {
        const int kv = F.tid >> 8, hidx = F.tid & 255; const float* w1 = a.in[kv ? I_CW1_V : I_CW1_K]; const float* pos = a.in[kv ? I_CPOS_V : I_CPOS_K]; float s = 0.f;
        for (int kk = 0; kk < 2048; ++kk) s += pos[kk] * w1[(size_t)kk * 256 + hidx];
        ((float*)(ws + WS_PB))[kv * 256 + hidx] = s;
    }
    const float* x = a.in[I_X]; const float* gmix = a.in[I_NORM_MIX]; bf16* XN = (bf16*)(ws + WS_XN);
    for (int m = gw; m < M; m += NGW) rms_row_to_bf16(x + (size_t)m * D, nullptr, XN + (size_t)m * D, F.lane);
}


typedef float f32x16 __attribute__((ext_vector_type(16)));
typedef float f32x2v __attribute__((ext_vector_type(2)));
typedef __bf16 bf16x2v __attribute__((ext_vector_type(2)));
#define MFMA32(a, b, c) __builtin_amdgcn_mfma_f32_32x32x16_bf16((a), (b), (c), 0, 0, 0)
constexpr float LOG2E = 1.4426950408889634f;
constexpr size_t WS_QN = WS_R + 336 * MiB;
constexpr size_t WS_VTS = 8 * MiB;
constexpr size_t WS_VTW = WS_R + 368 * MiB;
constexpr size_t WS_KF = WS_R + 240 * MiB;
constexpr size_t WS_VF = WS_R + 248 * MiB;
constexpr size_t WS_KC16 = 2 * MiB;
constexpr size_t WS_VTC = 3 * MiB;
constexpr size_t WS_BLG = 3 * MiB + 512 * 1024;
static_assert(WS_QN + (size_t)M * D * 2 <= WS_VTW && WS_VTW + 8 * MiB <= WS_END && WS_OACC + (size_t)M * D * 4 <= WS_QN, "d_ws map (attention)");
__device__ __forceinline__ int perm16(int x) { const int g4 = (x >> 2) & 3; const int gp = (g4 == 1) ? 2 : ((g4 == 2) ? 1 : g4); return (gp << 2) | (x & 3); }
__device__ __forceinline__ unsigned cvtpk(float lo, float hi) { f32x2v v = {lo, hi}; bf16x2v b = __builtin_convertvector(v, bf16x2v); return __builtin_bit_cast(unsigned, b); }
__device__ __forceinline__ bf16x8 pack8(const f32x16& p, int s) { v4u w; w.x = cvtpk(p[8 * s], p[8 * s + 1]); w.y = cvtpk(p[8 * s + 2], p[8 * s + 3]); w.z = cvtpk(p[8 * s + 4], p[8 * s + 5]); w.w = cvtpk(p[8 * s + 6], p[8 * s + 7]); return __builtin_bit_cast(bf16x8, w); }
__device__ __forceinline__ bf16x8 ldg8(const bf16* p) { return *(const GAS bf16x8*)p; }


constexpr size_t WS_UT = WS_O0;
constexpr size_t WS_ST = WS_ACT;
constexpr size_t WS_DEC = 2 * MiB;
constexpr int HG_SEG = 0, HG_AP = 2048, HG_AQ = HG_AP + 64 * 136 * 2, HG_BP = HG_AQ + 64 * 136 * 2, HG_VT = HG_BP + 64 * 136 * 2, HG_KDT = HG_VT + 128 * 72 * 2, HG_PS = HG_KDT + 128 * 72 * 2;
static_assert(HG_PS + 1024 <= RING_BYTES, "HGRN2 LDS map");
__device__ __forceinline__ void hg_gates_raw(const unsigned short (&rf)[16], float lb, LAS float* SEG, int d, int seg, float (&kk)[16], float (&bb)[16], float& b31, float& blast) {
    float acc = 0.f;
#pragma unroll
    for (int u = 0; u < 16; ++u) { const float f = bf2f(rf[u]); const float g = lb + (1.f - lb) * sigmoid_f(f); kk[u] = 1.f - g; acc += __logf(g); bb[u] = acc; }
    SEG[seg * 128 + d] = acc;
    __syncthreads();
    const float s0 = SEG[d], s1 = SEG[128 + d], s2 = SEG[256 + d], s3 = SEG[384 + d];
    const float pre = seg == 0 ? 0.f : (seg == 1 ? s0 : (seg == 2 ? s0 + s1 : s0 + s1 + s2));
    b31 = s0 + s1; blast = (s0 + s1) + (s2 + s3);
#pragma unroll
    for (int u = 0; u < 16; ++u) bb[u] += pre;
}
__device__ __forceinline__ void p_hg_a(Frame& F) {
    const bf16* QFIG = (const bf16*)(F.ws + WS_QFIG); bf16* UT = (bf16*)(F.ws + WS_UT); float* DEC = (float*)(F.ws + WS_DEC); const float* lbv = (const float*)(F.ws + WS_LB);
    LAS float* SEG = (LAS float*)(F.lds + HG_SEG); LAS unsigned short* VT = (LAS unsigned short*)(F.lds + HG_VT); LAS unsigned short* KDT = (LAS unsigned short*)(F.lds + HG_KDT);
    const int tid = F.tid, lane = F.lane, w = F.wave, d = tid & 127, seg = tid >> 7, l31 = lane & 31, hi = lane >> 5;
    unsigned short rf[16], rv[16];
#define HA_LOAD_RAW(un) do { const int bh_ = (un) >> 7, j_ = (un) & 127; const bf16* r0_ = QFIG + (size_t)((bh_ >> 3) * T + 64 * j_ + 16 * seg) * NIN0 + (bh_ & 7) * 128 + d; \
        _Pragma("unroll") for (int u = 0; u < 16; ++u) { rf[u] = r0_[(size_t)u * NIN0 + D]; rv[u] = r0_[(size_t)u * NIN0 + 2 * D]; } } while (0)
    const int nunits = BATCH * HG_H * (T / 64);
    if (F.vcu < nunits) HA_LOAD_RAW(F.vcu);
    for (int unit = F.vcu; unit < nunits; unit += F.G) {
        const int bh = unit >> 7, h = bh & 7;
        float kk[16], bb[16], b31, blast;
        __syncthreads();
        hg_gates_raw(rf, lbv[h * 128 + d], SEG, d, seg, kk, bb, b31, blast);
#pragma unroll
        for (int u = 0; u < 16; ++u) { KDT[d * 72 + 16 * seg + u] = (unsigned short)f2bf(kk[u] * __expf(blast - bb[u])); VT[d * 72 + 16 * seg + u] = rv[u]; }
        if (seg == 3) DEC[(size_t)unit * 128 + d] = __expf(blast);
        if (unit + F.G < nunits) HA_LOAD_RAW(unit + F.G);
        __syncthreads();
        const int et = w >> 1;
#pragma unroll
        for (int dd = 0; dd < 2; ++dd) { const int dt = (w & 1) * 2 + dd; f32x16 c = (f32x16){0.f,0.f,0.f,0.f,0.f,0.f,0.f,0.f,0.f,0.f,0.f,0.f,0.f,0.f,0.f,0.f};
#pragma unroll
            for (int ks = 0; ks < 4; ++ks) { const bf16x8 av = *(const LAS bf16x8*)(VT + (32 * et + l31) * 72 + 16 * ks + 8 * hi), bv = *(const LAS bf16x8*)(KDT + (32 * dt + l31) * 72 + 16 * ks + 8 * hi); c = MFMA32(av, bv, c); }
            bf16* up = UT + ((size_t)unit * 128 + 32 * et + 4 * hi) * 128 + 32 * dt + l31;
#pragma unroll
            for (int r = 0; r < 16; ++r) up[(size_t)((r & 3) + 8 * (r >> 2)) * 128] = (bf16)f2bf(c[r]); }
    }
#undef HA_LOAD_RAW
}
__device__ __forceinline__ void p_hg_b(Frame& F) {
    const unsigned* UT = (const unsigned*)(F.ws + WS_UT); unsigned* ST = (unsigned*)(F.ws + WS_ST); const float* DEC = (const float*)(F.ws + WS_DEC);
    const int gt = F.vcu * (NWAVES * 64) + F.tid, NT = F.G * NWAVES * 64;
    for (int idx = gt; idx < BATCH * HG_H * 128 * 64; idx += NT) {
        const int bh = idx >> 13, e = (idx >> 6) & 127, dp = idx & 63;
        float s0 = 0.f, s1 = 0.f;
        size_t off = ((size_t)(bh * 128) * 128 + e) * 64 + dp;
        const float* dc = DEC + (size_t)(bh * 128) * 128 + 2 * dp;
        for (int j0 = 0; j0 < 128; j0 += 8) {
            unsigned uu[8]; f32x2v dd[8];
#pragma unroll
            for (int k = 0; k < 8; ++k) { uu[k] = UT[off + (size_t)(j0 + k) * 128 * 64]; dd[k] = *(const GAS f32x2v*)(dc + (size_t)(j0 + k) * 128); }
#pragma unroll
            for (int k = 0; k < 8; ++k) { ST[off + (size_t)(j0 + k) * 128 * 64] = pk2(s0, s1); s0 = dd[k].x * s0 + bflo(uu[k]); s1 = dd[k].y * s1 + bfhi(uu[k]); }
        }
    }
}
__device__ __forceinline__ void p_hg_c(Frame& F, const float* gon) {
    const bf16* QFIG = (const bf16*)(F.ws + WS_QFIG); const bf16* ST = (const bf16*)(F.ws + WS_ST); bf16* OG = (bf16*)(F.ws + WS_OG); const float* lbv = (const float*)(F.ws + WS_LB);
    LAS float* SEG = (LAS float*)(F.lds + HG_SEG); LAS unsigned short* AP = (LAS unsigned short*)(F.lds + HG_AP); LAS unsigned short* AQ = (LAS unsigned short*)(F.lds + HG_AQ);
    LAS unsigned short* BP = (LAS unsigned short*)(F.lds + HG_BP); LAS unsigned short* VT = (LAS unsigned short*)(F.lds + HG_VT); LAS float* PS = (LAS float*)(F.lds + HG_PS);
    const int tid = F.tid, lane = F.lane, w = F.wave, d = tid & 127, seg = tid >> 7, l31 = lane & 31, hi = lane >> 5;
    const int st = w & 1, et = w >> 1;
    unsigned short rq[16], rf[16], rv[16]; bf16x8 sfr[8];
#define HC_LOAD_RAW(un) do { const int bh_ = (un) >> 7, j_ = (un) & 127; const bf16* r0_ = QFIG + (size_t)((bh_ >> 3) * T + 64 * j_ + 16 * seg) * NIN0 + (bh_ & 7) * 128 + d; \
        _Pragma("unroll") for (int u = 0; u < 16; ++u) { rq[u] = r0_[(size_t)u * NIN0]; rf[u] = r0_[(size_t)u * NIN0 + D]; rv[u] = r0_[(size_t)u * NIN0 + 2 * D]; } } while (0)
#define HC_LOAD_ST(un) do { const bf16* sp_ = ST + ((size_t)(un) * 128 + 32 * et + l31) * 128 + 8 * hi; _Pragma("unroll") for (int ks = 0; ks < 8; ++ks) sfr[ks] = ldg8(sp_ + 16 * ks); } while (0)
    const int nunits = BATCH * HG_H * (T / 64);
    if (F.vcu < nunits) { HC_LOAD_RAW(F.vcu); HC_LOAD_ST(F.vcu); }
    for (int unit = F.vcu; unit < nunits; unit += F.G) {
        const int bh = unit >> 7, j = unit & 127, b = bh >> 3, h = bh & 7;
        float kk[16], bb[16], b31, blast;
        __syncthreads();
        hg_gates_raw(rf, lbv[h * 128 + d], SEG, d, seg, kk, bb, b31, blast);
        const float eb31 = __expf(b31);
#pragma unroll
        for (int u = 0; u < 16; ++u) { const int tok = 16 * seg + u; const float q = bf2f(rq[u]);
            const float er = __expf(bb[u] - b31);
            AP[tok * 136 + d] = (unsigned short)f2bf(q * er); AQ[tok * 136 + d] = (unsigned short)f2bf(q * er * eb31);
            BP[tok * 136 + d] = (unsigned short)f2bf(kk[u] * __builtin_amdgcn_rcpf(er)); VT[d * 72 + 16 * seg + perm16(u)] = rv[u]; }
        if (unit + F.G < nunits) HC_LOAD_RAW(unit + F.G);
        __syncthreads();
        f32x16 o = (f32x16){0.f,0.f,0.f,0.f,0.f,0.f,0.f,0.f,0.f,0.f,0.f,0.f,0.f,0.f,0.f,0.f};
#pragma unroll
        for (int ks = 0; ks < 8; ++ks) { const bf16x8 bv = *(const LAS bf16x8*)(AQ + (32 * st + l31) * 136 + 16 * ks + 8 * hi); o = MFMA32(sfr[ks], bv, o); }
        if (unit + F.G < nunits) HC_LOAD_ST(unit + F.G);
        for (int ut = 0; ut <= st; ++ut) { f32x16 at = (f32x16){0.f,0.f,0.f,0.f,0.f,0.f,0.f,0.f,0.f,0.f,0.f,0.f,0.f,0.f,0.f,0.f};
#pragma unroll
            for (int ks = 0; ks < 8; ++ks) { const bf16x8 av = *(const LAS bf16x8*)(BP + (32 * ut + l31) * 136 + 16 * ks + 8 * hi), bv = *(const LAS bf16x8*)(AP + (32 * st + l31) * 136 + 16 * ks + 8 * hi); at = MFMA32(av, bv, at); }
            if (ut == st) {
#pragma unroll
                for (int r = 0; r < 16; ++r) at[r] = ((r & 3) + 8 * (r >> 2) + 4 * hi <= l31) ? at[r] : 0.f; }
            const bf16x8 pb0 = pack8(at, 0), pb1 = pack8(at, 1);
            const bf16x8 v0 = *(const LAS bf16x8*)(VT + (32 * et + l31) * 72 + 32 * ut + 8 * hi), v1 = *(const LAS bf16x8*)(VT + (32 * et + l31) * 72 + 32 * ut + 16 + 8 * hi);
            o = MFMA32(v0, pb0, o); o = MFMA32(v1, pb1, o); }
        float ss = 0.f;
#pragma unroll
        for (int r = 0; r < 16; ++r) ss += o[r] * o[r];
        ss += __shfl_xor(ss, 32);
        if (hi == 0) PS[et * 64 + 32 * st + l31] = ss;
        __syncthreads();
        const int s = 32 * st + l31; const float tot = (PS[s] + PS[64 + s]) + (PS[128 + s] + PS[192 + s]);
        const float rstd = 1.0f / sqrtf(tot * (1.f / 128.f) + NORM_EPS);
        const size_t mrow = (size_t)b * T + 64 * j + s;
        const bf16* gp = QFIG + mrow * NIN0 + 3 * D + h * 128 + 32 * et + 4 * hi; bf16* op = OG + mrow * D + h * 128 + 32 * et + 4 * hi; const float* gop = gon + 32 * et + 4 * hi;
#pragma unroll
        for (int q4 = 0; q4 < 4; ++q4) { const unsigned long long gw8 = *(const GAS unsigned long long*)(gp + 8 * q4); const unsigned glo = (unsigned)gw8, ghi = (unsigned)(gw8 >> 32); const f32x4 go = *(const GAS f32x4*)(gop + 8 * q4);
            const float a0 = bflo(glo), a1 = bfhi(glo), a2 = bflo(ghi), a3 = bfhi(ghi);
            const float y0 = o[4 * q4] * rstd * go.x * (a0 * sigmoid_f(a0)), y1 = o[4 * q4 + 1] * rstd * go.y * (a1 * sigmoid_f(a1)), y2 = o[4 * q4 + 2] * rstd * go.z * (a2 * sigmoid_f(a2)), y3 = o[4 * q4 + 3] * rstd * go.w * (a3 * sigmoid_f(a3));
            *(GAS unsigned long long*)(op + 8 * q4) = (unsigned long long)cvtpk(y0, y1) | ((unsigned long long)cvtpk(y2, y3) << 32); }
    }
}

__device__ __forceinline__ void p_knorm(Frame& F, const float* kng) {
    bf16* KV = (bf16*)(F.ws + WS_KV);
    const int gt = F.vcu * (NWAVES * 64) + F.tid, NT = F.G * NWAVES * 64;
    for (int idx = gt; idx < M * 8; idx += NT) {
        const int m = idx >> 3, j = idx & 7; const int col0 = j < 4 ? 512 + 64 * j : 1024 + 64 * (j - 4); const float* gain = kng + (j < 4 ? 64 : 128);
        GAS v4u* p = (GAS v4u*)(KV + (size_t)m * NKV + col0);
        v4u w[8]; float ss = 0.f;
#pragma unroll
        for (int i = 0; i < 8; ++i) { w[i] = p[i];
#pragma unroll
            for (int k = 0; k < 4; ++k) { const float a = bflo(w[i][k]), b = bfhi(w[i][k]); ss += a * a + b * b; } }
        const float rstd = 1.0f / sqrtf(ss * (1.f / 64.f) + NORM_EPS);
#pragma unroll
        for (int i = 0; i < 8; ++i) { v4u o;
#pragma unroll
            for (int k = 0; k < 4; ++k) o[k] = pk2(bflo(w[i][k]) * rstd * gain[8 * i + 2 * k], bfhi(w[i][k]) * rstd * gain[8 * i + 2 * k + 1]);
            p[i] = o;
            if (j < 4) { const int bq = m >> 13, tq = m & (T - 1);
                ((v4u*)(F.ws + WS_KF))[(size_t)((((bq * 4 + j) * 128 + (tq >> 6)) * 2 + ((tq >> 5) & 1)) * 4 + (i >> 1)) * 64 + (i & 1) * 32 + (tq & 31)] = o; } }
    }
}
__device__ __forceinline__ void p_route(Frame& F, const Args& a, bool dry = false) {
    const float* H3 = F.out; const float* gain = a.in[I_NORM_FFN] + D; const float* wr = a.in[I_MOE_ROUTER];
    unsigned* route = (unsigned*)(F.ws + WS_ROUTE); gu32* ecnt = F.ctl + CW_ECNT;
    const int gw = F.vcu * NWAVES + F.wave, NGW = F.G * NWAVES;
    for (int m = gw; m < M; m += NGW) {
        const GAS f32x4* xr = (const GAS f32x4*)(H3 + (size_t)m * D) + F.lane; const GAS f32x4* gr = (const GAS f32x4*)gain + F.lane;
        f32x4 v[4]; float s = 0.f;
#pragma unroll
        for (int j = 0; j < 4; ++j) { v[j] = xr[64 * j]; s += (v[j].x * v[j].x + v[j].y * v[j].y) + (v[j].z * v[j].z + v[j].w * v[j].w); }
        const float rstd = 1.0f / sqrtf(wave_sum(s) * (1.f / D) + NORM_EPS);
        float lg[8];
#pragma unroll
        for (int e = 0; e < 8; ++e) lg[e] = 0.f;
#pragma unroll
        for (int j = 0; j < 4; ++j) { const f32x4 gg = gr[64 * j]; const f32x4 y = (f32x4){v[j].x * rstd * gg.x, v[j].y * rstd * gg.y, v[j].z * rstd * gg.z, v[j].w * rstd * gg.w};
            const GAS f32x4* wp = (const GAS f32x4*)(wr + (size_t)(256 * j + 4 * F.lane) * 8);
#pragma unroll
            for (int k = 0; k < 4; ++k) { const f32x4 w0 = wp[2 * k], w1 = wp[2 * k + 1]; const float yk = y[k];
                lg[0] += yk * w0.x; lg[1] += yk * w0.y; lg[2] += yk * w0.z; lg[3] += yk * w0.w; lg[4] += yk * w1.x; lg[5] += yk * w1.y; lg[6] += yk * w1.z; lg[7] += yk * w1.w; } }
#pragma unroll
        for (int e = 0; e < 8; ++e) lg[e] = wave_sum(lg[e]);
        if (dry) continue;
        int e0 = 0; float v0 = lg[0];
#pragma unroll
        for (int e = 1; e < 8; ++e) if (lg[e] > v0) { v0 = lg[e]; e0 = e; }
        int e1 = -1; float v1 = -3.0e38f;
#pragma unroll
        for (int e = 0; e < 8; ++e) if (e != e0 && lg[e] > v1) { v1 = lg[e]; e1 = e; }
        const float w0 = 1.0f / (1.0f + __expf(v1 - v0)), w1 = 1.0f - w0;
        unsigned p0 = 0u, p1 = 0u;
        if (F.lane == 0) { p0 = __hip_atomic_fetch_add(ecnt + e0, 1u, RLX_AGENT); p1 = __hip_atomic_fetch_add(ecnt + e1, 1u, RLX_AGENT);
            unsigned* r = route + (size_t)m * 8; r[0] = (unsigned)e0; r[1] = (unsigned)e1; r[2] = p0; r[3] = p1; r[4] = __float_as_uint(w0); r[5] = __float_as_uint(w1);
            float* rse = (float*)(F.ws + WS_RS_E); rse[(size_t)e0 * M + p0] = rstd; rse[(size_t)e1 * M + p1] = rstd; }
        p0 = (unsigned)__builtin_amdgcn_readfirstlane((int)p0); p1 = (unsigned)__builtin_amdgcn_readfirstlane((int)p1);
        unsigned char* x0 = (unsigned char*)(F.ws + WS_XG8) + ((size_t)e0 * M + p0) * D, *x1 = (unsigned char*)(F.ws + WS_XG8) + ((size_t)e1 * M + p1) * D;
#pragma unroll
        for (int j = 0; j < 4; ++j) { const unsigned w8 = pg8::pk4_fp8(v[j].x, v[j].y, v[j].z, v[j].w); ((GAS unsigned*)(x0 + 256 * j))[F.lane] = w8; ((GAS unsigned*)(x1 + 256 * j))[F.lane] = w8; }
    }
}
struct MoeOrder {
    int cn[8]; int ncol, G, c; bool apm;
    __device__ __forceinline__ void init(const gu32* cnt, int ncol_, int G_, int c_, bool apm_) { ncol = ncol_; G = G_; c = c_; apm = apm_;
#pragma unroll
        for (int e = 0; e < 8; ++e) cn[e] = __builtin_amdgcn_readfirstlane((int)__hip_atomic_load(cnt + e, RLX_AGENT)); }
    __device__ __forceinline__ bool next(int i, pg8::Unit& u) const {
        const int L = i * G + c; int base = 0, tiles = 0; bool found = false;
#pragma unroll
        for (int e = 0; e < 8; ++e) { const int n = (cn[e] + 255) >> 8; const int units = n * ncol;
            if (!found && L < base + units) { found = true; const int r = L - base; u.pnl = r / n; const int rt = r - u.pnl * n; u.pm = tiles + rt; u.pn = e * ncol + u.pnl; u.pa = apm ? e * (M / 256) + rt : u.pm; u.nv = cn[e] - 256 * rt; }
            base += units; tiles += n; }
        return found;
    }
};

__device__ __forceinline__ void p_moe_combine(Frame& F) {
    const unsigned* route = (const unsigned*)(F.ws + WS_ROUTE); const bf16* Y = (const bf16*)(F.ws + WS_Y2); float* out = F.out;
    const int gw = F.vcu * NWAVES + F.wave, NGW = F.G * NWAVES;
    int off[9]; off[0] = 0;
#pragma unroll
    for (int e = 0; e < 8; ++e) off[e + 1] = off[e] + (((int)__hip_atomic_load(F.ctl + CW_ECNT + e, RLX_AGENT) + 255) & ~255);
    for (int m = gw; m < M; m += NGW) { const unsigned* r = route + (size_t)m * 8; const float w0 = __uint_as_float(r[4]), w1 = __uint_as_float(r[5]); const int e0 = (int)r[0], e1 = (int)r[1];
        int o0 = 0, o1 = 0;
#pragma unroll
        for (int e = 0; e < 8; ++e) { o0 = (e == e0) ? off[e] : o0; o1 = (e == e1) ? off[e] : o1; }
        const int s0 = o0 + (int)r[2], s1 = o1 + (int)r[3];
        GAS f32x4* o = (GAS f32x4*)(out + (size_t)m * D) + F.lane;
        const GAS unsigned long long* y0 = (const GAS unsigned long long*)(Y + (size_t)s0 * D) + F.lane; const GAS unsigned long long* y1 = (const GAS unsigned long long*)(Y + (size_t)s1 * D) + F.lane;
#pragma unroll
        for (int j = 0; j < 4; ++j) { f32x4 v = o[64 * j]; const unsigned long long a = y0[64 * j], b = y1[64 * j];
            v.x += w0 * bflo((unsigned)a) + w1 * bflo((unsigned)b); v.y += w0 * bfhi((unsigned)a) + w1 * bfhi((unsigned)b);
            v.z += w0 * bflo((unsigned)(a >> 32)) + w1 * bflo((unsigned)(b >> 32)); v.w += w0 * bfhi((unsigned)(a >> 32)) + w1 * bfhi((unsigned)(b >> 32));
            o[64 * j] = v; } }
}

__device__ __forceinline__ void p_compress_mfma(Frame& F, const float* kng0) {
    const bf16* KV = (const bf16*)(F.ws + WS_KV); const bf16* W1T = (const bf16*)(F.ws + WS_W1T); const bf16* W2T = (const bf16*)(F.ws + WS_W2T); const float* PB = (const float*)(F.ws + WS_PB);
    LAS unsigned short* TK = (LAS unsigned short*)(F.lds);
    LAS unsigned short* HD = TK + 528 * 72;
    const int tid = F.tid, lane = F.lane, w = F.wave, l31 = lane & 31, hi = lane >> 5;
    for (int unit = F.vcu; unit < 256; unit += F.G) {
        const int kvsel = unit >> 7, bg = (unit >> 4) & 7, rg = unit & 15, n0 = 32 * rg, b = bg >> 2, g = bg & 3;
        const int col0 = kvsel * 256 + g * 64;
        __syncthreads();
        for (int c = tid; c < 528 * 8; c += NWAVES * 64) { const int row = c >> 3, part = c & 7; int tok = 16 * n0 + row; tok = tok < T ? tok : T - 1;
            const v4u val = *(const GAS v4u*)(KV + (size_t)(b * T + tok) * NKV + col0 + 8 * part);
            *(LAS v4u*)(TK + ((row & 15) * 33 + (row >> 4)) * 72 + 8 * part) = val; }
        __syncthreads();
        f32x16 acc = (f32x16){0.f,0.f,0.f,0.f,0.f,0.f,0.f,0.f,0.f,0.f,0.f,0.f,0.f,0.f,0.f,0.f};
        const bf16* bp = W1T + (size_t)(kvsel * 256 + 32 * w + l31) * 2048 + 8 * hi;
        for (int k0 = 0; k0 < 128; k0 += 16) { bf16x8 bv[16];
#pragma unroll
            for (int i = 0; i < 16; ++i) bv[i] = ldg8(bp + 16 * (k0 + i));
#pragma unroll
            for (int i = 0; i < 16; ++i) { const int ks = k0 + i, j = ks >> 2, d0 = 16 * (ks & 3) + 8 * hi;
                const bf16x8 av = *(const LAS bf16x8*)(TK + ((j & 15) * 33 + l31 + (j >> 4)) * 72 + d0);   acc = MFMA32(av, bv[i], acc); } }
        { const float pb = PB[kvsel * 256 + 32 * w + l31];
#pragma unroll
          for (int r = 0; r < 16; ++r) HD[((r & 3) + 8 * (r >> 2) + 4 * hi) * 264 + 32 * w + l31] = (unsigned short)f2bf(gelu_tanh(acc[r] + pb)); }
        __syncthreads();
        if (w == 0) {
            f32x16 c2[2]; c2[0] = (f32x16){0.f,0.f,0.f,0.f,0.f,0.f,0.f,0.f,0.f,0.f,0.f,0.f,0.f,0.f,0.f,0.f}; c2[1] = c2[0];
#pragma unroll
            for (int mt = 0; mt < 2; ++mt) { const bf16* ap = W2T + (size_t)(kvsel * 64 + 32 * mt + l31) * 256 + 8 * hi;
#pragma unroll
                for (int ks = 0; ks < 16; ++ks) { const bf16x8 av = ldg8(ap + 16 * ks), bv = *(const LAS bf16x8*)(HD + l31 * 264 + 16 * ks + 8 * hi); c2[mt] = MFMA32(av, bv, c2[mt]); } }
            const int n = n0 + l31; const bool ok = n < NCMP;
            if (kvsel == 0) { float ss = 0.f;
#pragma unroll
                for (int mt = 0; mt < 2; ++mt)
#pragma unroll
                    for (int r = 0; r < 16; ++r) ss += c2[mt][r] * c2[mt][r];
                ss += __shfl_xor(ss, 32);
                const float rstd = ok ? 1.0f / sqrtf(ss * (1.f / 64.f) + NORM_EPS) : 0.f;
                bf16* kp = (bf16*)(F.ws + WS_KC16) + (size_t)(bg * NCMPP + n) * 64 + 4 * hi;
#pragma unroll
                for (int mt = 0; mt < 2; ++mt)
#pragma unroll
                    for (int q4 = 0; q4 < 4; ++q4) { const f32x4 gg = *(const GAS f32x4*)(kng0 + 32 * mt + 8 * q4 + 4 * hi);
                        *(GAS unsigned long long*)(kp + 32 * mt + 8 * q4) = (unsigned long long)cvtpk(c2[mt][4 * q4] * rstd * gg.x, c2[mt][4 * q4 + 1] * rstd * gg.y) | ((unsigned long long)cvtpk(c2[mt][4 * q4 + 2] * rstd * gg.z, c2[mt][4 * q4 + 3] * rstd * gg.w) << 32); }
            } else { bf16* vp = (bf16*)(F.ws + WS_VTC) + (size_t)(bg * 64 + 4 * hi) * NCMPP + (n & ~15) + perm16(n & 15);
#pragma unroll
                for (int mt = 0; mt < 2; ++mt)
#pragma unroll
                    for (int r = 0; r < 16; ++r) vp[(size_t)(32 * mt + (r & 3) + 8 * (r >> 2)) * NCMPP] = (bf16)f2bf(ok ? c2[mt][r] : 0.f); }
        }
    }
}
__device__ __forceinline__ void p_qnorm(Frame& F, const float* gq) {
    const bf16* QG = (const bf16*)(F.ws + WS_QG); bf16* QN = (bf16*)(F.ws + WS_QN);
    const int gt = F.vcu * (NWAVES * 64) + F.tid, NT = F.G * NWAVES * 64;
    for (int idx = gt; idx < M * NH; idx += NT) { const int m = idx >> 4, h = idx & 15;
        const GAS v4u* p = (const GAS v4u*)(QG + (size_t)m * NQINP + h * 64); GAS v4u* o = (GAS v4u*)(QN + (size_t)m * D + h * 64);
        v4u w[8]; float ss = 0.f;
#pragma unroll
        for (int i = 0; i < 8; ++i) { w[i] = p[i];
#pragma unroll
            for (int k = 0; k < 4; ++k) { const float x0 = bflo(w[i][k]), x1 = bfhi(w[i][k]); ss += x0 * x0 + x1 * x1; } }
        const float rs = (0.125f * LOG2E) / sqrtf(ss * (1.f / 64.f) + NORM_EPS);
#pragma unroll
        for (int i = 0; i < 8; ++i) { v4u r;
#pragma unroll
            for (int k = 0; k < 4; ++k) r[k] = cvtpk(bflo(w[i][k]) * rs * gq[8 * i + 2 * k], bfhi(w[i][k]) * rs * gq[8 * i + 2 * k + 1]);
            o[i] = r; } }
}
__device__ __forceinline__ void p_vtrans(Frame& F) {
    const bf16* KV = (const bf16*)(F.ws + WS_KV);
    LAS unsigned short* scr = (LAS unsigned short*)(F.lds + F.wave * 8192);
    const int gw = F.vcu * NWAVES + F.wave, NGW = F.G * NWAVES, lane = F.lane;
    for (int item = gw; item < 2 * 8 * (T / 64); item += NGW) {
        const int which = item >> 10, bg = (item >> 7) & 7, tile = item & 127, b = bg >> 2, g = bg & 3;
        const GAS v4u* p = (const GAS v4u*)(KV + (size_t)(b * T + 64 * tile + lane) * NKV + (which ? 1280 : 768) + 64 * g);
        const int posn = (lane & ~15) + perm16(lane & 15);
#pragma unroll
        for (int i = 0; i < 8; ++i) { const v4u w = p[i];
#pragma unroll
            for (int k = 0; k < 4; ++k) { scr[(8 * i + 2 * k) * 64 + posn] = (unsigned short)(w[k] & 0xffffu); scr[(8 * i + 2 * k + 1) * 64 + posn] = (unsigned short)(w[k] >> 16); } }
        LDS_WAIT(); asm volatile("" ::: "memory");
        bf16* VT = (bf16*)(F.ws + (which ? WS_VTW : WS_VTS));
        GAS v4u* o = (GAS v4u*)(VT + (size_t)(bg * 64 + lane) * T + 64 * tile); const LAS v4u* s = (const LAS v4u*)(scr + lane * 64);
#pragma unroll
        for (int i = 0; i < 8; ++i) o[i] = s[i];
        if (which == 0) { v4u* VF = (v4u*)(F.ws + WS_VF);
#pragma unroll
            for (int i = 0; i < 8; ++i) VF[(size_t)(((((bg * 128 + tile) * 2 + (i >> 2)) * 2 + (lane >> 5)) * 2 + ((i >> 1) & 1)) * 64) + (i & 1) * 32 + (lane & 31)] = s[i]; }
        LDS_WAIT(); asm volatile("" ::: "memory");
    }
}

__device__ __forceinline__ void p_biaslut(Frame& F, const float* relb) {
    float* BLG = (float*)(F.ws + WS_BLG);
    const int gt = F.vcu * (NWAVES * 64) + F.tid, NT = F.G * NWAVES * 64;
    for (int idx = gt; idx < NH * 2048; idx += NT) { const int h = idx >> 11, d = idx & 2047; BLG[idx] = relb[rel_bucket(d) * NH + h] * LOG2E; }
}

template <int MASK, int DS> __device__ __forceinline__ float st_softmax(f32x16& st, int dbase, const LAS float* blp, float scale) {
    float l = 0.f; asm volatile("" : "+v"(dbase));
#pragma unroll
    for (int r = 0; r < 16; ++r) { const int d = dbase - DS * ((r & 3) + 8 * (r >> 2)); int di = d < 0 ? 0 : d; di = di > 2047 ? 2047 : di;
        float e = __builtin_amdgcn_exp2f(st[r] + blp[di]) * scale;
        if (MASK == 1) e = d >= 0 ? e : 0.f;
        if (MASK == 2) e = (d >= 0 && d < WIN) ? e : 0.f;
        st[r] = e; l += e; }
    return l;
}
template <int DS> __device__ __forceinline__ float st_softmax_in(f32x16& st, int dbase, const LAS float* blp, float scale) {
    float l = 0.f; const LAS float* bp = blp + (dbase - 27 * DS); asm volatile("" : "+v"(bp));
#pragma unroll
    for (int r = 0; r < 16; ++r) { const float e = __builtin_amdgcn_exp2f(st[r] + bp[(27 - ((r & 3) + 8 * (r >> 2))) * DS]) * scale; st[r] = e; l += e; }
    return l;
}
constexpr float OFIX = 1024.0f, LFIX = 256.0f;
#ifndef REP_SUB
#define REP_SUB 0
#endif
#define SUBREP(k) for (int rep_ = 0; rep_ < (REP_SUB == (k) ? 2 : 1); ++rep_) if (const float rs_ = rep_ ? 0.f : 1.f; true)
__device__ __forceinline__ float st_softmax_far(f32x16& st, float cb, float scale) {
    float l = 0.f;
#pragma unroll
    for (int r = 0; r < 16; ++r) { const float e = __builtin_amdgcn_exp2f(st[r] + cb) * scale; st[r] = e; l += e; }
    return l;
}
#define DENSE_STK(buf) (*(LAS v4u*)(KT + (buf) * 4608 + (tio >> 3) * 72 + 8 * (tio & 7)) = kreg)
#define DENSE_STV(buf) (*(LAS v4u*)(VTT + (buf) * 4608 + (tio >> 3) * 72 + 8 * (tio & 7)) = vreg)
#define DENSE_LDK(kf, buf, sub) do { _Pragma("unroll") for (int _k = 0; _k < 4; ++_k) kf[_k] = *(const LAS bf16x8*)(KT + (buf) * 4608 + (32 * (sub) + (lane & 31)) * 72 + 16 * _k + 8 * hi); } while (0)
#define DENSE_LDV(vf, buf, sub) do { _Pragma("unroll") for (int _m = 0; _m < 2; ++_m) _Pragma("unroll") for (int _s = 0; _s < 2; ++_s) vf[_m][_s] = *(const LAS bf16x8*)(VTT + (buf) * 4608 + (32 * _m + (lane & 31)) * 72 + 32 * (sub) + 16 * _s + 8 * hi); } while (0)
#define NSA_LDK(kf, base) do { _Pragma("unroll") for (int _k = 0; _k < 4; ++_k) kf[_k] = ldg8((base) + 16 * _k); } while (0)
#define NSA_QK(st, kf, qf) do { st = (f32x16){0.f,0.f,0.f,0.f,0.f,0.f,0.f,0.f,0.f,0.f,0.f,0.f,0.f,0.f,0.f,0.f}; _Pragma("unroll") for (int _k = 0; _k < 4; ++_k) st = MFMA32(kf[_k], qf[_k], st); } while (0)

__device__ __forceinline__ void p_nsa(Frame& F, const Args& a) {
    const bf16* QN = (const bf16*)(F.ws + WS_QN); const bf16* QG = (const bf16*)(F.ws + WS_QG); const bf16* KV = (const bf16*)(F.ws + WS_KV);
    const bf16* KC = (const bf16*)(F.ws + WS_KC16); const bf16* VTC = (const bf16*)(F.ws + WS_VTC); const bf16* VTS = (const bf16*)(F.ws + WS_VTS); const bf16* VTW = (const bf16*)(F.ws + WS_VTW);
    const float* BLG = (const float*)(F.ws + WS_BLG); bf16* OATT = (bf16*)(F.ws + WS_OATT); float* OPARK = (float*)(F.ws + WS_OACC);
    LAS float* BL = (LAS float*)(F.lds);
    LAS int* OACC = (LAS int*)(BL + 4 * 2056);
    LAS float* IMPL = (LAS float*)OACC;
    LAS int* LACC = OACC + 16384;
    LAS unsigned* SELM = (LAS unsigned*)(LACC + 256);
    LAS unsigned long long* BM = (LAS unsigned long long*)(SELM + 256);
    LAS unsigned short* KT = (LAS unsigned short*)(BM + 128);
    LAS unsigned short* VTT = KT + 2 * 4608;
    LAS unsigned* BCTR = (LAS unsigned*)(F.lds + MISC_OFF + 64);
    LAS unsigned short* QL = KT;
    const v4u* KF = (const v4u*)(F.ws + WS_KF); const v4u* VF = (const v4u*)(F.ws + WS_VF);
    static_assert(4 * 2056 * 4 + 16384 * 4 + 1024 + 1024 + 1024 + 4 * 4608 * 2 <= LDSCTL_OFF, "attention LDS map");
    const int tid = F.tid, lane = F.lane, w = F.wave;
    const int col = lane & 31, hi = lane >> 5, hp = col & 3, ti = w * 8 + (col >> 2);
    const LAS float* blp = BL + hp * 2056;
    int last_g = -1;
    for (int it = 0;; ++it) {
        const int id = F.vcu + F.G * it; if (id >= BATCH * NG * (T / 64)) break;
        const int bg = id >> 7, b = bg >> 2, g = bg & 3, tt = (it & 1) ? 127 - (id & 127) : (id & 127);
        const int t0 = tt * 64, cur = tt, t_l = t0 + ti, h = 4 * g + hp;
        const size_t mrow = (size_t)b * T + t_l;
        __syncthreads();
        if (g != last_g) { int tio = tid; asm volatile("" : "+v"(tio)); for (int i = tio; i < 4 * 2048; i += NWAVES * 64) BL[(i >> 11) * 2056 + (i & 2047)] = BLG[(size_t)(4 * g) * 2048 + i]; }
        last_g = g;
        for (int i = tid; i < 64 * 132 / 4; i += NWAVES * 64) ((LAS v4u*)IMPL)[i] = (v4u){0u, 0u, 0u, 0u};
        __syncthreads();
        bf16x8 qf[4];
#pragma unroll
        for (int k = 0; k < 4; ++k) qf[k] = ldg8(QN + mrow * D + h * 64 + 16 * k + 8 * hi);
        f32x16 ofin[2];
        const float cbias = blp[2047];
        SUBREP(1) {
            const int ncv_max = ((t0 + 63 - 31) >> 4) + 1; int n_kt = (ncv_max >> 5) + 1; n_kt = n_kt > 16 ? 16 : n_kt; const int n64 = (n_kt + 1) >> 1;
            int tio = tid; asm volatile("" : "+v"(tio));
            const bf16* kcs = KC + (size_t)bg * NCMPP * 64 + (size_t)(tio >> 3) * 64 + 8 * (tio & 7); const bf16* vcs = VTC + (size_t)bg * 64 * NCMPP + (size_t)(tio >> 3) * NCMPP + 8 * (tio & 7);
            float l = 0.f; v4u kreg, vreg;
            f32x16 oc[2]; oc[0] = (f32x16){0.f,0.f,0.f,0.f,0.f,0.f,0.f,0.f,0.f,0.f,0.f,0.f,0.f,0.f,0.f,0.f}; oc[1] = oc[0];
            unsigned av[16][2];
#pragma unroll
            for (int kt = 0; kt < 16; ++kt) { av[kt][0] = 0u; av[kt][1] = 0u; }
            float prevx3 = 0.f;
            kreg = *(const GAS v4u*)kcs; vreg = *(const GAS v4u*)vcs; DENSE_STK(0); DENSE_STV(0); __syncthreads();
#pragma unroll
            for (int i = 0; i < 8; ++i) { if (i < n64) { if (i + 1 < n64) { kreg = *(const GAS v4u*)(kcs + (size_t)(i + 1) * 64 * 64); vreg = *(const GAS v4u*)(vcs + (i + 1) * 64); }
#pragma unroll
                for (int sub = 0; sub < 2; ++sub) { const int kt = 2 * i + sub; if (kt < n_kt) { bf16x8 kf[4]; DENSE_LDK(kf, i & 1, sub); bf16x8 vf[2][2]; DENSE_LDV(vf, i & 1, sub);
                    f32x16 st; NSA_QK(st, kf, qf);
                    if (t0 - 512 * kt - 527 >= 2047) l += st_softmax_far(st, cbias, 1.0f); else if (t0 - 512 * kt - 527 >= 0 && t0 + 32 - 512 * kt <= 2047) l += st_softmax_in<16>(st, t_l - 31 - 512 * kt - 64 * hi, blp, 1.0f);
                    else l += st_softmax<1, 16>(st, t_l - 31 - 512 * kt - 64 * hi, blp, 1.0f);
                    float xq[4], aq[4];
#pragma unroll
                    for (int q = 0; q < 4; ++q) { const float cr = 0.5f * st[4 * q + 3]; aq[q] = st[4 * q] + st[4 * q + 1] + st[4 * q + 2] + cr; xq[q] = __shfl_xor(cr, 32); }
#pragma unroll
                    for (int q = 0; q < 4; ++q) aq[q] += hi ? xq[q] : (q == 0 ? prevx3 : xq[q > 0 ? q - 1 : 0]);
                    prevx3 = xq[3]; av[kt][0] = cvtpk(aq[0], aq[1]); av[kt][1] = cvtpk(aq[2], aq[3]);
                    const bf16x8 pb0 = pack8(st, 0), pb1 = pack8(st, 1);
#pragma unroll
                    for (int mt = 0; mt < 2; ++mt) { oc[mt] = MFMA32(vf[mt][0], pb0, oc[mt]); oc[mt] = MFMA32(vf[mt][1], pb1, oc[mt]); } } }
                if (i + 1 < n64) { DENSE_STK((i + 1) & 1); DENSE_STV((i + 1) & 1); }
                __syncthreads(); } }
            l += __shfl_xor(l, 32);
            const float gate = sigmoid_f(bf2f(QG[mrow * NQINP + D + h * 3 + 0]));
            const float inv = l > 0.f ? 1.0f / l : 0.f;
#pragma unroll
            for (int kt = 0; kt < 16; ++kt) { if (kt < n_kt) {
#pragma unroll
                for (int q = 0; q < 4; ++q) { float v = ((q & 1) ? bfhi(av[kt][q >> 1]) : bflo(av[kt][q >> 1])) * inv; v += __shfl_xor(v, 1); v += __shfl_xor(v, 2); if (hp == 0) IMPL[ti * 132 + 8 * kt + 2 * q + hi] = v; } } }
            const float og = gate * inv;
#pragma unroll
            for (int mt = 0; mt < 2; ++mt)
#pragma unroll
                for (int r = 0; r < 16; ++r) ofin[mt][r] = oc[mt][r] * og;
        }
        __syncthreads();
        v4u pf_wk, pf_wv, pf_dk, pf_dv, pf_q[4];
        { int tio = tid; asm volatile("" : "+v"(tio)); const int kt_lo_ = t0 >= 512 ? 0 : (512 - t0) >> 6, keyw = t0 - 512 + 64 * kt_lo_;
          pf_wk = *(const GAS v4u*)(KV + (size_t)b * T * NKV + 1024 + 64 * g + (size_t)(tio >> 3) * NKV + 8 * (tio & 7) + (size_t)keyw * NKV); pf_wv = *(const GAS v4u*)(VTW + (size_t)bg * 64 * T + (size_t)(tio >> 3) * T + 8 * (tio & 7) + keyw); }
        SUBREP(2) {
            int tk = tid >> 3, j = tid & 7; asm volatile("" : "+v"(tk), "+v"(j)); float v[16];
#pragma unroll
            for (int k = 0; k < 16; ++k) { const int s = 16 * j + k; v[k] = (s >= 1 && s <= cur - 2) ? IMPL[tk * 132 + s] : -1.0f; }
            unsigned msk = 0u;
#pragma unroll
            for (int k = 0; k < 16; ++k) { const int s = 16 * j + k; if (s <= cur && (s == 0 || s >= cur - 1)) msk |= 1u << k; }
            const int ncand = cur - 2 > 0 ? cur - 2 : 0; const int n_need = ncand < NTOP - 3 ? ncand : NTOP - 3;
            for (int itn = 0; itn < n_need; ++itn) {
                float bm = fmaxf(fmaxf(fmaxf(v[0], v[1]), fmaxf(v[2], v[3])), fmaxf(fmaxf(v[4], v[5]), fmaxf(v[6], v[7])));
                bm = fmaxf(bm, fmaxf(fmaxf(fmaxf(v[8], v[9]), fmaxf(v[10], v[11])), fmaxf(fmaxf(v[12], v[13]), fmaxf(v[14], v[15]))));
#define DPP_I(x, ctl) __builtin_amdgcn_update_dpp(0, (x), (ctl), 0xF, 0xF, true)
#define DPP_F(x, ctl) __builtin_bit_cast(float, __builtin_amdgcn_update_dpp(0, __builtin_bit_cast(int, (x)), (ctl), 0xF, 0xF, true))
                float gm = bm; gm = fmaxf(gm, DPP_F(gm, 0xB1)); gm = fmaxf(gm, DPP_F(gm, 0x4E)); gm = fmaxf(gm, DPP_F(gm, 0x141));
                unsigned eq = 0u;
#pragma unroll
                for (int k = 0; k < 16; ++k) eq |= (v[k] == gm) ? (1u << k) : 0u;
                int cand = eq ? 16 * j + (__ffs(eq) - 1) : 9999; int o1 = DPP_I(cand, 0xB1); cand = o1 < cand ? o1 : cand; o1 = DPP_I(cand, 0x4E); cand = o1 < cand ? o1 : cand; o1 = DPP_I(cand, 0x141); cand = o1 < cand ? o1 : cand;
#undef DPP_I
#undef DPP_F
                const unsigned hit = (unsigned)(cand - 16 * j) < 16u ? (1u << (cand - 16 * j)) : 0u; msk |= hit;
#pragma unroll
                for (int k = 0; k < 16; ++k) v[k] = (hit >> k) & 1u ? -1.0f : v[k];
            }
            ((LAS unsigned short*)SELM)[tk * 8 + j] = (unsigned short)msk;
        }
        __syncthreads();
        if (tid == 0) *BCTR = 0u;
        for (int i = tid; i < (16384 + 256) / 4; i += NWAVES * 64) ((LAS v4u*)OACC)[i] = (v4u){0u, 0u, 0u, 0u};
        {
            const unsigned wsel = SELM[lane * 4 + (w >> 1)]; const unsigned part = (w & 1) ? (wsel >> 16) : (wsel & 0xffffu);
#pragma unroll
            for (int k = 0; k < 16; ++k) { const unsigned long long bal = __ballot((part >> k) & 1u); if (lane == 0) BM[16 * w + k] = bal; }
        }
        __syncthreads();
        SUBREP(5) {
            int tio = tid; asm volatile("" : "+v"(tio));
            const bf16* ks_ = KV + (size_t)b * T * NKV + 1024 + 64 * g + (size_t)(tio >> 3) * NKV + 8 * (tio & 7);
            const bf16* vs_ = VTW + (size_t)bg * 64 * T + (size_t)(tio >> 3) * T + 8 * (tio & 7);
            f32x16 ow[2]; ow[0] = (f32x16){0.f,0.f,0.f,0.f,0.f,0.f,0.f,0.f,0.f,0.f,0.f,0.f,0.f,0.f,0.f,0.f}; ow[1] = ow[0]; float lw = 0.f;
            const int kt_lo = t0 >= 512 ? 0 : (512 - t0) >> 6; v4u kreg, vreg;
            kreg = pf_wk; vreg = pf_wv;
            { const int keyd = 64 * cur;
              pf_dk = *(const GAS v4u*)(KV + (size_t)b * T * NKV + 512 + 64 * g + (size_t)(tio >> 3) * NKV + 8 * (tio & 7) + (size_t)keyd * NKV); pf_dv = *(const GAS v4u*)(VTS + (size_t)bg * 64 * T + (size_t)(tio >> 3) * T + 8 * (tio & 7) + keyd); }
            DENSE_STK(0); DENSE_STV(0); __syncthreads();
            for (int kt = kt_lo; kt < 9; ++kt) { const int buf = (kt - kt_lo) & 1;
                if (kt + 1 < 9) { const int key1 = t0 - 512 + 64 * (kt + 1); kreg = *(const GAS v4u*)(ks_ + (size_t)key1 * NKV); vreg = *(const GAS v4u*)(vs_ + key1); }
#pragma unroll
                for (int sub = 0; sub < 2; ++sub) { const int key0 = t0 - 512 + 64 * kt + 32 * sub; bf16x8 kf[4]; DENSE_LDK(kf, buf, sub); bf16x8 vf[2][2]; DENSE_LDV(vf, buf, sub);
                    f32x16 st; NSA_QK(st, kf, qf);
                    if (kt >= 1 && kt <= 7) lw += st_softmax_in<1>(st, t_l - key0 - 4 * hi, blp, 1.0f); else lw += st_softmax<2, 1>(st, t_l - key0 - 4 * hi, blp, 1.0f);
                    const bf16x8 pb0 = pack8(st, 0), pb1 = pack8(st, 1);
#pragma unroll
                    for (int mt = 0; mt < 2; ++mt) { ow[mt] = MFMA32(vf[mt][0], pb0, ow[mt]); ow[mt] = MFMA32(vf[mt][1], pb1, ow[mt]); } }
                if (kt + 1 < 9) { DENSE_STK(buf ^ 1); DENSE_STV(buf ^ 1); }
                __syncthreads(); }
            lw += __shfl_xor(lw, 32);
            const float gw = sigmoid_f(bf2f(QG[mrow * NQINP + D + h * 3 + 2])) / lw * rs_;
#pragma unroll
            for (int mt = 0; mt < 2; ++mt)
#pragma unroll
                for (int r = 0; r < 16; ++r) ofin[mt][r] += ow[mt][r] * gw;
            float* pk = OPARK + mrow * D + h * 64;
#pragma unroll
            for (int mt = 0; mt < 2; ++mt)
#pragma unroll
                for (int q = 0; q < 4; ++q) *(GAS f32x4*)(pk + 32 * mt + 8 * q + 4 * hi) = (f32x4){ofin[mt][4 * q], ofin[mt][4 * q + 1], ofin[mt][4 * q + 2], ofin[mt][4 * q + 3]};
        }
        {
            const bf16* kbase = KV + (size_t)b * T * NKV + 512 + 64 * g + (size_t)(lane & 31) * NKV + 8 * hi;
            const bf16* vbase = VTS + (size_t)bg * 64 * T + (size_t)(lane & 31) * T + 8 * hi;
            SUBREP(3) {
            int tio = tid; asm volatile("" : "+v"(tio));
            const bf16* ks_ = KV + (size_t)b * T * NKV + 512 + 64 * g + (size_t)(tio >> 3) * NKV + 8 * (tio & 7);
            const bf16* vs_ = VTS + (size_t)bg * 64 * T + (size_t)(tio >> 3) * T + 8 * (tio & 7);
            f32x16 os[2]; os[0] = (f32x16){0.f,0.f,0.f,0.f,0.f,0.f,0.f,0.f,0.f,0.f,0.f,0.f,0.f,0.f,0.f,0.f}; os[1] = os[0]; float ls = 0.f;
            const int nfb = cur >= 2 ? 3 : cur + 1; v4u kreg, vreg;
            kreg = pf_dk; vreg = pf_dv;
#pragma unroll
            for (int c = 0; c < 4; ++c) { const int ch = tio + 512 * c, row = ch >> 3, part = ch & 7; pf_q[c] = *(const GAS v4u*)(QN + ((size_t)b * T + t0 + (row >> 2)) * D + (4 * g + (row & 3)) * 64 + 8 * part); }
            DENSE_STK(0); DENSE_STV(0); __syncthreads();
            for (int fi = 0; fi < nfb; ++fi) { const int fb = fi == 0 ? cur : (fi == 1 ? cur - 1 : 0);
                if (fi + 1 < nfb) { const int key1 = 64 * (fi == 0 ? cur - 1 : 0); kreg = *(const GAS v4u*)(ks_ + (size_t)key1 * NKV); vreg = *(const GAS v4u*)(vs_ + key1); }
#pragma unroll
                for (int sub = 0; sub < 2; ++sub) { const int key0 = 64 * fb + 32 * sub; bf16x8 kf[4]; DENSE_LDK(kf, fi & 1, sub); bf16x8 vf[2][2]; DENSE_LDV(vf, fi & 1, sub);
                    f32x16 st; NSA_QK(st, kf, qf);
                    if (fi == 1) ls += st_softmax_in<1>(st, t_l - key0 - 4 * hi, blp, 1.0f);
                    else if (fi == 2 && t0 - 63 >= 2047) ls += st_softmax_far(st, cbias, 1.0f);
                    else if (fi == 2 && t0 + 63 <= 2047) ls += st_softmax_in<1>(st, t_l - key0 - 4 * hi, blp, 1.0f);
                    else ls += st_softmax<1, 1>(st, t_l - key0 - 4 * hi, blp, 1.0f);
                    const bf16x8 pb0 = pack8(st, 0), pb1 = pack8(st, 1);
#pragma unroll
                    for (int mt = 0; mt < 2; ++mt) { os[mt] = MFMA32(vf[mt][0], pb0, os[mt]); os[mt] = MFMA32(vf[mt][1], pb1, os[mt]); } }
                if (fi + 1 < nfb) { DENSE_STK((fi + 1) & 1); DENSE_STV((fi + 1) & 1); }
                __syncthreads(); }
            {   int rowi = ti * 4 + hp; asm volatile("" : "+v"(rowi)); LAS int* orow = OACC + rowi * 64; const int swz = rowi & 31;
#pragma unroll
                for (int mt = 0; mt < 2; ++mt)
#pragma unroll
                    for (int r = 0; r < 16; ++r) { const int dim = 32 * mt + (r & 3) + 8 * (r >> 2) + 4 * hi; __hip_atomic_fetch_add(orow + (dim ^ swz), __float2int_rn(os[mt][r] * rs_ * OFIX), __ATOMIC_RELAXED, __HIP_MEMORY_SCOPE_WORKGROUP); }
                __hip_atomic_fetch_add(LACC + rowi, __float2int_rn(ls * rs_ * LFIX), __ATOMIC_RELAXED, __HIP_MEMORY_SCOPE_WORKGROUP); }
            }
            { int tio = tid; asm volatile("" : "+v"(tio));
#pragma unroll
              for (int c = 0; c < 4; ++c) { const int ch = tio + 512 * c, row = ch >> 3, part = ch & 7;
                  *(LAS v4u*)(QL + row * 72 + 8 * part) = pf_q[c]; } }
            __syncthreads();
            for (int rep_ = 0; rep_ < ((REP_SUB == 4 || REP_SUB == 6) ? 2 : 1); ++rep_) if (const float rs_ = rep_ ? 0.f : 1.f; true) {
#define NSA_NEXTBLK(sv) do { for (;;) { unsigned t_ = 0u; if (lane == 0) t_ = __hip_atomic_fetch_add(BCTR, 1u, __ATOMIC_RELAXED, __HIP_MEMORY_SCOPE_WORKGROUP); sv = 1 + __builtin_amdgcn_readfirstlane((int)t_); if (sv > cur - 2) break; \
        const unsigned long long m_ = BM[sv]; if (__builtin_amdgcn_readfirstlane((unsigned)m_) | __builtin_amdgcn_readfirstlane((unsigned)(m_ >> 32))) break; } } while (0)
#define NSA_LDK8(dst, sv) do { const size_t fb_ = ((size_t)(bg * 128 + (sv)) * 8) * 64 + lane; _Pragma("unroll") for (int k_ = 0; k_ < 8; ++k_) dst[k_] = KF[fb_ + (size_t)k_ * 64]; } while (0)
#define NSA_LDV8(dst, sv) do { const size_t fb_ = ((size_t)(bg * 128 + (sv)) * 8) * 64 + lane; _Pragma("unroll") for (int k_ = 0; k_ < 8; ++k_) dst[8 + k_] = VF[fb_ + (size_t)k_ * 64]; } while (0)
            v4u kv_[16];
            int s; NSA_NEXTBLK(s);
            while (s <= cur - 2) {
                NSA_LDK8(kv_, s); NSA_LDV8(kv_, s);
                const bool far_ = (t0 - 64 * s - 63) >= 2047, in_ = (t0 + 63 - 64 * s) <= 2047;
                unsigned long long mk = BM[s]; unsigned mlo = __builtin_amdgcn_readfirstlane((unsigned)mk), mhi = __builtin_amdgcn_readfirstlane((unsigned)(mk >> 32));
                mk = ((unsigned long long)mhi << 32) | mlo;
                while (mk) {
                    int mytok = -1;
#pragma unroll
                    for (int k = 0; k < 8; ++k) { int tkk = -1; if (mk) { tkk = __builtin_ctzll(mk); mk &= mk - 1; } mytok = ((col >> 2) == k) ? tkk : mytok; }
                    const bool valid = mytok >= 0; const int tq = valid ? mytok : 0; const int tq_abs = t0 + tq;
                    bf16x8 q2[4];
                    { const LAS unsigned short* qp = QL + (tq * 4 + hp) * 72 + 8 * hi;
#pragma unroll
                      for (int k = 0; k < 4; ++k) q2[k] = *(const LAS bf16x8*)(qp + 16 * k); }
                    f32x16 oi[2]; oi[0] = (f32x16){0.f,0.f,0.f,0.f,0.f,0.f,0.f,0.f,0.f,0.f,0.f,0.f,0.f,0.f,0.f,0.f}; oi[1] = oi[0]; float li = 0.f;
#pragma unroll
                    for (int sub = 0; sub < 2; ++sub) { f32x16 st = (f32x16){0.f,0.f,0.f,0.f,0.f,0.f,0.f,0.f,0.f,0.f,0.f,0.f,0.f,0.f,0.f,0.f};
#pragma unroll
                      for (int k = 0; k < 4; ++k) st = MFMA32(__builtin_bit_cast(bf16x8, kv_[4 * sub + k]), q2[k], st);
                      if (far_) li += st_softmax_far(st, cbias, 1.0f); else if (in_) li += st_softmax_in<1>(st, tq_abs - 64 * s - 32 * sub - 4 * hi, blp, 1.0f); else li += st_softmax<0, 1>(st, tq_abs - 64 * s - 32 * sub - 4 * hi, blp, 1.0f);
                      const bf16x8 pb0 = pack8(st, 0), pb1 = pack8(st, 1);
#pragma unroll
                      for (int mt = 0; mt < 2; ++mt) { oi[mt] = MFMA32(__builtin_bit_cast(bf16x8, kv_[8 + 4 * sub + 2 * mt]), pb0, oi[mt]); oi[mt] = MFMA32(__builtin_bit_cast(bf16x8, kv_[8 + 4 * sub + 2 * mt + 1]), pb1, oi[mt]); }
                      __builtin_amdgcn_sched_barrier(0); }
                    if (valid && !(REP_SUB == 6 && rep_)) { const int rowi = tq * 4 + hp; LAS int* orow = OACC + rowi * 64; const int swz = rowi & 31;
#pragma unroll
                        for (int mt = 0; mt < 2; ++mt)
#pragma unroll
                            for (int r = 0; r < 16; ++r) { const int dim = 32 * mt + (r & 3) + 8 * (r >> 2) + 4 * hi; __hip_atomic_fetch_add(orow + (dim ^ swz), __float2int_rn(oi[mt][r] * rs_ * OFIX), __ATOMIC_RELAXED, __HIP_MEMORY_SCOPE_WORKGROUP); }
                        __hip_atomic_fetch_add(LACC + rowi, __float2int_rn(li * rs_ * LFIX), __ATOMIC_RELAXED, __HIP_MEMORY_SCOPE_WORKGROUP); }
                }
                NSA_NEXTBLK(s);
            }
            }
        }
        __syncthreads();
        {
            int rowi = ti * 4 + hp; asm volatile("" : "+v"(rowi)); const LAS int* orow = OACC + rowi * 64; const int swz = rowi & 31;
            const float gs = sigmoid_f(bf2f(QG[mrow * NQINP + D + h * 3 + 1])) / ((float)LACC[rowi] * (1.0f / LFIX)) * (1.0f / OFIX);
            bf16* od = OATT + mrow * D + h * 64;
#pragma unroll
            for (int mt = 0; mt < 2; ++mt)
#pragma unroll
                for (int q = 0; q < 4; ++q) { const int dim0 = 32 * mt + 8 * q + 4 * hi; float o4[4];
                    const f32x4 pk4 = *(const GAS f32x4*)(OPARK + mrow * D + h * 64 + dim0);
#pragma unroll
                    for (int e = 0; e < 4; ++e) o4[e] = pk4[e] + (float)orow[(dim0 + e) ^ swz] * gs;
                    *(GAS unsigned long long*)(od + dim0) = (unsigned long long)cvtpk(o4[0], o4[1]) | ((unsigned long long)cvtpk(o4[2], o4[3]) << 32); }
        }
    }
}

enum Phase { P_PRO, P_IN0, P_HA, P_HB, P_HC, P_OUT0, P_GU0, P_DN0, P_KVQ, P_PREP, P_NSA, P_OUT1, P_ROUTE, P_MOE1, P_MOE2, P_COMB, N_PHASES };
#define NREP(k) (REP_PHASE == (int)(k) ? 2 : 1)
#define REPEAT(k, call) do { if (REP_PHASE == (int)(k)) { __syncthreads(); call; } } while (0)
__global__ void __launch_bounds__(NWAVES * 64, 2) fwd_kernel(Args args) {
    extern __shared__ __attribute__((aligned(16))) unsigned char lds[];
    Frame F;
    F.lds = (LAS unsigned char*)lds;
    F.MISC = (volatile LAS unsigned*)(F.lds + MISC_OFF);
    F.tid = threadIdx.x; F.lane = F.tid & 63; F.wave = __builtin_amdgcn_readfirstlane(F.tid >> 6);
    F.G = gridDim.x; { const int bx = blockIdx.x; F.vcu = (F.G % 8 == 0) ? (bx % 8) * (F.G / 8) + bx / 8 : bx; }
    F.ws = args.ws; F.out = args.out; F.ctl = (gu32*)(args.ws + WS_CTL);
    unsigned char* ws = args.ws;
    for (int u = F.tid; u < (LDS_BYTES - LDSCTL_OFF) / 4; u += NWAVES * 64) ((LAS unsigned*)(F.lds + LDSCTL_OFF))[u] = 0u;
    __syncthreads();
    XcdBarrier bar; bar.bar = (unsigned*)(F.ctl + CW_BAR); bar.x = 0; bar.st = nullptr;
    if (MK_SINGLE) bar = xcd_barrier_post((unsigned*)(F.ctl + CW_BAR), F.MISC + 8);
    const int lo = args.ph_lo, hi = args.ph_hi;
#define IN(k) (lo <= (k) && (k) < hi)
#define SEAM(k) do { if (MK_SINGLE && IN(k) && hi > (k) + 1) xcd_barrier(bar); } while (0)
    bf16* XN = (bf16*)(ws + WS_XN);

#define GEMM_IN0() do { pg8::Gemm g{XN, (const bf16*)(ws + WS_W_IN0), D}; pg8::StaticOrder S; S.init(M, NIN0, F.G, (int)blockIdx.x); pg8::EpiBf16 E{(bf16*)(ws + WS_QFIG), NIN0, nullptr, 0, nullptr, 0}; \
        pg8::gemm_phase<pg8::EpiBf16, pg8::StaticOrder, true>(F.lds + RING_OFF, g, S, E); } while (0)
#define GEMM_OUT0() do { pg8::Gemm g{(const bf16*)(ws + WS_OG), (const bf16*)(ws + WS_W_OUT0), D}; pg8::StaticOrder S; S.init(M, D, F.G, (int)blockIdx.x); pg8::EpiResF32 E{args.in[I_X], nullptr, nullptr, D, XN, (float*)(ws + WS_SSP1), nullptr}; \
        pg8::gemm_phase<pg8::EpiResF32, pg8::StaticOrder, true>(F.lds + RING_OFF, g, S, E); } while (0)
#define GEMM_GU0() do { pg8::Gemm g{XN, (const bf16*)(ws + WS_W_GU0), D}; pg8::StaticOrder S; S.init(M, 2 * FF, F.G, (int)blockIdx.x); pg8::EpiSwiglu E{(bf16*)(ws + WS_ACT), FF, (const float*)(ws + WS_SSP1)}; \
        pg8::gemm_phase<pg8::EpiSwiglu, pg8::StaticOrder, true>(F.lds + RING_OFF, g, S, E); } while (0)
#define GEMM_DN0() do { pg8::Gemm g{(const bf16*)(ws + WS_ACT), (const bf16*)(ws + WS_W_DN0), FF}; pg8::StaticOrder S; S.init(M, D, F.G, (int)blockIdx.x); pg8::EpiResF32 E{nullptr, XN, nullptr, D, XN, (float*)(ws + WS_SSP2), nullptr}; \
        pg8::gemm_phase<pg8::EpiResF32, pg8::StaticOrder, true>(F.lds + RING_OFF, g, S, E); } while (0)
#define GEMM_KVQ() do { pg8::Gemm g{XN, (const bf16*)(ws + WS_W_KV), D}; pg8::StaticOrder S; S.init(M, NKV + NQINP, F.G, (int)blockIdx.x); \
        pg8::EpiBf16 E{(bf16*)(ws + WS_KV), NKV, (const float*)(ws + WS_SSP2), NKV / 256, (bf16*)(ws + WS_QG), NQINP}; pg8::gemm_phase<pg8::EpiBf16, pg8::StaticOrder, true>(F.lds + RING_OFF, g, S, E); } while (0)
#define GEMM_OUT1() do { pg8::Gemm g{(const bf16*)(ws + WS_OATT), (const bf16*)(ws + WS_W_OUT1), D}; pg8::StaticOrder S; S.init(M, D, F.G, (int)blockIdx.x); pg8::EpiResF32 E{nullptr, XN, F.out, D, XN, (float*)(ws + WS_SSP3), nullptr}; \
        pg8::gemm_phase<pg8::EpiResF32, pg8::StaticOrder, true>(F.lds + RING_OFF, g, S, E); } while (0)
#define GEMM_MOE1() do { pg8::Gemm g{(const bf16*)(ws + WS_XG8), (const bf16*)(ws + WS_W_GU1), D}; MoeOrder S; S.init(F.ctl + CW_ECNT, 2 * EF / 256, F.G, F.vcu, true); \
        pg8::EpiSwigluF8 E{(unsigned char*)(ws + WS_ACT2), EF, (const float*)(ws + WS_RS_E)}; pg8::gemm_phase<pg8::EpiSwigluF8, MoeOrder, true, true>(F.lds + RING_OFF, g, S, E); } while (0)
#define GEMM_MOE2() do { pg8::Gemm g{(const bf16*)(ws + WS_ACT2), (const bf16*)(ws + WS_W_DN1), EF}; MoeOrder S; S.init(F.ctl + CW_ECNT, D / 256, F.G, F.vcu, false); \
        pg8::EpiMoeDown E{(bf16*)(ws + WS_Y2), D, 1.0f / (pg8::F8_WSCALE * pg8::F8_ASCALE)}; pg8::gemm_phase<pg8::EpiMoeDown, MoeOrder, true, true>(F.lds + RING_OFF, g, S, E); } while (0)
    if (IN(P_PRO)) { p0_prologue(F, args); REPEAT(P_PRO, p0_prologue(F, args)); } SEAM(P_PRO);
    if (IN(P_IN0)) { GEMM_IN0(); REPEAT(P_IN0, GEMM_IN0()); } SEAM(P_IN0);
    if (IN(P_HA)) { p_hg_a(F); REPEAT(P_HA, p_hg_a(F)); } SEAM(P_HA);
    if (IN(P_HB)) { p_hg_b(F); REPEAT(P_HB, p_hg_b(F)); } SEAM(P_HB);
    if (IN(P_HC)) { p_hg_c(F, args.in[I_A_ONORM]); REPEAT(P_HC, p_hg_c(F, args.in[I_A_ONORM])); } SEAM(P_HC);
    if (IN(P_OUT0)) { GEMM_OUT0();  } SEAM(P_OUT0);
    if (IN(P_GU0)) { GEMM_GU0(); REPEAT(P_GU0, GEMM_GU0()); } SEAM(P_GU0);
    if (IN(P_DN0)) { GEMM_DN0();  } SEAM(P_DN0);
    if (IN(P_KVQ)) { GEMM_KVQ(); REPEAT(P_KVQ, GEMM_KVQ()); } SEAM(P_KVQ);
    if (IN(P_PREP)) { p_knorm(F, args.in[I_K_NORM]); p_qnorm(F, args.in[I_B_QNORM]); p_biaslut(F, args.in[I_REL_BIAS]); p_vtrans(F); __syncthreads(); p_compress_mfma(F, args.in[I_K_NORM]);
        REPEAT(P_PREP, p_qnorm(F, args.in[I_B_QNORM]); p_biaslut(F, args.in[I_REL_BIAS]); p_vtrans(F); __syncthreads(); p_compress_mfma(F, args.in[I_K_NORM])); } SEAM(P_PREP);
    if (IN(P_NSA)) { p_nsa(F, args); REPEAT(P_NSA, p_nsa(F, args)); } SEAM(P_NSA);
    if (IN(P_OUT1)) { GEMM_OUT1();  } SEAM(P_OUT1);
    if (IN(P_ROUTE)) { p_route(F, args); REPEAT(P_ROUTE, p_route(F, args, true)); } SEAM(P_ROUTE);
    if (IN(P_MOE1)) { GEMM_MOE1(); REPEAT(P_MOE1, GEMM_MOE1()); } SEAM(P_MOE1);
    if (IN(P_MOE2)) { GEMM_MOE2(); REPEAT(P_MOE2, GEMM_MOE2()); } SEAM(P_MOE2);
    if (IN(P_COMB)) { p_moe_combine(F); }
#undef IN
#undef SEAM
}

extern "C" void kernel_launch(void* const* d_in, const int* in_sizes, int n_in, void* d_out, int out_size, void* d_ws, size_t ws_size, hipStream_t stream) {
    static int grid = 0;
    if (grid == 0) {
        if (n_in != N_IN || in_sizes[0] != M * D || out_size != M * D || ws_size < WS_END) { fprintf(stderr, "kernel_launch: unexpected shapes (n_in %d, in0 %d, out %d, ws %zu < %zu); nothing launched\n", n_in, n_in > 0 ? in_sizes[0] : -1, out_size, ws_size, (size_t)WS_END); grid = -1; return; }
        int dev = 0, cus = 0, per_cu = 0;
        if (hipGetDevice(&dev) != hipSuccess || hipDeviceGetAttribute(&cus, hipDeviceAttributeMultiprocessorCount, dev) != hipSuccess) { grid = -1; return; }
        if (hipFuncSetAttribute((const void*)fwd_kernel, hipFuncAttributeMaxDynamicSharedMemorySize, LDS_BYTES) != hipSuccess) { fprintf(stderr, "kernel_launch: hipFuncSetAttribute failed\n"); grid = -1; return; }
        if (hipOccupancyMaxActiveBlocksPerMultiprocessor(&per_cu, (const void*)fwd_kernel, NWAVES * 64, LDS_BYTES) != hipSuccess || per_cu < 1)
            fprintf(stderr, "kernel_launch: note: occupancy query reports %d workgroups per CU\n", per_cu);
        (void)hipGetLastError();
        grid = cus;
    }
    if (grid < 0) return;
    if (hipMemsetAsync((char*)d_ws + WS_CTL, 0, CTL_ZERO_BYTES, stream) != hipSuccess) { fprintf(stderr, "kernel_launch: hipMemsetAsync failed\n"); return; }
    Args a{};
    for (int i = 0; i < N_IN; ++i) a.in[i] = (const float*)d_in[i];
    a.out = (float*)d_out; a.ws = (unsigned char*)d_ws;
#if MK_SINGLE
    a.ph_lo = 0; a.ph_hi = N_PHASES;
    hipLaunchKernelGGL(fwd_kernel, dim3(grid), dim3(NWAVES * 64), LDS_BYTES, stream, a);
#else
    for (int p = 0; p < N_PHASES; ++p) { a.ph_lo = p; a.ph_hi = p + 1; hipLaunchKernelGGL(fwd_kernel, dim3(grid), dim3(NWAVES * 64), LDS_BYTES, stream, a); }
#endif
}
```

```cpp
#include <hip/hip_runtime.h>
#include <cstdio>
#include <cstdint>

#ifndef REP_PHASE
#define REP_PHASE -1
#endif
#ifndef MK_SINGLE
#define MK_SINGLE 1
#endif

namespace pg8 {
#define PG8_LAS __attribute__((address_space(3)))
typedef unsigned short bf16_t;
typedef short bf16x8 __attribute__((ext_vector_type(8)));
typedef float f32x4 __attribute__((ext_vector_type(4)));
typedef unsigned u32x4 __attribute__((ext_vector_type(4)));
typedef float f32x2 __attribute__((ext_vector_type(2)));
constexpr int BM = 256, BK = 64, HALF = 128, HTB = HALF * BK * 2  , STAGE_BYTES = 8 * HTB, NXCD = 8, WGM = 8;

__host__ __device__ __forceinline__ int lds_byte(int r, int c) { const int st = (r >> 4) * 2 + (c >> 5), rr = r & 15, cc = c & 31, ob = rr * 64 + cc * 2; return st * 1024 + (ob ^ (((ob >> 9) & 1) << 5)); }
__host__ __device__ __forceinline__ void stage_rc(int b, int& R, int& C) { const int st = b / 1024, sb = b % 1024, swz = sb ^ (((sb >> 9) & 1) << 5); R = (st >> 1) * 16 + swz / 64; C = (st & 1) * 32 + (swz % 64) / 2; }
__host__ __device__ __forceinline__ int perm32(int rho) { const int n = rho >> 4, i = rho & 15; return 8 * (i >> 2) + 4 * n + (i & 3); }

struct Unit { int pm, pn, pnl, pa, nv, k0, nk, part; };
struct Gemm { const bf16_t* A; const bf16_t* Bt; int K; };

struct StaticOrder {
    static constexpr bool KSPLIT = false;
    int nM, nN, nwg, G, c;
    __host__ __device__ void init(int M, int N, int G_, int c_) { nM = M / BM; nN = N / BM; nwg = nM * nN; G = G_; c = c_; }
    __host__ __device__ bool next(int i, Unit& u) const {
        const long L = (long)i * G + c; if (L >= nwg) return false;
        int wgid = (int)L; { const int q = nwg / NXCD, r = nwg % NXCD, xcd = wgid % NXCD, off = wgid / NXCD; wgid = (xcd < r ? xcd * (q + 1) : r * (q + 1) + (xcd - r) * q) + off; }
        const int nig = WGM * nN, gid = wgid / nig, fm = gid * WGM, gsz = (nM - fm) < WGM ? (nM - fm) : WGM;
        u.pm = fm + ((wgid % nig) % gsz); u.pn = (wgid % nig) / gsz; u.pnl = u.pn; u.pa = u.pm; u.nv = BM; return true;
    }
};

__device__ __forceinline__ unsigned cvt_pk_bf16(float lo, float hi) { unsigned r; asm volatile("v_cvt_pk_bf16_f32 %0, %1, %2" : "=v"(r) : "v"(lo), "v"(hi)); return r; }

__device__ __forceinline__ float row_rstd(const float* ssp, int row) {
    const f32x4* p = (const f32x4*)(ssp + (size_t)row * 16); const f32x4 a = p[0], b = p[1], c = p[2], d = p[3];
    const float s = ((a[0] + a[1]) + (a[2] + a[3])) + ((b[0] + b[1]) + (b[2] + b[3])) + (((c[0] + c[1]) + (c[2] + c[3])) + ((d[0] + d[1]) + (d[2] + d[3])));
    return 1.0f / sqrtf(s * (1.0f / 1024.0f) + 1e-6f);
}
struct EpiBf16 {
    static constexpr bool PERM = true;
    bf16_t* O; int ldc; const float* ssp; int split; bf16_t* O2; int ldc2;
    static constexpr bool HAS_PREP = true;
    __device__ __forceinline__ void prep(const Unit& u, PG8_LAS float* slot) const { if (ssp && threadIdx.x < 256) slot[threadIdx.x] = row_rstd(ssp, u.pm * BM + threadIdx.x); }
    __device__ __forceinline__ void operator()(const f32x4 (&acc)[2][2][4][2], const Unit& u, int wr, int wc, int fr, int fq, const PG8_LAS float* rsl) const {
        const int row0 = u.pm * BM + wr * 64 + fr; bf16_t* base = O; int ld = ldc, pt = u.pnl;
        if (split > 0 && pt >= split) { base = O2; ld = ldc2; pt -= split; }
        const int col0 = pt * BM + wc * 32 + 8 * fq;
        const __amdgpu_buffer_rsrc_t rsrc = __builtin_amdgcn_make_buffer_rsrc(base, 0, 0x7fffffff, 0x00020000);
#pragma unroll
        for (int ai = 0; ai < 2; ++ai)
#pragma unroll
            for (int m = 0; m < 4; ++m) { const int row = row0 + ai * HALF + m * 16; const unsigned boff = (unsigned)(((size_t)row * ld + col0) * 2); const float rs = ssp ? rsl[row - u.pm * BM] : 1.0f;
#pragma unroll
                for (int bj = 0; bj < 2; ++bj) { const f32x4 v0 = acc[ai][bj][m][0] * rs, v1 = acc[ai][bj][m][1] * rs;
                    u32x4 w; w.x = cvt_pk_bf16(v0[0], v0[1]); w.y = cvt_pk_bf16(v0[2], v0[3]); w.z = cvt_pk_bf16(v1[0], v1[1]); w.w = cvt_pk_bf16(v1[2], v1[3]);
                    __builtin_amdgcn_raw_buffer_store_b128(w, rsrc, boff + bj * HALF * 2, 0, 16); } }
    }
};
__device__ __forceinline__ float silu_f(float x) { return x / (1.0f + __expf(-x)); }
__device__ __forceinline__ float clamp8(float x) { return fminf(fmaxf(x, -440.0f), 440.0f); }
__device__ __forceinline__ unsigned pk4_fp8(float a, float b, float c, float d) { int w = __builtin_amdgcn_cvt_pk_fp8_f32(clamp8(a), clamp8(b), 0, false); w = __builtin_amdgcn_cvt_pk_fp8_f32(clamp8(c), clamp8(d), w, true); return (unsigned)w; }
constexpr float F8_WSCALE = 256.0f;
constexpr float F8_ASCALE = 8.0f;
struct EpiSwiglu {
    static constexpr bool PERM = true;
    bf16_t* O; int ldc; const float* ssp;
    static constexpr bool HAS_PREP = true;
    __device__ __forceinline__ void prep(const Unit& u, PG8_LAS float* slot) const { if (threadIdx.x < 256) slot[threadIdx.x] = row_rstd(ssp, u.pm * BM + threadIdx.x); }
    __device__ __forceinline__ void operator()(const f32x4 (&acc)[2][2][4][2], const Unit& u, int wr, int wc, int fr, int fq, const PG8_LAS float* rsl) const {
        const int row0 = u.pm * BM + wr * 64 + fr; const int col0 = u.pnl * HALF + wc * 32 + 8 * fq;
#pragma unroll
        for (int ai = 0; ai < 2; ++ai)
#pragma unroll
            for (int m = 0; m < 4; ++m) { const int row = row0 + ai * HALF + m * 16; bf16_t* rowp = O + (size_t)row * ldc + col0; const float rs = rsl[row - u.pm * BM];
                const f32x4 g0 = acc[ai][0][m][0] * rs, g1 = acc[ai][0][m][1] * rs, u0 = acc[ai][1][m][0] * rs, u1 = acc[ai][1][m][1] * rs;
                u32x4 w; w.x = cvt_pk_bf16(silu_f(g0[0]) * u0[0], silu_f(g0[1]) * u0[1]); w.y = cvt_pk_bf16(silu_f(g0[2]) * u0[2], silu_f(g0[3]) * u0[3]);
                w.z = cvt_pk_bf16(silu_f(g1[0]) * u1[0], silu_f(g1[1]) * u1[1]); w.w = cvt_pk_bf16(silu_f(g1[2]) * u1[2], silu_f(g1[3]) * u1[3]);
                *(u32x4*)rowp = w; }
    }
};
struct EpiResF32 {
    static constexpr bool PERM = false;
    const float* res; const bf16_t* resb; float* out; int ldc; bf16_t* xh; float* ssp; unsigned char* x8  ;
    static constexpr bool HAS_PREP = false;
    __device__ __forceinline__ void prep(const Unit&, PG8_LAS float*) const {}
    __device__ __forceinline__ void operator()(const f32x4 (&acc)[2][2][4][2], const Unit& u, int wr, int wc, int fr, int fq, const PG8_LAS float*) const {
        const int col0 = u.pnl * BM + wc * 32 + 4 * fq;
#pragma unroll
        for (int ai = 0; ai < 2; ++ai)
#pragma unroll
            for (int m = 0; m < 4; ++m) { const int row = u.pm * BM + ai * HALF + wr * 64 + m * 16 + fr; const size_t off = (size_t)row * ldc + col0; float ss = 0.f;
#pragma unroll
                for (int bj = 0; bj < 2; ++bj)
#pragma unroll
                    for (int n = 0; n < 2; ++n) { f32x4 bs;
                        if (res) bs = *(const f32x4*)(res + off + bj * HALF + n * 16);
                        else { const unsigned long long rb = *(const unsigned long long*)(resb + off + bj * HALF + n * 16); const unsigned lo = (unsigned)rb, hi = (unsigned)(rb >> 32);
                            bs = (f32x4){__builtin_bit_cast(float, lo << 16), __builtin_bit_cast(float, lo & 0xffff0000u), __builtin_bit_cast(float, hi << 16), __builtin_bit_cast(float, hi & 0xffff0000u)}; }
                        const f32x4 o = bs + acc[ai][bj][m][n]; if (out) *(f32x4*)(out + off + bj * HALF + n * 16) = o;
                        ss += (o[0] * o[0] + o[1] * o[1]) + (o[2] * o[2] + o[3] * o[3]);
                        *(unsigned long long*)(xh + off + bj * HALF + n * 16) = (unsigned long long)cvt_pk_bf16(o[0], o[1]) | ((unsigned long long)cvt_pk_bf16(o[2], o[3]) << 32);
                        if (x8) *(unsigned*)(x8 + off + bj * HALF + n * 16) = pk4_fp8(o[0], o[1], o[2], o[3]); }
                ss += __shfl_xor(ss, 16); ss += __shfl_xor(ss, 32);
                if (fq == 0) ssp[(size_t)row * 16 + 4 * u.pnl + wc] = ss; }
    }
};
struct EpiSwigluF8 {
    static constexpr bool PERM = true;
    unsigned char* O; int ldc; const float* rs_e;
    static constexpr bool HAS_PREP = true;
    __device__ __forceinline__ void prep(const Unit& u, PG8_LAS float* slot) const { if (threadIdx.x < 256) slot[threadIdx.x] = (int)threadIdx.x < u.nv ? rs_e[(size_t)u.pa * BM + threadIdx.x] * (1.0f / F8_WSCALE) : 0.f; }
    __device__ __forceinline__ void operator()(const f32x4 (&acc)[2][2][4][2], const Unit& u, int wr, int wc, int fr, int fq, const PG8_LAS float* rsl) const {
        const int row0 = u.pm * BM + wr * 64 + fr; const int col0 = u.pnl * HALF + wc * 32 + 8 * fq;
#pragma unroll
        for (int ai = 0; ai < 2; ++ai)
#pragma unroll
            for (int m = 0; m < 4; ++m) { const int row = row0 + ai * HALF + m * 16; unsigned char* rowp = O + (size_t)row * ldc + col0; const float rs = rsl[row - u.pm * BM];
                const f32x4 g0 = acc[ai][0][m][0] * rs, g1 = acc[ai][0][m][1] * rs, u0 = acc[ai][1][m][0] * (rs * F8_ASCALE), u1 = acc[ai][1][m][1] * (rs * F8_ASCALE);
                const unsigned w0 = pk4_fp8(silu_f(g0[0]) * u0[0], silu_f(g0[1]) * u0[1], silu_f(g0[2]) * u0[2], silu_f(g0[3]) * u0[3]);
                const unsigned w1 = pk4_fp8(silu_f(g1[0]) * u1[0], silu_f(g1[1]) * u1[1], silu_f(g1[2]) * u1[2], silu_f(g1[3]) * u1[3]);
                *(unsigned long long*)rowp = (unsigned long long)w0 | ((unsigned long long)w1 << 32); }
    }
};
struct EpiMoeDown {
    static constexpr bool PERM = true;
    bf16_t* Y; int ldc; float scale; bf16_t* Y1; bf16_t* Y2; bf16_t* Y3;
    static constexpr bool HAS_PREP = false;
    __device__ __forceinline__ void prep(const Unit&, PG8_LAS float*) const {}
    __device__ __forceinline__ void operator()(const f32x4 (&acc)[2][2][4][2], const Unit& u, int wr, int wc, int fr, int fq, const PG8_LAS float*) const {
        const int row0 = u.pm * BM + wr * 64 + fr; const int col0 = u.pnl * BM + wc * 32 + 8 * fq;
        bf16_t* const Yb = u.part == 0 ? Y : u.part == 1 ? Y1 : u.part == 2 ? Y2 : Y3;
#pragma unroll
        for (int ai = 0; ai < 2; ++ai)
#pragma unroll
            for (int m = 0; m < 4; ++m) { bf16_t* rowp = Yb + (size_t)(row0 + ai * HALF + m * 16) * ldc + col0;
#pragma unroll
                for (int bj = 0; bj < 2; ++bj) { const f32x4 v0 = acc[ai][bj][m][0] * scale, v1 = acc[ai][bj][m][1] * scale;
                    u32x4 w; w.x = cvt_pk_bf16(v0[0], v0[1]); w.y = cvt_pk_bf16(v0[2], v0[3]); w.z = cvt_pk_bf16(v1[0], v1[1]); w.w = cvt_pk_bf16(v1[2], v1[3]);
                    *(u32x4*)(rowp + bj * HALF) = w; } }
    }
};

template <class Epi, class Sched, bool ALIGN_EPI, bool F8 = false>
__device__ __forceinline__ void gemm_phase(PG8_LAS unsigned char* lds, const Gemm g, const Sched& S, const Epi& E) {
    const int tid = threadIdx.x, wid = __builtin_amdgcn_readfirstlane(tid >> 6), lane = tid & 63, wr = wid >> 2, wc = wid & 3, fr = lane & 15, fq = lane >> 4;
    constexpr int EB = F8 ? 1 : 2;
    const int K = g.K; int nt = K * EB / (BK * 2);
    unsigned voffB[2], voffA[2];
#pragma unroll
    for (int i = 0; i < 2; ++i) { int R, C; stage_rc(tid * 16 + i * 8192, R, C); const int Rb = Epi::PERM ? ((R & ~31) + perm32(R & 31)) : R;
        voffA[i] = (unsigned)(R * K * EB + C * 2); voffB[i] = (unsigned)(Rb * K * EB + C * 2); }
    const size_t kstep = (size_t)(BK * 2);
    const size_t hstep = (size_t)HALF * K * EB;
    const size_t tstep = 2 * hstep;
    const unsigned ldsw = (unsigned)wid * 1024u;
    const int aoff = lds_byte(wr * 64 + fr, fq * (F8 ? 16 : 8)), boff = lds_byte(wc * 32 + fr, fq * (F8 ? 16 : 8));
    typedef int v8i_ __attribute__((ext_vector_type(8))); typedef int v4i_ __attribute__((ext_vector_type(4)));
#define PG8_SA(b, h) (((b) * 2 + (h)) * HTB)
#define PG8_SB(b, h) ((4 + (b) * 2 + (h)) * HTB)
#define PG8_STAGE(bufoff, gbase, voff) do { _Pragma("unroll") for (int _i = 0; _i < 2; ++_i) \
        __builtin_amdgcn_global_load_lds((const unsigned*)((const char*)(gbase) + (voff)[_i]), (PG8_LAS unsigned*)(lds + (bufoff) + ldsw + _i * 8192), 16, 0, 0); } while (0)
#define PG8_LD32(p) __builtin_shufflevector(*(const PG8_LAS v4i_*)(p), *(const PG8_LAS v4i_*)((p) + 16), 0, 1, 2, 3, 4, 5, 6, 7)
#define PG8_LDA(dst, b, h) do { _Pragma("unroll") for (int m = 0; m < 4; ++m) { if constexpr (F8) dst##8[m] = PG8_LD32(lds + PG8_SA(b, h) + aoff + m * 2048); else { _Pragma("unroll") for (int k = 0; k < 2; ++k) dst[m][k] = *(const PG8_LAS bf16x8*)(lds + PG8_SA(b, h) + aoff + m * 2048 + k * 1024); } } } while (0)
#define PG8_LDB(dst, b, h) do { _Pragma("unroll") for (int n = 0; n < 2; ++n) { if constexpr (F8) dst##8[n] = PG8_LD32(lds + PG8_SB(b, h) + boff + n * 2048); else { _Pragma("unroll") for (int k = 0; k < 2; ++k) dst[n][k] = *(const PG8_LAS bf16x8*)(lds + PG8_SB(b, h) + boff + n * 2048 + k * 1024); } } } while (0)
#define PG8_MMA(ai, bj, At, Bt) do { __builtin_amdgcn_s_setprio(1); _Pragma("unroll") for (int m = 0; m < 4; ++m) _Pragma("unroll") for (int n = 0; n < 2; ++n) { \
        if constexpr (F8) acc[ai][bj][m][n] = __builtin_amdgcn_mfma_scale_f32_16x16x128_f8f6f4(Bt##8[n], At##8[m], acc[ai][bj][m][n], 0, 0, 0, 0x7F7F7F7F, 0, 0x7F7F7F7F); \
        else { _Pragma("unroll") for (int k = 0; k < 2; ++k) acc[ai][bj][m][n] = __builtin_amdgcn_mfma_f32_16x16x32_bf16(Bt[n][k], At[m][k], acc[ai][bj][m][n], 0, 0, 0); } } \
        if constexpr (F8) { _Pragma("unroll") for (int m = 0; m < 4; ++m) _Pragma("unroll") for (int n = 0; n < 2; ++n) asm volatile("" : "+v"(acc[ai][bj][m][n])); }     \
        __builtin_amdgcn_s_setprio(0); } while (0)
#define PG8_WAIT_V(n) asm volatile("s_waitcnt vmcnt(" #n ")" ::: "memory")
#define PG8_WAIT_L(n) asm volatile("s_waitcnt lgkmcnt(" #n ")" ::: "memory")
#define PG8_BAR __builtin_amdgcn_s_barrier()
#define PG8_SCHED __builtin_amdgcn_sched_barrier(0)
    Unit cur, nxt; int ui = 0;
    if (!S.next(0, cur)) return;
    f32x4 acc[2][2][4][2];
#pragma unroll
    for (int a = 0; a < 2; ++a)
#pragma unroll
        for (int b = 0; b < 2; ++b)
#pragma unroll
            for (int m = 0; m < 4; ++m)
#pragma unroll
                for (int n = 0; n < 2; ++n) acc[a][b][m][n] = (f32x4){0.f, 0.f, 0.f, 0.f};
    bf16x8 At[4][2], B0[2][2], B1[2][2]; v8i_ At8[4], B08[2], B18[2];
    const char* cA = (const char*)g.A + (size_t)cur.pa * tstep; const char* cB = (const char*)g.Bt + (size_t)cur.pn * tstep;
    if constexpr (Sched::KSPLIT) { cA += (size_t)cur.k0 * (BK * 2); cB += (size_t)cur.k0 * (BK * 2); nt = cur.nk; }
    PG8_LAS float* const rsl0 = (PG8_LAS float*)(lds + STAGE_BYTES);
    if constexpr (Epi::HAS_PREP) E.prep(cur, rsl0);
    PG8_STAGE(PG8_SB(0, 0), cB, voffB); PG8_STAGE(PG8_SB(0, 1), cB + hstep, voffB); PG8_STAGE(PG8_SA(0, 0), cA, voffA); PG8_STAGE(PG8_SA(0, 1), cA + hstep, voffA);
    if (wr == 1) PG8_BAR;
    PG8_WAIT_V(2); PG8_BAR;
    PG8_STAGE(PG8_SB(1, 0), cB + kstep, voffB); PG8_STAGE(PG8_SA(1, 0), cA + kstep, voffA); PG8_STAGE(PG8_SB(1, 1), cB + hstep + kstep, voffB);
    PG8_WAIT_V(6); PG8_BAR;
    for (;;) {
        const bool has_next = S.next(ui + 1, nxt);
        const char* nA = has_next ? (const char*)g.A + (size_t)nxt.pa * tstep : cA; const char* nB = has_next ? (const char*)g.Bt + (size_t)nxt.pn * tstep : cB;
        if constexpr (Sched::KSPLIT) { if (has_next) { nA += (size_t)nxt.k0 * kstep; nB += (size_t)nxt.k0 * kstep; } }
        for (int t = 0; t < nt; t += 2) {
            const bool last = (t == nt - 2);
            const char* a1 = cA + (size_t)(t + 1) * kstep;
            const char* a2 = last ? nA : cA + (size_t)(t + 2) * kstep; const char* b2 = last ? nB : cB + (size_t)(t + 2) * kstep;
            const char* a3 = a2 + kstep; const char* b3 = b2 + kstep;
            PG8_LDB(B0, 0, 0); PG8_LDB(B1, 0, 1); PG8_SCHED; PG8_LDA(At, 0, 0); PG8_STAGE(PG8_SA(1, 1), a1 + hstep, voffA);
            PG8_WAIT_V(8); PG8_WAIT_L(0); PG8_BAR; PG8_MMA(0, 0, At, B0); PG8_MMA(0, 1, At, B1); PG8_BAR; PG8_SCHED;
            PG8_LDA(At, 0, 1); PG8_STAGE(PG8_SB(0, 0), b2, voffB); PG8_STAGE(PG8_SB(0, 1), b2 + hstep, voffB); PG8_STAGE(PG8_SA(0, 0), a2, voffA);
            PG8_WAIT_V(8); PG8_WAIT_L(0); PG8_BAR; PG8_MMA(1, 0, At, B0); PG8_MMA(1, 1, At, B1); PG8_BAR; PG8_SCHED;
            PG8_LDB(B0, 1, 0); PG8_LDB(B1, 1, 1); PG8_SCHED; PG8_LDA(At, 1, 0); PG8_STAGE(PG8_SA(0, 1), a2 + hstep, voffA);
            PG8_WAIT_V(8); PG8_WAIT_L(0); PG8_BAR; PG8_MMA(0, 0, At, B0); PG8_MMA(0, 1, At, B1); PG8_BAR; PG8_SCHED;
            PG8_LDA(At, 1, 1); PG8_STAGE(PG8_SB(1, 0), b3, voffB); PG8_STAGE(PG8_SB(1, 1), b3 + hstep, voffB); PG8_STAGE(PG8_SA(1, 0), a3, voffA);
            PG8_WAIT_V(8); PG8_WAIT_L(0); PG8_BAR; PG8_MMA(1, 0, At, B0); PG8_MMA(1, 1, At, B1); PG8_BAR; PG8_SCHED;
        }
        if constexpr (ALIGN_EPI) { if (wr == 0) PG8_BAR; }
        E(acc, cur, wr, wc, fr, fq, rsl0 + (ui & 1) * 256);
        if (!has_next) break;
#pragma unroll
        for (int a = 0; a < 2; ++a)
#pragma unroll
            for (int b = 0; b < 2; ++b)
#pragma unroll
                for (int m = 0; m < 4; ++m)
#pragma unroll
                    for (int n = 0; n < 2; ++n) acc[a][b][m][n] = (f32x4){0.f, 0.f, 0.f, 0.f};
        cur = nxt; cA = nA; cB = nB; ++ui; if constexpr (Sched::KSPLIT) nt = cur.nk;
        if constexpr (Epi::HAS_PREP) E.prep(cur, rsl0 + (ui & 1) * 256);
        if constexpr (ALIGN_EPI) { if (wr == 1) PG8_BAR; }
    }
    PG8_WAIT_V(0);
    if constexpr (!ALIGN_EPI) { if (wr == 0) PG8_BAR; }
    PG8_BAR;
#undef PG8_SA
#undef PG8_SB
#undef PG8_STAGE
#undef PG8_LDA
#undef PG8_LD32
#undef PG8_LDB
#undef PG8_MMA
#undef PG8_WAIT_V
#undef PG8_WAIT_L
#undef PG8_BAR
#undef PG8_SCHED
}
}

constexpr int NWAVES = 8;
constexpr int BATCH = 2, T = 8192, D = 1024, M = BATCH * T;
constexpr int HG_H = 8, HG_DH = 128;
constexpr int NH = 16, NG = 4, HPG = 4, DH = 64;
constexpr int NCMP = 511, NCMPP = 512, NSEL = 128, NTOP = 16, WIN = 512;
constexpr int FF = 2816, NE = 8, EF = 3584;
constexpr int NIN0 = 4 * D;
constexpr int NKV = 1536, NQIN = 1072, NQINP = 1280;
constexpr int NSLOT = 2 * M + NE * 256;
constexpr float NORM_EPS = 1e-6f;

constexpr size_t MiB = 1u << 20;
constexpr size_t WS_CTL = 0, CTL_ZERO_BYTES = 1 * MiB;
constexpr size_t WS_SSP1 = 222 * MiB, WS_SSP2 = 223 * MiB, WS_SSP3 = 8 * MiB;
constexpr size_t WS_LB = 1 * MiB;
constexpr size_t WS_ROUTE = 6 * MiB;
constexpr size_t WS_W_IN0 = 16 * MiB;
constexpr size_t WS_W_OUT0 = 24 * MiB;
constexpr size_t WS_W_GU0 = 26 * MiB;
constexpr size_t WS_W_DN0 = 37 * MiB;
constexpr size_t WS_W_KV = 43 * MiB;
constexpr size_t WS_W_QIN = 46 * MiB;
constexpr size_t WS_W_OUT1 = 49 * MiB;
constexpr size_t WS_W_GU1 = 51 * MiB;
constexpr size_t WS_W_DN1 = 163 * MiB;
constexpr size_t WS_RS_E = 256 * MiB;
constexpr size_t WS_W1T = 219 * MiB;
constexpr size_t WS_W2T = 221 * MiB;
constexpr size_t WS_PB = 221 * MiB + 256 * 1024;
constexpr size_t WS_XN = 224 * MiB;
constexpr size_t WS_KV = 352 * MiB;
constexpr size_t WS_QG = 400 * MiB;
constexpr size_t WS_OATT = 440 * MiB;
constexpr size_t WS_R = 480 * MiB;
constexpr size_t WS_QFIG = WS_R;
constexpr size_t WS_O0 = WS_R + 128 * MiB;
constexpr size_t WS_OG = WS_R + 192 * MiB;
constexpr size_t WS_ACT = WS_R + 288 * MiB;
constexpr size_t WS_ACT2 = WS_R;
constexpr size_t WS_XG8 = WS_R + 120 * MiB;
constexpr size_t WS_Y2 = WS_R + 256 * MiB;
constexpr size_t WS_YP1 = WS_KV, WS_YP2 = WS_XG8, WS_YP3 = WS_XG8 + 68 * MiB;
static_assert((size_t)NSLOT * D * 2 <= 68 * MiB && WS_YP1 + 68 * MiB <= WS_R && WS_YP3 + 68 * MiB <= WS_Y2, "d_ws map (K-split partials)");
constexpr size_t WS_OACC = WS_R + 272 * MiB;
constexpr size_t WS_END = WS_R + 376 * MiB;
static_assert(WS_ACT2 + (size_t)NSLOT * EF <= WS_XG8 && WS_XG8 + (size_t)NE * M * D <= WS_Y2 && WS_Y2 + (size_t)NSLOT * D * 2 <= WS_END && WS_ACT + (size_t)M * FF * 2 <= WS_END, "d_ws map");
constexpr int CW_TMO = 0;
constexpr int CW_ECNT = 64;
constexpr int CW_BAR = 4096;

constexpr int RING_OFF = 0, RING_BYTES = 131072;
constexpr int LDSCTL_OFF = 147456 - 1024, MISC_OFF = LDSCTL_OFF + 320;
constexpr int LDS_BYTES = 147456;
static_assert(MISC_OFF + 128 <= LDS_BYTES, "LDS map");

#define GAS __attribute__((address_space(1)))
#define LAS __attribute__((address_space(3)))
typedef unsigned short bf16;
typedef unsigned v4u __attribute__((ext_vector_type(4)));
typedef float f32x4 __attribute__((ext_vector_type(4)));
typedef short bf16x8 __attribute__((ext_vector_type(8)));
typedef GAS unsigned gu32;
#define RLX_AGENT __ATOMIC_RELAXED, __HIP_MEMORY_SCOPE_AGENT
#define LDS_WAIT() asm volatile("s_waitcnt lgkmcnt(0)" ::: "memory")
#define VM_WAIT() asm volatile("s_waitcnt vmcnt(0)" ::: "memory")
__device__ __forceinline__ unsigned f2bf(float f) { unsigned u = __builtin_bit_cast(unsigned, f); return (u + 0x7fffu + ((u >> 16) & 1u)) >> 16; }
__device__ __forceinline__ unsigned pk2(float lo, float hi) { return f2bf(lo) | (f2bf(hi) << 16); }
__device__ __forceinline__ float bf2f(unsigned short b) { return __builtin_bit_cast(float, (unsigned)b << 16); }
__device__ __forceinline__ float bflo(unsigned w) { return __builtin_bit_cast(float, w << 16); }
__device__ __forceinline__ float bfhi(unsigned w) { return __builtin_bit_cast(float, w & 0xffff0000u); }
__device__ __forceinline__ float sigmoid_f(float x) { return 1.0f / (1.0f + __expf(-x)); }
#define XB_TMO      128
#define XB_XCNT(j)  (256  + 64 * (j))
#define XB_XSUB(j)  (1280 + 64 * (j))
#define XB_XGEN(j)  (2304 + 64 * (j))
#define XB_TOP      3328
#define XB_TOPGEN   3392
#define XCD_BAR_WORDS 3456
#define XB_SPIN_CAP (1u << 18)

__device__ __forceinline__ unsigned xb_ld(unsigned* p)              { return __hip_atomic_load(p, __ATOMIC_RELAXED, __HIP_MEMORY_SCOPE_AGENT); }
__device__ __forceinline__ unsigned xb_add(unsigned* p, unsigned v) { return __hip_atomic_fetch_add(p, v, __ATOMIC_RELAXED, __HIP_MEMORY_SCOPE_AGENT); }
__device__ __forceinline__ unsigned xb_xcc_id() { return (unsigned)__builtin_amdgcn_s_getreg((3 << 11) | 20) & 0xFu; }
#define XB_SPIN(cond, bar) do { unsigned _sp = 0; while (cond) { __builtin_amdgcn_s_sleep(1); \
    if ((++_sp & 255u) == 0u) { if (xb_ld(&(bar)[XB_TMO])) break; if (_sp > XB_SPIN_CAP) { atomicAdd(&(bar)[XB_TMO], 1u); break; } } } } while (0)

struct XcdBarrier {
    unsigned* bar; unsigned x;
    volatile LAS unsigned* st;
};

__device__ __forceinline__ XcdBarrier xcd_barrier_post(unsigned* bar, volatile LAS unsigned* st) {
    XcdBarrier b; b.bar = bar; b.x = xb_xcc_id(); b.st = st;
    if (threadIdx.x == 0) (void)xb_add(&bar[XB_XCNT(b.x)], 1u);
    return b;
}
__device__ __forceinline__ void xcd_barrier_complete(unsigned* bar, unsigned x, unsigned& nloc, unsigned& nx) {
    const unsigned G = gridDim.x * gridDim.y * gridDim.z;
    unsigned sum, cnt, mine, sp = 0u;
    for (;;) {
        sum = 0u; cnt = 0u; mine = 0u;
#pragma unroll
        for (unsigned j = 0; j < 16; ++j) { const unsigned c = xb_ld(&bar[XB_XCNT(j)]); sum += c; cnt += (c > 0u) ? 1u : 0u; mine = (j == x) ? c : mine; }
        if (sum == G) break;
        __builtin_amdgcn_s_sleep(1);
        if ((++sp & 255u) == 0u) { if (xb_ld(&bar[XB_TMO])) break; if (sp > XB_SPIN_CAP) { atomicAdd(&bar[XB_TMO], 1u); break; } }
    }
    nloc = mine > 0u ? mine : 1u; nx = cnt > 0u ? cnt : 1u;
}

__device__ __forceinline__ void xcd_barrier(const XcdBarrier& b) {
    asm volatile("s_waitcnt vmcnt(0)" ::: "memory");
    __syncthreads();
    if (threadIdx.x == 0) {
        unsigned* bar = b.bar;
        __builtin_amdgcn_s_waitcnt(0);
        unsigned nloc = b.st[0], nx = b.st[1];
        if (nloc == 0u) { xcd_barrier_complete(bar, b.x, nloc, nx); b.st[0] = nloc; b.st[1] = nx; }
        const unsigned old = xb_add(&bar[XB_XSUB(b.x)], 1u);
        const unsigned gen = old / nloc;
        if (old + 1u == (gen + 1u) * nloc) {
            __builtin_amdgcn_fence(__ATOMIC_RELEASE, "agent");
            asm volatile("s_waitcnt vmcnt(0)" ::: "memory");
            const unsigned og = xb_add(&bar[XB_TOP], 1u);
            const unsigned tg = og / nx;
            if (og + 1u == (tg + 1u) * nx) xb_add(&bar[XB_TOPGEN], 1u);
            else XB_SPIN(xb_ld(&bar[XB_TOPGEN]) == tg, bar);
            __builtin_amdgcn_fence(__ATOMIC_ACQUIRE, "agent");
            xb_add(&bar[XB_XGEN(b.x)], 1u);
            asm volatile("s_waitcnt vmcnt(0)" ::: "memory");
        } else {
            XB_SPIN(xb_ld(&bar[XB_XGEN(b.x)]) == gen, bar);
            __builtin_amdgcn_fence(__ATOMIC_ACQUIRE, "agent");
            asm volatile("s_waitcnt vmcnt(0)" ::: "memory");
        }
    }
    __syncthreads();
}

enum InIdx { I_X = 0, I_NORM_MIX = 1, I_NORM_FFN = 2, I_A_W_IN = 3, I_A_W_OUT = 4, I_A_ONORM = 5, I_LB = 6, I_KV_NORM = 7, I_W_KV = 8, I_K_NORM = 9,
             I_CPOS_K = 10, I_CW1_K = 11, I_CW2_K = 12, I_CPOS_V = 13, I_CW1_V = 14, I_CW2_V = 15, I_B_W_IN = 16, I_B_W_OUT = 17, I_B_QNORM = 18, I_REL_BIAS = 19,
             I_FFN_GU = 20, I_FFN_DN = 21, I_MOE_ROUTER = 22, I_MOE_GU = 23, I_MOE_DN = 24, N_IN = 25 };
struct Args { const float* in[N_IN]; float* out; unsigned char* ws; int ph_lo, ph_hi; };
struct Frame {
    LAS unsigned char* lds;
    volatile LAS unsigned* MISC;
    gu32* ctl;
    int tid, lane, wave;
    int vcu, G;
    unsigned char* ws; float* out;
};
__device__ __forceinline__ float wave_sum(float v) {
#pragma unroll
    for (int o = 1; o < 64; o <<= 1) v += __shfl_xor(v, o);
    return v;
}
__device__ __forceinline__ int rel_bucket(int d) {
    d = d < 0 ? 0 : d;
    if (d < 16) return d;
    const float v = logf((float)d / 16.0f) / 4.852030263919617f * 16.0f;
    int lg = 16 + (int)v; return lg < 31 ? lg : 31;
}
__device__ __forceinline__ float gelu_tanh(float x) { const float u = 0.7978845608028654f * (x + 0.044715f * x * x * x); return 0.5f * x * (1.0f + tanhf(u)); }

__device__ __forceinline__ void p0_transpose_item(const float* W, int ldw, int ncols, int K, bf16* WT, int dst_row0, LAS float* scr, int k0, int n0, int lane, const float* gain  ) {
    const int nn = n0 + 4 * (lane & 15); const bool ok = nn + 3 < ncols;
    f32x4 v[16];
#pragma unroll
    for (int i = 0; i < 16; ++i) { const int kk = 4 * i + (lane >> 4); v[i] = ok ? *(const GAS f32x4*)(W + (size_t)(k0 + kk) * ldw + nn) : (f32x4){0.f, 0.f, 0.f, 0.f}; }
#pragma unroll
    for (int i = 0; i < 16; ++i) { const int kk = 4 * i + (lane >> 4); const float gk = gain ? gain[k0 + kk] : 1.0f; LAS float* d = scr + kk * 65 + 4 * (lane & 15);
        d[0] = v[i].x * gk; d[1] = v[i].y * gk; d[2] = v[i].z * gk; d[3] = v[i].w * gk; }
    LDS_WAIT(); asm volatile("" ::: "memory");
#pragma unroll
    for (int i = 0; i < 8; ++i) { const int c = i * 64 + lane, n = c >> 3, kc = c & 7; const LAS float* s = scr + (8 * kc) * 65 + n;
        v4u o; o.x = pk2(s[0 * 65], s[1 * 65]); o.y = pk2(s[2 * 65], s[3 * 65]); o.z = pk2(s[4 * 65], s[5 * 65]); o.w = pk2(s[6 * 65], s[7 * 65]);
        *(GAS v4u*)(WT + (size_t)(dst_row0 + n) * K + k0 + 8 * kc) = o; }
    LDS_WAIT(); asm volatile("" ::: "memory");
}
__device__ __forceinline__ void p0_transpose_item_f8(const float* W, int ldw, int K, unsigned char* WT, int dst_row0, LAS float* scr, int k0, int n0, int lane, const float* gain) {
    const int nn = n0 + 4 * (lane & 15);
    f32x4 v[16];
#pragma unroll
    for (int i = 0; i < 16; ++i) { const int kk = 4 * i + (lane >> 4); v[i] = *(const GAS f32x4*)(W + (size_t)(k0 + kk) * ldw + nn); }
#pragma unroll
    for (int i = 0; i < 16; ++i) { const int kk = 4 * i + (lane >> 4); const float gk = (gain ? gain[k0 + kk] : 1.0f) * pg8::F8_WSCALE; LAS float* d = scr + kk * 65 + 4 * (lane & 15);
        d[0] = v[i].x * gk; d[1] = v[i].y * gk; d[2] = v[i].z * gk; d[3] = v[i].w * gk; }
    LDS_WAIT(); asm volatile("" ::: "memory");
#pragma unroll
    for (int i = 0; i < 4; ++i) { const int c = i * 64 + lane, n = c >> 2, kc = c & 3; const LAS float* s = scr + (16 * kc) * 65 + n;
        v4u o; o.x = pg8::pk4_fp8(s[0 * 65], s[1 * 65], s[2 * 65], s[3 * 65]); o.y = pg8::pk4_fp8(s[4 * 65], s[5 * 65], s[6 * 65], s[7 * 65]);
        o.z = pg8::pk4_fp8(s[8 * 65], s[9 * 65], s[10 * 65], s[11 * 65]); o.w = pg8::pk4_fp8(s[12 * 65], s[13 * 65], s[14 * 65], s[15 * 65]);
        *(GAS v4u*)(WT + (size_t)(dst_row0 + n) * K + k0 + 16 * kc) = o; }
    LDS_WAIT(); asm volatile("" ::: "memory");
}
template <int GU> __device__ __forceinline__ void p0_item_f8(const float* W, int ldw, int npad, int K, unsigned char* WT, LAS float* scr, int r, int lane, const float* gain) {
    const int nblk = npad / 64, kb = r / nblk, nb = r % nblk, n0 = 64 * nb;
    int dst = n0;
    if (GU) { if (n0 < GU) dst = 256 * (n0 / 128) + (n0 % 128); else { const int n1 = n0 - GU; dst = 256 * (n1 / 128) + 128 + (n1 % 128); } }
    p0_transpose_item_f8(W, ldw, K, WT, dst, scr, 64 * kb, n0, lane, gain);
}
template <int GU> __device__ __forceinline__ void p0_item(const float* W, int ldw, int ncols, int npad, int K, bf16* WT, LAS float* scr, int r, int lane, const float* gain = nullptr) {
    const int nblk = npad / 64, kb = r / nblk, nb = r % nblk, n0 = 64 * nb;
    int dst = n0;
    if (GU) { if (n0 < GU) dst = 256 * (n0 / 128) + (n0 % 128); else { const int n1 = n0 - GU; dst = 256 * (n1 / 128) + 128 + (n1 % 128); } }
    p0_transpose_item(W, ldw, ncols, K, WT, dst, scr, 64 * kb, n0, lane, gain);
}
__device__ __forceinline__ void rms_row_to_bf16(const float* xrow, const float* gain, bf16* orow, int lane) {
    const GAS f32x4* xr = (const GAS f32x4*)xrow + lane; const GAS f32x4* gr = (const GAS f32x4*)gain + lane;
    f32x4 v[4]; float s = 0.f;
#pragma unroll
    for (int j = 0; j < 4; ++j) { v[j] = xr[64 * j]; s += (v[j].x * v[j].x + v[j].y * v[j].y) + (v[j].z * v[j].z + v[j].w * v[j].w); }
    const float rstd = 1.0f / sqrtf(wave_sum(s) * (1.f / D) + NORM_EPS);
    GAS unsigned long long* o8 = (GAS unsigned long long*)orow + lane;
#pragma unroll
    for (int j = 0; j < 4; ++j) { const f32x4 gg = gain ? gr[64 * j] : (f32x4){1.f, 1.f, 1.f, 1.f}; o8[64 * j] = (unsigned long long)pk2(v[j].x * rstd * gg.x, v[j].y * rstd * gg.y) | ((unsigned long long)pk2(v[j].z * rstd * gg.z, v[j].w * rstd * gg.w) << 32); }
}
__device__ __forceinline__ void p0_prologue(Frame& F, const Args& a) {
    LAS float* scr = (LAS float*)(F.lds + RING_OFF + F.wave * 16640);
    const int gw = F.vcu * NWAVES + F.wave, NGW = F.G * NWAVES;
    unsigned char* ws = F.ws;
    constexpr int I1 = 16 * 64, I2 = 16 * 16, I3 = 16 * 88, I4 = 44 * 16, I5 = 16 * 24, I6 = 16 * 20, I7 = 16 * 16, I8 = 16 * 112, I9 = 56 * 16;
    constexpr int I10 = 32 * 4, I11 = 4 * 1;
    constexpr int NITEMS = I1 + I2 + I3 + I4 + I5 + I6 + I7 + NE * I8 + NE * I9 + 2 * I10 + 2 * I11;
    for (int it = gw; it < NITEMS; it += NGW) {
        int r = it;
        if (r < I1) { p0_item<0>(a.in[I_A_W_IN], NIN0, NIN0, NIN0, D, (bf16*)(ws + WS_W_IN0), scr, r, F.lane, a.in[I_NORM_MIX]); continue; } r -= I1;
        if (r < I2) { p0_item<0>(a.in[I_A_W_OUT], D, D, D, D, (bf16*)(ws + WS_W_OUT0), scr, r, F.lane); continue; } r -= I2;
        if (r < I3) { p0_item<FF>(a.in[I_FFN_GU], 2 * FF, 2 * FF, 2 * FF, D, (bf16*)(ws + WS_W_GU0), scr, r, F.lane, a.in[I_NORM_FFN]); continue; } r -= I3;
        if (r < I4) { p0_item<0>(a.in[I_FFN_DN], D, D, D, FF, (bf16*)(ws + WS_W_DN0), scr, r, F.lane); continue; } r -= I4;
        if (r < I5) { p0_item<0>(a.in[I_W_KV], NKV, NKV, NKV, D, (bf16*)(ws + WS_W_KV), scr, r, F.lane, a.in[I_KV_NORM]); continue; } r -= I5;
        if (r < I6) { p0_item<0>(a.in[I_B_W_IN], NQIN, NQIN, NQINP, D, (bf16*)(ws + WS_W_QIN), scr, r, F.lane, a.in[I_NORM_MIX] + D); continue; } r -= I6;
        if (r < I7) { p0_item<0>(a.in[I_B_W_OUT], D, D, D, D, (bf16*)(ws + WS_W_OUT1), scr, r, F.lane); continue; } r -= I7;
        if (r < NE * I8) { const int e = r / I8; p0_item_f8<EF>(a.in[I_MOE_GU] + (size_t)e * D * 2 * EF, 2 * EF, 2 * EF, D, (unsigned char*)(ws + WS_W_GU1) + (size_t)e * 2 * EF * D, scr, r % I8, F.lane, a.in[I_NORM_FFN] + D); continue; } r -= NE * I8;
        if (r < NE * I9) { const int e = r / I9; p0_item_f8<0>(a.in[I_MOE_DN] + (size_t)e * EF * D, D, D, EF, (unsigned char*)(ws + WS_W_DN1) + (size_t)e * D * EF, scr, r % I9, F.lane, nullptr); continue; } r -= NE * I9;
        if (r < 2 * I10) { const int kv = r / I10; p0_item<0>(a.in[kv ? I_CW1_V : I_CW1_K], 256, 256, 256, 2048, (bf16*)(ws + WS_W1T) + (size_t)kv * 256 * 2048, scr, r % I10, F.lane); continue; } r -= 2 * I10;
        { const int kv = r / I11; p0_item<0>(a.in[kv ? I_CW2_V : I_CW2_K], 64, 64, 64, 256, (bf16*)(ws + WS_W2T) + (size_t)kv * 64 * 256, scr, r % I11, F.lane); }
    }
    if (blockIdx.x == 0) {
        const float* lbp = a.in[I_LB]; float* lbv = (float*)(ws + WS_LB);
        for (int c = F.tid; c < D; c += NWAVES * 64) { const float p0 = lbp[c], p1 = lbp[D + c], mx = fmaxf(p0, p1), e0 = __expf(p0 - mx), e1 = __expf(p1 - mx); lbv[c] = e0 / (e0 + e1); }
    }
    if (blockIdx.x == 1) {
        const int kv = F.tid >> 8, hidx = F.tid & 255; const float* w1 = a.in[kv ? I_CW1_V : I_CW1_K]; const float* pos = a.in[kv ? I_CPOS_V : I_CPOS_K]; float s = 0.f;
        for (int kk = 0; kk < 2048; ++kk) s += pos[kk] * w1[(size_t)kk * 256 + hidx];
        ((float*)(ws + WS_PB))[kv * 256 + hidx] = s;
    }
    const float* x = a.in[I_X]; const float* gmix = a.in[I_NORM_MIX]; bf16* XN = (bf16*)(ws + WS_XN);
    for (int m = gw; m < M; m += NGW) rms_row_to_bf16(x + (size_t)m * D, nullptr, XN + (size_t)m * D, F.lane);
}


typedef float f32x16 __attribute__((ext_vector_type(16)));
typedef float f32x2v __attribute__((ext_vector_type(2)));
typedef __bf16 bf16x2v __attribute__((ext_vector_type(2)));
#define MFMA32(a, b, c) __builtin_amdgcn_mfma_f32_32x32x16_bf16((a), (b), (c), 0, 0, 0)
constexpr float LOG2E = 1.4426950408889634f;
constexpr size_t WS_QN = WS_R + 336 * MiB;
constexpr size_t WS_VTS = 8 * MiB;
constexpr size_t WS_VTW = WS_R + 368 * MiB;
constexpr size_t WS_KF = WS_R + 240 * MiB;
constexpr size_t WS_VF = WS_R + 248 * MiB;
constexpr size_t WS_KC16 = 2 * MiB;
constexpr size_t WS_VTC = 3 * MiB;
constexpr size_t WS_BLG = 3 * MiB + 512 * 1024;
static_assert(WS_QN + (size_t)M * D * 2 <= WS_VTW && WS_VTW + 8 * MiB <= WS_END && WS_OACC + (size_t)M * D * 4 <= WS_QN, "d_ws map (attention)");
__device__ __forceinline__ int perm16(int x) { const int g4 = (x >> 2) & 3; const int gp = (g4 == 1) ? 2 : ((g4 == 2) ? 1 : g4); return (gp << 2) | (x & 3); }
__device__ __forceinline__ unsigned cvtpk(float lo, float hi) { f32x2v v = {lo, hi}; bf16x2v b = __builtin_convertvector(v, bf16x2v); return __builtin_bit_cast(unsigned, b); }
__device__ __forceinline__ bf16x8 pack8(const f32x16& p, int s) { v4u w; w.x = cvtpk(p[8 * s], p[8 * s + 1]); w.y = cvtpk(p[8 * s + 2], p[8 * s + 3]); w.z = cvtpk(p[8 * s + 4], p[8 * s + 5]); w.w = cvtpk(p[8 * s + 6], p[8 * s + 7]); return __builtin_bit_cast(bf16x8, w); }
__device__ __forceinline__ bf16x8 ldg8(const bf16* p) { return *(const GAS bf16x8*)p; }


constexpr size_t WS_UT = WS_O0;
constexpr size_t WS_ST = WS_ACT;
constexpr size_t WS_DEC = 2 * MiB;
constexpr int HG_SEG = 0, HG_AP = 2048, HG_AQ = HG_AP + 64 * 136 * 2, HG_BP = HG_AQ + 64 * 136 * 2, HG_VT = HG_BP + 64 * 136 * 2, HG_KDT = HG_VT + 128 * 72 * 2, HG_PS = HG_KDT + 128 * 72 * 2;
static_assert(HG_PS + 1024 <= RING_BYTES, "HGRN2 LDS map");
__device__ __forceinline__ void hg_gates_raw(const unsigned short (&rf)[16], float lb, LAS float* SEG, int d, int seg, float (&kk)[16], float (&bb)[16], float& b31, float& blast) {
    float acc = 0.f;
#pragma unroll
    for (int u = 0; u < 16; ++u) { const float f = bf2f(rf[u]); const float g = lb + (1.f - lb) * sigmoid_f(f); kk[u] = 1.f - g; acc += __logf(g); bb[u] = acc; }
    SEG[seg * 128 + d] = acc;
    __syncthreads();
    const float s0 = SEG[d], s1 = SEG[128 + d], s2 = SEG[256 + d], s3 = SEG[384 + d];
    const float pre = seg == 0 ? 0.f : (seg == 1 ? s0 : (seg == 2 ? s0 + s1 : s0 + s1 + s2));
    b31 = s0 + s1; blast = (s0 + s1) + (s2 + s3);
#pragma unroll
    for (int u = 0; u < 16; ++u) bb[u] += pre;
}
__device__ __forceinline__ void p_hg_a(Frame& F) {
    const bf16* QFIG = (const bf16*)(F.ws + WS_QFIG); bf16* UT = (bf16*)(F.ws + WS_UT); float* DEC = (float*)(F.ws + WS_DEC); const float* lbv = (const float*)(F.ws + WS_LB);
    LAS float* SEG = (LAS float*)(F.lds + HG_SEG); LAS unsigned short* VT = (LAS unsigned short*)(F.lds + HG_VT); LAS unsigned short* KDT = (LAS unsigned short*)(F.lds + HG_KDT);
    const int tid = F.tid, lane = F.lane, w = F.wave, d = tid & 127, seg = tid >> 7, l31 = lane & 31, hi = lane >> 5;
    unsigned short rf[16], rv[16];
#define HA_LOAD_RAW(un) do { const int bh_ = (un) >> 7, j_ = (un) & 127; const bf16* r0_ = QFIG + (size_t)((bh_ >> 3) * T + 64 * j_ + 16 * seg) * NIN0 + (bh_ & 7) * 128 + d; \
        _Pragma("unroll") for (int u = 0; u < 16; ++u) { rf[u] = r0_[(size_t)u * NIN0 + D]; rv[u] = r0_[(size_t)u * NIN0 + 2 * D]; } } while (0)
    const int nunits = BATCH * HG_H * (T / 64);
    if (F.vcu < nunits) HA_LOAD_RAW(F.vcu);
    for (int unit = F.vcu; unit < nunits; unit += F.G) {
        const int bh = unit >> 7, h = bh & 7;
        float kk[16], bb[16], b31, blast;
        __syncthreads();
        hg_gates_raw(rf, lbv[h * 128 + d], SEG, d, seg, kk, bb, b31, blast);
#pragma unroll
        for (int u = 0; u < 16; ++u) { KDT[d * 72 + 16 * seg + u] = (unsigned short)f2bf(kk[u] * __expf(blast - bb[u])); VT[d * 72 + 16 * seg + u] = rv[u]; }
        if (seg == 3) DEC[(size_t)unit * 128 + d] = __expf(blast);
        if (unit + F.G < nunits) HA_LOAD_RAW(unit + F.G);
        __syncthreads();
        const int et = w >> 1;
#pragma unroll
        for (int dd = 0; dd < 2; ++dd) { const int dt = (w & 1) * 2 + dd; f32x16 c = (f32x16){0.f,0.f,0.f,0.f,0.f,0.f,0.f,0.f,0.f,0.f,0.f,0.f,0.f,0.f,0.f,0.f};
#pragma unroll
            for (int ks = 0; ks < 4; ++ks) { const bf16x8 av = *(const LAS bf16x8*)(VT + (32 * et + l31) * 72 + 16 * ks + 8 * hi), bv = *(const LAS bf16x8*)(KDT + (32 * dt + l31) * 72 + 16 * ks + 8 * hi); c = MFMA32(av, bv, c); }
            bf16* up = UT + ((size_t)unit * 128 + 32 * et + 4 * hi) * 128 + 32 * dt + l31;
#pragma unroll
            for (int r = 0; r < 16; ++r) up[(size_t)((r & 3) + 8 * (r >> 2)) * 128] = (bf16)f2bf(c[r]); }
    }
#undef HA_LOAD_RAW
}
__device__ __forceinline__ void p_hg_b(Frame& F) {
    const unsigned* UT = (const unsigned*)(F.ws + WS_UT); unsigned* ST = (unsigned*)(F.ws + WS_ST); const float* DEC = (const float*)(F.ws + WS_DEC);
    const int gt = F.vcu * (NWAVES * 64) + F.tid, NT = F.G * NWAVES * 64;
    for (int idx = gt; idx < BATCH * HG_H * 128 * 64; idx += NT) {
        const int bh = idx >> 13, e = (idx >> 6) & 127, dp = idx & 63;
        float s0 = 0.f, s1 = 0.f;
        size_t off = ((size_t)(bh * 128) * 128 + e) * 64 + dp;
        const float* dc = DEC + (size_t)(bh * 128) * 128 + 2 * dp;
        for (int j0 = 0; j0 < 128; j0 += 8) {
            unsigned uu[8]; f32x2v dd[8];
#pragma unroll
            for (int k = 0; k < 8; ++k) { uu[k] = UT[off + (size_t)(j0 + k) * 128 * 64]; dd[k] = *(const GAS f32x2v*)(dc + (size_t)(j0 + k) * 128); }
#pragma unroll
            for (int k = 0; k < 8; ++k) { ST[off + (size_t)(j0 + k) * 128 * 64] = pk2(s0, s1); s0 = dd[k].x * s0 + bflo(uu[k]); s1 = dd[k].y * s1 + bfhi(uu[k]); }
        }
    }
}
__device__ __forceinline__ void p_hg_c(Frame& F, const float* gon) {
    const bf16* QFIG = (const bf16*)(F.ws + WS_QFIG); const bf16* ST = (const bf16*)(F.ws + WS_ST); bf16* OG = (bf16*)(F.ws + WS_OG); const float* lbv = (const float*)(F.ws + WS_LB);
    LAS float* SEG = (LAS float*)(F.lds + HG_SEG); LAS unsigned short* AP = (LAS unsigned short*)(F.lds + HG_AP); LAS unsigned short* AQ = (LAS unsigned short*)(F.lds + HG_AQ);
    LAS unsigned short* BP = (LAS unsigned short*)(F.lds + HG_BP); LAS unsigned short* VT = (LAS unsigned short*)(F.lds + HG_VT); LAS float* PS = (LAS float*)(F.lds + HG_PS);
    const int tid = F.tid, lane = F.lane, w = F.wave, d = tid & 127, seg = tid >> 7, l31 = lane & 31, hi = lane >> 5;
    const int st = w & 1, et = w >> 1;
    unsigned short rq[16], rf[16], rv[16]; bf16x8 sfr[8];
#define HC_LOAD_RAW(un) do { const int bh_ = (un) >> 7, j_ = (un) & 127; const bf16* r0_ = QFIG + (size_t)((bh_ >> 3) * T + 64 * j_ + 16 * seg) * NIN0 + (bh_ & 7) * 128 + d; \
        _Pragma("unroll") for (int u = 0; u < 16; ++u) { rq[u] = r0_[(size_t)u * NIN0]; rf[u] = r0_[(size_t)u * NIN0 + D]; rv[u] = r0_[(size_t)u * NIN0 + 2 * D]; } } while (0)
#define HC_LOAD_ST(un) do { const bf16* sp_ = ST + ((size_t)(un) * 128 + 32 * et + l31) * 128 + 8 * hi; _Pragma("unroll") for (int ks = 0; ks < 8; ++ks) sfr[ks] = ldg8(sp_ + 16 * ks); } while (0)
    const int nunits = BATCH * HG_H * (T / 64);
    if (F.vcu < nunits) { HC_LOAD_RAW(F.vcu); HC_LOAD_ST(F.vcu); }
    for (int unit = F.vcu; unit < nunits; unit += F.G) {
        const int bh = unit >> 7, j = unit & 127, b = bh >> 3, h = bh & 7;
        float kk[16], bb[16], b31, blast;
        __syncthreads();
        hg_gates_raw(rf, lbv[h * 128 + d], SEG, d, seg, kk, bb, b31, blast);
        const float eb31 = __expf(b31);
#pragma unroll
        for (int u = 0; u < 16; ++u) { const int tok = 16 * seg + u; const float q = bf2f(rq[u]);
            const float er = __expf(bb[u] - b31);
            AP[tok * 136 + d] = (unsigned short)f2bf(q * er); AQ[tok * 136 + d] = (unsigned short)f2bf(q * er * eb31);
            BP[tok * 136 + d] = (unsigned short)f2bf(kk[u] * __builtin_amdgcn_rcpf(er)); VT[d * 72 + 16 * seg + perm16(u)] = rv[u]; }
        if (unit + F.G < nunits) HC_LOAD_RAW(unit + F.G);
        __syncthreads();
        f32x16 o = (f32x16){0.f,0.f,0.f,0.f,0.f,0.f,0.f,0.f,0.f,0.f,0.f,0.f,0.f,0.f,0.f,0.f};
#pragma unroll
        for (int ks = 0; ks < 8; ++ks) { const bf16x8 bv = *(const LAS bf16x8*)(AQ + (32 * st + l31) * 136 + 16 * ks + 8 * hi); o = MFMA32(sfr[ks], bv, o); }
        if (unit + F.G < nunits) HC_LOAD_ST(unit + F.G);
        for (int ut = 0; ut <= st; ++ut) { f32x16 at = (f32x16){0.f,0.f,0.f,0.f,0.f,0.f,0.f,0.f,0.f,0.f,0.f,0.f,0.f,0.f,0.f,0.f};
#pragma unroll
            for (int ks = 0; ks < 8; ++ks) { const bf16x8 av = *(const LAS bf16x8*)(BP + (32 * ut + l31) * 136 + 16 * ks + 8 * hi), bv = *(const LAS bf16x8*)(AP + (32 * st + l31) * 136 + 16 * ks + 8 * hi); at = MFMA32(av, bv, at); }
            if (ut == st) {
#pragma unroll
                for (int r = 0; r < 16; ++r) at[r] = ((r & 3) + 8 * (r >> 2) + 4 * hi <= l31) ? at[r] : 0.f; }
            const bf16x8 pb0 = pack8(at, 0), pb1 = pack8(at, 1);
            const bf16x8 v0 = *(const LAS bf16x8*)(VT + (32 * et + l31) * 72 + 32 * ut + 8 * hi), v1 = *(const LAS bf16x8*)(VT + (32 * et + l31) * 72 + 32 * ut + 16 + 8 * hi);
            o = MFMA32(v0, pb0, o); o = MFMA32(v1, pb1, o); }
        float ss = 0.f;
#pragma unroll
        for (int r = 0; r < 16; ++r) ss += o[r] * o[r];
        ss += __shfl_xor(ss, 32);
        if (hi == 0) PS[et * 64 + 32 * st + l31] = ss;
        __syncthreads();
        const int s = 32 * st + l31; const float tot = (PS[s] + PS[64 + s]) + (PS[128 + s] + PS[192 + s]);
        const float rstd = 1.0f / sqrtf(tot * (1.f / 128.f) + NORM_EPS);
        const size_t mrow = (size_t)b * T + 64 * j + s;
        const bf16* gp = QFIG + mrow * NIN0 + 3 * D + h * 128 + 32 * et + 4 * hi; bf16* op = OG + mrow * D + h * 128 + 32 * et + 4 * hi; const float* gop = gon + 32 * et + 4 * hi;
#pragma unroll
        for (int q4 = 0; q4 < 4; ++q4) { const unsigned long long gw8 = *(const GAS unsigned long long*)(gp + 8 * q4); const unsigned glo = (unsigned)gw8, ghi = (unsigned)(gw8 >> 32); const f32x4 go = *(const GAS f32x4*)(gop + 8 * q4);
            const float a0 = bflo(glo), a1 = bfhi(glo), a2 = bflo(ghi), a3 = bfhi(ghi);
            const float y0 = o[4 * q4] * rstd * go.x * (a0 * sigmoid_f(a0)), y1 = o[4 * q4 + 1] * rstd * go.y * (a1 * sigmoid_f(a1)), y2 = o[4 * q4 + 2] * rstd * go.z * (a2 * sigmoid_f(a2)), y3 = o[4 * q4 + 3] * rstd * go.w * (a3 * sigmoid_f(a3));
            *(GAS unsigned long long*)(op + 8 * q4) = (unsigned long long)cvtpk(y0, y1) | ((unsigned long long)cvtpk(y2, y3) << 32); }
    }
}

__device__ __forceinline__ void p_knorm(Frame& F, const float* kng) {
    bf16* KV = (bf16*)(F.ws + WS_KV);
    const int gt = F.vcu * (NWAVES * 64) + F.tid, NT = F.G * NWAVES * 64;
    for (int idx = gt; idx < M * 8; idx += NT) {
        const int m = idx >> 3, j = idx & 7; const int col0 = j < 4 ? 512 + 64 * j : 1024 + 64 * (j - 4); const float* gain = kng + (j < 4 ? 64 : 128);
        GAS v4u* p = (GAS v4u*)(KV + (size_t)m * NKV + col0);
        v4u w[8]; float ss = 0.f;
#pragma unroll
        for (int i = 0; i < 8; ++i) { w[i] = p[i];
#pragma unroll
            for (int k = 0; k < 4; ++k) { const float a = bflo(w[i][k]), b = bfhi(w[i][k]); ss += a * a + b * b; } }
        const float rstd = 1.0f / sqrtf(ss * (1.f / 64.f) + NORM_EPS);
#pragma unroll
        for (int i = 0; i < 8; ++i) { v4u o;
#pragma unroll
            for (int k = 0; k < 4; ++k) o[k] = pk2(bflo(w[i][k]) * rstd * gain[8 * i + 2 * k], bfhi(w[i][k]) * rstd * gain[8 * i + 2 * k + 1]);
            p[i] = o;
            if (j < 4) { const int bq = m >> 13, tq = m & (T - 1);
                ((v4u*)(F.ws + WS_KF))[(size_t)((((bq * 4 + j) * 128 + (tq >> 6)) * 2 + ((tq >> 5) & 1)) * 4 + (i >> 1)) * 64 + (i & 1) * 32 + (tq & 31)] = o; } }
    }
}
__device__ __forceinline__ void p_route(Frame& F, const Args& a, bool dry = false) {
    const float* H3 = F.out; const float* gain = a.in[I_NORM_FFN] + D; const float* wr = a.in[I_MOE_ROUTER];
    unsigned* route = (unsigned*)(F.ws + WS_ROUTE); gu32* ecnt = F.ctl + CW_ECNT;
    const int gw = F.vcu * NWAVES + F.wave, NGW = F.G * NWAVES;
    for (int m = gw; m < M; m += NGW) {
        const GAS f32x4* xr = (const GAS f32x4*)(H3 + (size_t)m * D) + F.lane; const GAS f32x4* gr = (const GAS f32x4*)gain + F.lane;
        f32x4 v[4]; float s = 0.f;
#pragma unroll
        for (int j = 0; j < 4; ++j) { v[j] = xr[64 * j]; s += (v[j].x * v[j].x + v[j].y * v[j].y) + (v[j].z * v[j].z + v[j].w * v[j].w); }
        const float rstd = 1.0f / sqrtf(wave_sum(s) * (1.f / D) + NORM_EPS);
        float lg[8];
#pragma unroll
        for (int e = 0; e < 8; ++e) lg[e] = 0.f;
#pragma unroll
        for (int j = 0; j < 4; ++j) { const f32x4 gg = gr[64 * j]; const f32x4 y = (f32x4){v[j].x * rstd * gg.x, v[j].y * rstd * gg.y, v[j].z * rstd * gg.z, v[j].w * rstd * gg.w};
            const GAS f32x4* wp = (const GAS f32x4*)(wr + (size_t)(256 * j + 4 * F.lane) * 8);
#pragma unroll
            for (int k = 0; k < 4; ++k) { const f32x4 w0 = wp[2 * k], w1 = wp[2 * k + 1]; const float yk = y[k];
                lg[0] += yk * w0.x; lg[1] += yk * w0.y; lg[2] += yk * w0.z; lg[3] += yk * w0.w; lg[4] += yk * w1.x; lg[5] += yk * w1.y; lg[6] += yk * w1.z; lg[7] += yk * w1.w; } }
#pragma unroll
        for (int e = 0; e < 8; ++e) lg[e] = wave_sum(lg[e]);
        if (dry) continue;
        int e0 = 0; float v0 = lg[0];
#pragma unroll
        for (int e = 1; e < 8; ++e) if (lg[e] > v0) { v0 = lg[e]; e0 = e; }
        int e1 = -1; float v1 = -3.0e38f;
#pragma unroll
        for (int e = 0; e < 8; ++e) if (e != e0 && lg[e] > v1) { v1 = lg[e]; e1 = e; }
        const float w0 = 1.0f / (1.0f + __expf(v1 - v0)), w1 = 1.0f - w0;
        unsigned p0 = 0u, p1 = 0u;
        if (F.lane == 0) { p0 = __hip_atomic_fetch_add(ecnt + e0, 1u, RLX_AGENT); p1 = __hip_atomic_fetch_add(ecnt + e1, 1u, RLX_AGENT);
            unsigned* r = route + (size_t)m * 8; r[0] = (unsigned)e0; r[1] = (unsigned)e1; r[2] = p0; r[3] = p1; r[4] = __float_as_uint(w0); r[5] = __float_as_uint(w1);
            float* rse = (float*)(F.ws + WS_RS_E); rse[(size_t)e0 * M + p0] = rstd; rse[(size_t)e1 * M + p1] = rstd; }
        p0 = (unsigned)__builtin_amdgcn_readfirstlane((int)p0); p1 = (unsigned)__builtin_amdgcn_readfirstlane((int)p1);
        unsigned char* x0 = (unsigned char*)(F.ws + WS_XG8) + ((size_t)e0 * M + p0) * D, *x1 = (unsigned char*)(F.ws + WS_XG8) + ((size_t)e1 * M + p1) * D;
#pragma unroll
        for (int j = 0; j < 4; ++j) { const unsigned w8 = pg8::pk4_fp8(v[j].x, v[j].y, v[j].z, v[j].w); ((GAS unsigned*)(x0 + 256 * j))[F.lane] = w8; ((GAS unsigned*)(x1 + 256 * j))[F.lane] = w8; }
    }
}
template <bool KS> struct MoeOrderT {
    static constexpr bool KSPLIT = KS;
    int cn[8]; int ncol, G, c; bool apm;
    __device__ __forceinline__ void init(const gu32* cnt, int ncol_, int G_, int c_, bool apm_) { ncol = ncol_; G = G_; c = c_; apm = apm_;
#pragma unroll
        for (int e = 0; e < 8; ++e) cn[e] = __builtin_amdgcn_readfirstlane((int)__hip_atomic_load(cnt + e, RLX_AGENT)); }
    __device__ __forceinline__ bool next(int i, pg8::Unit& u) const {
        int L = i * G + c, part = 0; bool sp = false; int base = 0, tiles = 0; bool found = false;
        if constexpr (KS) { if (i >= 2) { const int q = (i - 2) * G + c; L = 2 * G + (q >> 2); part = q & 3; sp = true; }
            u.part = part; u.k0 = sp ? part * 8 - (part == 3 ? 2 : 0) : 0; u.nk = sp ? (part < 2 ? 8 : 6) : EF / 128; }
#pragma unroll
        for (int e = 0; e < 8; ++e) { const int n = (cn[e] + 255) >> 8; const int units = n * ncol;
            if (!found && L < base + units) { found = true; const int r = L - base; u.pnl = r / n; const int rt = r - u.pnl * n; u.pm = tiles + rt; u.pn = e * ncol + u.pnl; u.pa = apm ? e * (M / 256) + rt : u.pm; u.nv = cn[e] - 256 * rt; }
            base += units; tiles += n; }
        return found;
    }
};
typedef MoeOrderT<false> MoeOrder; typedef MoeOrderT<true> MoeOrderKS;
static_assert(EF / 128 == 28, "the K-split parts are 8 + 8 + 6 + 6 K-tiles");

__device__ __forceinline__ void p_moe_combine(Frame& F) {
    const unsigned* route = (const unsigned*)(F.ws + WS_ROUTE); const bf16* Y = (const bf16*)(F.ws + WS_Y2); float* out = F.out;
    const int gw = F.vcu * NWAVES + F.wave, NGW = F.G * NWAVES;
    int off[9]; off[0] = 0;
#pragma unroll
    for (int e = 0; e < 8; ++e) off[e + 1] = off[e] + (((int)__hip_atomic_load(F.ctl + CW_ECNT + e, RLX_AGENT) + 255) & ~255);
    const bf16* Y1 = (const bf16*)(F.ws + WS_YP1); const bf16* Y2 = (const bf16*)(F.ws + WS_YP2); const bf16* Y3 = (const bf16*)(F.ws + WS_YP3);
    for (int m = gw; m < M; m += NGW) { const unsigned* r = route + (size_t)m * 8; const float w0 = __uint_as_float(r[4]), w1 = __uint_as_float(r[5]); const int e0 = (int)r[0], e1 = (int)r[1];
        int o0 = 0, o1 = 0;
#pragma unroll
        for (int e = 0; e < 8; ++e) { o0 = (e == e0) ? off[e] : o0; o1 = (e == e1) ? off[e] : o1; }
        const int s0 = o0 + (int)r[2], s1 = o1 + (int)r[3];
        int n0 = 0, n1 = 0;
#pragma unroll
        for (int e = 0; e < 8; ++e) { n0 = (e == e0) ? (off[e + 1] - off[e]) >> 8 : n0; n1 = (e == e1) ? (off[e + 1] - off[e]) >> 8 : n1; }
        const int l0 = (o0 >> 8) * 4 + ((int)r[2] >> 8) - 2 * F.G, l1 = (o1 >> 8) * 4 + ((int)r[3] >> 8) - 2 * F.G;
        GAS f32x4* o = (GAS f32x4*)(out + (size_t)m * D) + F.lane;
        const GAS unsigned long long* y0 = (const GAS unsigned long long*)(Y + (size_t)s0 * D) + F.lane; const GAS unsigned long long* y1 = (const GAS unsigned long long*)(Y + (size_t)s1 * D) + F.lane;
#pragma unroll
        for (int j = 0; j < 4; ++j) { f32x4 v = o[64 * j]; const unsigned long long a = y0[64 * j], b = y1[64 * j];
            f32x4 ya = {bflo((unsigned)a), bfhi((unsigned)a), bflo((unsigned)(a >> 32)), bfhi((unsigned)(a >> 32))}, yb = {bflo((unsigned)b), bfhi((unsigned)b), bflo((unsigned)(b >> 32)), bfhi((unsigned)(b >> 32))};
            if (l0 + j * n0 >= 0) {
#pragma unroll
                for (int p = 0; p < 3; ++p) { const unsigned long long q = ((const GAS unsigned long long*)((p == 0 ? Y1 : p == 1 ? Y2 : Y3) + (size_t)s0 * D) + F.lane)[64 * j];
                    ya += (f32x4){bflo((unsigned)q), bfhi((unsigned)q), bflo((unsigned)(q >> 32)), bfhi((unsigned)(q >> 32))}; } }
            if (l1 + j * n1 >= 0) {
#pragma unroll
                for (int p = 0; p < 3; ++p) { const unsigned long long q = ((const GAS unsigned long long*)((p == 0 ? Y1 : p == 1 ? Y2 : Y3) + (size_t)s1 * D) + F.lane)[64 * j];
                    yb += (f32x4){bflo((unsigned)q), bfhi((unsigned)q), bflo((unsigned)(q >> 32)), bfhi((unsigned)(q >> 32))}; } }
            v.x += w0 * ya[0] + w1 * yb[0]; v.y += w0 * ya[1] + w1 * yb[1]; v.z += w0 * ya[2] + w1 * yb[2]; v.w += w0 * ya[3] + w1 * yb[3];
            o[64 * j] = v; } }
}

__device__ __forceinline__ void p_compress_mfma(Frame& F, const float* kng0) {
    const bf16* KV = (const bf16*)(F.ws + WS_KV); const bf16* W1T = (const bf16*)(F.ws + WS_W1T); const bf16* W2T = (const bf16*)(F.ws + WS_W2T); const float* PB = (const float*)(F.ws + WS_PB);
    LAS unsigned short* TK = (LAS unsigned short*)(F.lds);
    LAS unsigned short* HD = TK + 528 * 72;
    const int tid = F.tid, lane = F.lane, w = F.wave, l31 = lane & 31, hi = lane >> 5;
    for (int unit = F.vcu; unit < 256; unit += F.G) {
        const int kvsel = unit >> 7, bg = (unit >> 4) & 7, rg = unit & 15, n0 = 32 * rg, b = bg >> 2, g = bg & 3;
        const int col0 = kvsel * 256 + g * 64;
        __syncthreads();
        for (int c = tid; c < 528 * 8; c += NWAVES * 64) { const int row = c >> 3, part = c & 7; int tok = 16 * n0 + row; tok = tok < T ? tok : T - 1;
            const v4u val = *(const GAS v4u*)(KV + (size_t)(b * T + tok) * NKV + col0 + 8 * part);
            *(LAS v4u*)(TK + ((row & 15) * 33 + (row >> 4)) * 72 + 8 * part) = val; }
        __syncthreads();
        f32x16 acc = (f32x16){0.f,0.f,0.f,0.f,0.f,0.f,0.f,0.f,0.f,0.f,0.f,0.f,0.f,0.f,0.f,0.f};
        const bf16* bp = W1T + (size_t)(kvsel * 256 + 32 * w + l31) * 2048 + 8 * hi;
        for (int k0 = 0; k0 < 128; k0 += 16) { bf16x8 bv[16];
#pragma unroll
            for (int i = 0; i < 16; ++i) bv[i] = ldg8(bp + 16 * (k0 + i));
#pragma unroll
            for (int i = 0; i < 16; ++i) { const int ks = k0 + i, j = ks >> 2, d0 = 16 * (ks & 3) + 8 * hi;
                const bf16x8 av = *(const LAS bf16x8*)(TK + ((j & 15) * 33 + l31 + (j >> 4)) * 72 + d0);   acc = MFMA32(av, bv[i], acc); } }
        { const float pb = PB[kvsel * 256 + 32 * w + l31];
#pragma unroll
          for (int r = 0; r < 16; ++r) HD[((r & 3) + 8 * (r >> 2) + 4 * hi) * 264 + 32 * w + l31] = (unsigned short)f2bf(gelu_tanh(acc[r] + pb)); }
        __syncthreads();
        if (w == 0) {
            f32x16 c2[2]; c2[0] = (f32x16){0.f,0.f,0.f,0.f,0.f,0.f,0.f,0.f,0.f,0.f,0.f,0.f,0.f,0.f,0.f,0.f}; c2[1] = c2[0];
#pragma unroll
            for (int mt = 0; mt < 2; ++mt) { const bf16* ap = W2T + (size_t)(kvsel * 64 + 32 * mt + l31) * 256 + 8 * hi;
#pragma unroll
                for (int ks = 0; ks < 16; ++ks) { const bf16x8 av = ldg8(ap + 16 * ks), bv = *(const LAS bf16x8*)(HD + l31 * 264 + 16 * ks + 8 * hi); c2[mt] = MFMA32(av, bv, c2[mt]); } }
            const int n = n0 + l31; const bool ok = n < NCMP;
            if (kvsel == 0) { float ss = 0.f;
#pragma unroll
                for (int mt = 0; mt < 2; ++mt)
#pragma unroll
                    for (int r = 0; r < 16; ++r) ss += c2[mt][r] * c2[mt][r];
                ss += __shfl_xor(ss, 32);
                const float rstd = ok ? 1.0f / sqrtf(ss * (1.f / 64.f) + NORM_EPS) : 0.f;
                bf16* kp = (bf16*)(F.ws + WS_KC16) + (size_t)(bg * NCMPP + n) * 64 + 4 * hi;
#pragma unroll
                for (int mt = 0; mt < 2; ++mt)
#pragma unroll
                    for (int q4 = 0; q4 < 4; ++q4) { const f32x4 gg = *(const GAS f32x4*)(kng0 + 32 * mt + 8 * q4 + 4 * hi);
                        *(GAS unsigned long long*)(kp + 32 * mt + 8 * q4) = (unsigned long long)cvtpk(c2[mt][4 * q4] * rstd * gg.x, c2[mt][4 * q4 + 1] * rstd * gg.y) | ((unsigned long long)cvtpk(c2[mt][4 * q4 + 2] * rstd * gg.z, c2[mt][4 * q4 + 3] * rstd * gg.w) << 32); }
            } else { bf16* vp = (bf16*)(F.ws + WS_VTC) + (size_t)(bg * 64 + 4 * hi) * NCMPP + (n & ~15) + perm16(n & 15);
#pragma unroll
                for (int mt = 0; mt < 2; ++mt)
#pragma unroll
                    for (int r = 0; r < 16; ++r) vp[(size_t)(32 * mt + (r & 3) + 8 * (r >> 2)) * NCMPP] = (bf16)f2bf(ok ? c2[mt][r] : 0.f); }
        }
    }
}
__device__ __forceinline__ void p_qnorm(Frame& F, const float* gq) {
    const bf16* QG = (const bf16*)(F.ws + WS_QG); bf16* QN = (bf16*)(F.ws + WS_QN);
    const int gt = F.vcu * (NWAVES * 64) + F.tid, NT = F.G * NWAVES * 64;
    for (int idx = gt; idx < M * NH; idx += NT) { const int m = idx >> 4, h = idx & 15;
        const GAS v4u* p = (const GAS v4u*)(QG + (size_t)m * NQINP + h * 64); GAS v4u* o = (GAS v4u*)(QN + (size_t)m * D + h * 64);
        v4u w[8]; float ss = 0.f;
#pragma unroll
        for (int i = 0; i < 8; ++i) { w[i] = p[i];
#pragma unroll
            for (int k = 0; k < 4; ++k) { const float x0 = bflo(w[i][k]), x1 = bfhi(w[i][k]); ss += x0 * x0 + x1 * x1; } }
        const float rs = (0.125f * LOG2E) / sqrtf(ss * (1.f / 64.f) + NORM_EPS);
#pragma unroll
        for (int i = 0; i < 8; ++i) { v4u r;
#pragma unroll
            for (int k = 0; k < 4; ++k) r[k] = cvtpk(bflo(w[i][k]) * rs * gq[8 * i + 2 * k], bfhi(w[i][k]) * rs * gq[8 * i + 2 * k + 1]);
            o[i] = r; } }
}
__device__ __forceinline__ void p_vtrans(Frame& F) {
    const bf16* KV = (const bf16*)(F.ws + WS_KV);
    LAS unsigned short* scr = (LAS unsigned short*)(F.lds + F.wave * 8192);
    const int gw = F.vcu * NWAVES + F.wave, NGW = F.G * NWAVES, lane = F.lane;
    for (int item = gw; item < 2 * 8 * (T / 64); item += NGW) {
        const int which = item >> 10, bg = (item >> 7) & 7, tile = item & 127, b = bg >> 2, g = bg & 3;
        const GAS v4u* p = (const GAS v4u*)(KV + (size_t)(b * T + 64 * tile + lane) * NKV + (which ? 1280 : 768) + 64 * g);
        const int posn = (lane & ~15) + perm16(lane & 15);
#pragma unroll
        for (int i = 0; i < 8; ++i) { const v4u w = p[i];
#pragma unroll
            for (int k = 0; k < 4; ++k) { scr[(8 * i + 2 * k) * 64 + posn] = (unsigned short)(w[k] & 0xffffu); scr[(8 * i + 2 * k + 1) * 64 + posn] = (unsigned short)(w[k] >> 16); } }
        LDS_WAIT(); asm volatile("" ::: "memory");
        bf16* VT = (bf16*)(F.ws + (which ? WS_VTW : WS_VTS));
        GAS v4u* o = (GAS v4u*)(VT + (size_t)(bg * 64 + lane) * T + 64 * tile); const LAS v4u* s = (const LAS v4u*)(scr + lane * 64);
#pragma unroll
        for (int i = 0; i < 8; ++i) o[i] = s[i];
        if (which == 0) { v4u* VF = (v4u*)(F.ws + WS_VF);
#pragma unroll
            for (int i = 0; i < 8; ++i) VF[(size_t)(((((bg * 128 + tile) * 2 + (i >> 2)) * 2 + (lane >> 5)) * 2 + ((i >> 1) & 1)) * 64) + (i & 1) * 32 + (lane & 31)] = s[i]; }
        LDS_WAIT(); asm volatile("" ::: "memory");
    }
}

__device__ __forceinline__ void p_biaslut(Frame& F, const float* relb) {
    float* BLG = (float*)(F.ws + WS_BLG);
    const int gt = F.vcu * (NWAVES * 64) + F.tid, NT = F.G * NWAVES * 64;
    for (int idx = gt; idx < NH * 2048; idx += NT) { const int h = idx >> 11, d = idx & 2047; BLG[idx] = relb[rel_bucket(d) * NH + h] * LOG2E; }
}

template <int MASK, int DS> __device__ __forceinline__ float st_softmax(f32x16& st, int dbase, const LAS float* blp, float scale) {
    float l = 0.f; asm volatile("" : "+v"(dbase));
#pragma unroll
    for (int r = 0; r < 16; ++r) { const int d = dbase - DS * ((r & 3) + 8 * (r >> 2)); int di = d < 0 ? 0 : d; di = di > 2047 ? 2047 : di;
        float e = __builtin_amdgcn_exp2f(st[r] + blp[di]) * scale;
        if (MASK == 1) e = d >= 0 ? e : 0.f;
        if (MASK == 2) e = (d >= 0 && d < WIN) ? e : 0.f;
        st[r] = e; l += e; }
    return l;
}
template <int DS> __device__ __forceinline__ float st_softmax_in(f32x16& st, int dbase, const LAS float* blp, float scale) {
    float l = 0.f; const LAS float* bp = blp + (dbase - 27 * DS); asm volatile("" : "+v"(bp));
#pragma unroll
    for (int r = 0; r < 16; ++r) { const float e = __builtin_amdgcn_exp2f(st[r] + bp[(27 - ((r & 3) + 8 * (r >> 2))) * DS]) * scale; st[r] = e; l += e; }
    return l;
}
constexpr float OFIX = 1024.0f, LFIX = 256.0f;
#ifndef REP_SUB
#define REP_SUB 0
#endif
#define SUBREP(k) for (int rep_ = 0; rep_ < (REP_SUB == (k) ? 2 : 1); ++rep_) if (const float rs_ = rep_ ? 0.f : 1.f; true)
__device__ __forceinline__ float st_softmax_far(f32x16& st, float cb, float scale) {
    float l = 0.f;
#pragma unroll
    for (int r = 0; r < 16; ++r) { const float e = __builtin_amdgcn_exp2f(st[r] + cb) * scale; st[r] = e; l += e; }
    return l;
}
#define DENSE_STK(buf) (*(LAS v4u*)(KT + (buf) * 4608 + (tio >> 3) * 72 + 8 * (tio & 7)) = kreg)
#define DENSE_STV(buf) (*(LAS v4u*)(VTT + (buf) * 4608 + (tio >> 3) * 72 + 8 * (tio & 7)) = vreg)
#define DENSE_LDK(kf, buf, sub) do { _Pragma("unroll") for (int _k = 0; _k < 4; ++_k) kf[_k] = *(const LAS bf16x8*)(KT + (buf) * 4608 + (32 * (sub) + (lane & 31)) * 72 + 16 * _k + 8 * hi); } while (0)
#define DENSE_LDV(vf, buf, sub) do { _Pragma("unroll") for (int _m = 0; _m < 2; ++_m) _Pragma("unroll") for (int _s = 0; _s < 2; ++_s) vf[_m][_s] = *(const LAS bf16x8*)(VTT + (buf) * 4608 + (32 * _m + (lane & 31)) * 72 + 32 * (sub) + 16 * _s + 8 * hi); } while (0)
#define NSA_LDK(kf, base) do { _Pragma("unroll") for (int _k = 0; _k < 4; ++_k) kf[_k] = ldg8((base) + 16 * _k); } while (0)
#define NSA_QK(st, kf, qf) do { st = (f32x16){0.f,0.f,0.f,0.f,0.f,0.f,0.f,0.f,0.f,0.f,0.f,0.f,0.f,0.f,0.f,0.f}; _Pragma("unroll") for (int _k = 0; _k < 4; ++_k) st = MFMA32(kf[_k], qf[_k], st); } while (0)

__device__ __forceinline__ void p_nsa(Frame& F, const Args& a) {
    const bf16* QN = (const bf16*)(F.ws + WS_QN); const bf16* QG = (const bf16*)(F.ws + WS_QG); const bf16* KV = (const bf16*)(F.ws + WS_KV);
    const bf16* KC = (const bf16*)(F.ws + WS_KC16); const bf16* VTC = (const bf16*)(F.ws + WS_VTC); const bf16* VTS = (const bf16*)(F.ws + WS_VTS); const bf16* VTW = (const bf16*)(F.ws + WS_VTW);
    const float* BLG = (const float*)(F.ws + WS_BLG); bf16* OATT = (bf16*)(F.ws + WS_OATT); float* OPARK = (float*)(F.ws + WS_OACC);
    LAS float* BL = (LAS float*)(F.lds);
    LAS int* OACC = (LAS int*)(BL + 4 * 2056);
    LAS float* IMPL = (LAS float*)OACC;
    LAS int* LACC = OACC + 16384;
    LAS unsigned* SELM = (LAS unsigned*)(LACC + 256);
    LAS unsigned long long* BM = (LAS unsigned long long*)(SELM + 256);
    LAS unsigned short* KT = (LAS unsigned short*)(BM + 128);
    LAS unsigned short* VTT = KT + 2 * 4608;
    LAS unsigned* BCTR = (LAS unsigned*)(F.lds + MISC_OFF + 64);
    LAS unsigned short* QL = KT;
    const v4u* KF = (const v4u*)(F.ws + WS_KF); const v4u* VF = (const v4u*)(F.ws + WS_VF);
    static_assert(4 * 2056 * 4 + 16384 * 4 + 1024 + 1024 + 1024 + 4 * 4608 * 2 <= LDSCTL_OFF, "attention LDS map");
    const int tid = F.tid, lane = F.lane, w = F.wave;
    const int col = lane & 31, hi = lane >> 5, hp = col & 3, ti = w * 8 + (col >> 2);
    const LAS float* blp = BL + hp * 2056;
    int last_g = -1;
    for (int it = 0;; ++it) {
        const int id = F.vcu + F.G * it; if (id >= BATCH * NG * (T / 64)) break;
        const int bg = id >> 7, b = bg >> 2, g = bg & 3, tt = (it & 1) ? 127 - (id & 127) : (id & 127);
        const int t0 = tt * 64, cur = tt, t_l = t0 + ti, h = 4 * g + hp;
        const size_t mrow = (size_t)b * T + t_l;
        __syncthreads();
        if (g != last_g) { int tio = tid; asm volatile("" : "+v"(tio)); for (int i = tio; i < 4 * 2048; i += NWAVES * 64) BL[(i >> 11) * 2056 + (i & 2047)] = BLG[(size_t)(4 * g) * 2048 + i]; }
        last_g = g;
        for (int i = tid; i < 64 * 132 / 4; i += NWAVES * 64) ((LAS v4u*)IMPL)[i] = (v4u){0u, 0u, 0u, 0u};
        __syncthreads();
        bf16x8 qf[4];
#pragma unroll
        for (int k = 0; k < 4; ++k) qf[k] = ldg8(QN + mrow * D + h * 64 + 16 * k + 8 * hi);
        f32x16 ofin[2];
        const float cbias = blp[2047];
        SUBREP(1) {
            const int ncv_max = ((t0 + 63 - 31) >> 4) + 1; int n_kt = (ncv_max >> 5) + 1; n_kt = n_kt > 16 ? 16 : n_kt; const int n64 = (n_kt + 1) >> 1;
            int tio = tid; asm volatile("" : "+v"(tio));
            const bf16* kcs = KC + (size_t)bg * NCMPP * 64 + (size_t)(tio >> 3) * 64 + 8 * (tio & 7); const bf16* vcs = VTC + (size_t)bg * 64 * NCMPP + (size_t)(tio >> 3) * NCMPP + 8 * (tio & 7);
            float l = 0.f; v4u kreg, vreg;
            f32x16 oc[2]; oc[0] = (f32x16){0.f,0.f,0.f,0.f,0.f,0.f,0.f,0.f,0.f,0.f,0.f,0.f,0.f,0.f,0.f,0.f}; oc[1] = oc[0];
            unsigned av[16][2];
#pragma unroll
            for (int kt = 0; kt < 16; ++kt) { av[kt][0] = 0u; av[kt][1] = 0u; }
            float prevx3 = 0.f;
            kreg = *(const GAS v4u*)kcs; vreg = *(const GAS v4u*)vcs; DENSE_STK(0); DENSE_STV(0); __syncthreads();
#pragma unroll
            for (int i = 0; i < 8; ++i) { if (i < n64) { if (i + 1 < n64) { kreg = *(const GAS v4u*)(kcs + (size_t)(i + 1) * 64 * 64); vreg = *(const GAS v4u*)(vcs + (i + 1) * 64); }
#pragma unroll
                for (int sub = 0; sub < 2; ++sub) { const int kt = 2 * i + sub; if (kt < n_kt) { bf16x8 kf[4]; DENSE_LDK(kf, i & 1, sub); bf16x8 vf[2][2]; DENSE_LDV(vf, i & 1, sub);
                    f32x16 st; NSA_QK(st, kf, qf);
                    if (t0 - 512 * kt - 527 >= 2047) l += st_softmax_far(st, cbias, 1.0f); else if (t0 - 512 * kt - 527 >= 0 && t0 + 32 - 512 * kt <= 2047) l += st_softmax_in<16>(st, t_l - 31 - 512 * kt - 64 * hi, blp, 1.0f);
                    else l += st_softmax<1, 16>(st, t_l - 31 - 512 * kt - 64 * hi, blp, 1.0f);
                    float xq[4], aq[4];
#pragma unroll
                    for (int q = 0; q < 4; ++q) { const float cr = 0.5f * st[4 * q + 3]; aq[q] = st[4 * q] + st[4 * q + 1] + st[4 * q + 2] + cr; xq[q] = __shfl_xor(cr, 32); }
#pragma unroll
                    for (int q = 0; q < 4; ++q) aq[q] += hi ? xq[q] : (q == 0 ? prevx3 : xq[q > 0 ? q - 1 : 0]);
                    prevx3 = xq[3]; av[kt][0] = cvtpk(aq[0], aq[1]); av[kt][1] = cvtpk(aq[2], aq[3]);
                    const bf16x8 pb0 = pack8(st, 0), pb1 = pack8(st, 1);
#pragma unroll
                    for (int mt = 0; mt < 2; ++mt) { oc[mt] = MFMA32(vf[mt][0], pb0, oc[mt]); oc[mt] = MFMA32(vf[mt][1], pb1, oc[mt]); } } }
                if (i + 1 < n64) { DENSE_STK((i + 1) & 1); DENSE_STV((i + 1) & 1); }
                __syncthreads(); } }
            l += __shfl_xor(l, 32);
            const float gate = sigmoid_f(bf2f(QG[mrow * NQINP + D + h * 3 + 0]));
            const float inv = l > 0.f ? 1.0f / l : 0.f;
#pragma unroll
            for (int kt = 0; kt < 16; ++kt) { if (kt < n_kt) {
#pragma unroll
                for (int q = 0; q < 4; ++q) { float v = ((q & 1) ? bfhi(av[kt][q >> 1]) : bflo(av[kt][q >> 1])) * inv; v += __shfl_xor(v, 1); v += __shfl_xor(v, 2); if (hp == 0) IMPL[ti * 132 + 8 * kt + 2 * q + hi] = v; } } }
            const float og = gate * inv;
#pragma unroll
            for (int mt = 0; mt < 2; ++mt)
#pragma unroll
                for (int r = 0; r < 16; ++r) ofin[mt][r] = oc[mt][r] * og;
        }
        __syncthreads();
        v4u pf_wk, pf_wv, pf_dk, pf_dv, pf_q[4];
        { int tio = tid; asm volatile("" : "+v"(tio)); const int kt_lo_ = t0 >= 512 ? 0 : (512 - t0) >> 6, keyw = t0 - 512 + 64 * kt_lo_;
          pf_wk = *(const GAS v4u*)(KV + (size_t)b * T * NKV + 1024 + 64 * g + (size_t)(tio >> 3) * NKV + 8 * (tio & 7) + (size_t)keyw * NKV); pf_wv = *(const GAS v4u*)(VTW + (size_t)bg * 64 * T + (size_t)(tio >> 3) * T + 8 * (tio & 7) + keyw); }
        SUBREP(2) {
            int tk = tid >> 3, j = tid & 7; asm volatile("" : "+v"(tk), "+v"(j)); float v[16];
#pragma unroll
            for (int k = 0; k < 16; ++k) { const int s = 16 * j + k; v[k] = (s >= 1 && s <= cur - 2) ? IMPL[tk * 132 + s] : -1.0f; }
            unsigned msk = 0u;
#pragma unroll
            for (int k = 0; k < 16; ++k) { const int s = 16 * j + k; if (s <= cur && (s == 0 || s >= cur - 1)) msk |= 1u << k; }
            const int ncand = cur - 2 > 0 ? cur - 2 : 0; const int n_need = ncand < NTOP - 3 ? ncand : NTOP - 3;
            for (int itn = 0; itn < n_need; ++itn) {
                float bm = fmaxf(fmaxf(fmaxf(v[0], v[1]), fmaxf(v[2], v[3])), fmaxf(fmaxf(v[4], v[5]), fmaxf(v[6], v[7])));
                bm = fmaxf(bm, fmaxf(fmaxf(fmaxf(v[8], v[9]), fmaxf(v[10], v[11])), fmaxf(fmaxf(v[12], v[13]), fmaxf(v[14], v[15]))));
#define DPP_I(x, ctl) __builtin_amdgcn_update_dpp(0, (x), (ctl), 0xF, 0xF, true)
#define DPP_F(x, ctl) __builtin_bit_cast(float, __builtin_amdgcn_update_dpp(0, __builtin_bit_cast(int, (x)), (ctl), 0xF, 0xF, true))
                float gm = bm; gm = fmaxf(gm, DPP_F(gm, 0xB1)); gm = fmaxf(gm, DPP_F(gm, 0x4E)); gm = fmaxf(gm, DPP_F(gm, 0x141));
                unsigned eq = 0u;
#pragma unroll
                for (int k = 0; k < 16; ++k) eq |= (v[k] == gm) ? (1u << k) : 0u;
                int cand = eq ? 16 * j + (__ffs(eq) - 1) : 9999; int o1 = DPP_I(cand, 0xB1); cand = o1 < cand ? o1 : cand; o1 = DPP_I(cand, 0x4E); cand = o1 < cand ? o1 : cand; o1 = DPP_I(cand, 0x141); cand = o1 < cand ? o1 : cand;
#undef DPP_I
#undef DPP_F
                const unsigned hit = (unsigned)(cand - 16 * j) < 16u ? (1u << (cand - 16 * j)) : 0u; msk |= hit;
#pragma unroll
                for (int k = 0; k < 16; ++k) v[k] = (hit >> k) & 1u ? -1.0f : v[k];
            }
            ((LAS unsigned short*)SELM)[tk * 8 + j] = (unsigned short)msk;
        }
        __syncthreads();
        if (tid == 0) *BCTR = 0u;
        for (int i = tid; i < (16384 + 256) / 4; i += NWAVES * 64) ((LAS v4u*)OACC)[i] = (v4u){0u, 0u, 0u, 0u};
        {
            const unsigned wsel = SELM[lane * 4 + (w >> 1)]; const unsigned part = (w & 1) ? (wsel >> 16) : (wsel & 0xffffu);
#pragma unroll
            for (int k = 0; k < 16; ++k) { const unsigned long long bal = __ballot((part >> k) & 1u); if (lane == 0) BM[16 * w + k] = bal; }
        }
        __syncthreads();
        SUBREP(5) {
            int tio = tid; asm volatile("" : "+v"(tio));
            const bf16* ks_ = KV + (size_t)b * T * NKV + 1024 + 64 * g + (size_t)(tio >> 3) * NKV + 8 * (tio & 7);
            const bf16* vs_ = VTW + (size_t)bg * 64 * T + (size_t)(tio >> 3) * T + 8 * (tio & 7);
            f32x16 ow[2]; ow[0] = (f32x16){0.f,0.f,0.f,0.f,0.f,0.f,0.f,0.f,0.f,0.f,0.f,0.f,0.f,0.f,0.f,0.f}; ow[1] = ow[0]; float lw = 0.f;
            const int kt_lo = t0 >= 512 ? 0 : (512 - t0) >> 6; v4u kreg, vreg;
            kreg = pf_wk; vreg = pf_wv;
            { const int keyd = 64 * cur;
              pf_dk = *(const GAS v4u*)(KV + (size_t)b * T * NKV + 512 + 64 * g + (size_t)(tio >> 3) * NKV + 8 * (tio & 7) + (size_t)keyd * NKV); pf_dv = *(const GAS v4u*)(VTS + (size_t)bg * 64 * T + (size_t)(tio >> 3) * T + 8 * (tio & 7) + keyd); }
            DENSE_STK(0); DENSE_STV(0); __syncthreads();
            for (int kt = kt_lo; kt < 9; ++kt) { const int buf = (kt - kt_lo) & 1;
                if (kt + 1 < 9) { const int key1 = t0 - 512 + 64 * (kt + 1); kreg = *(const GAS v4u*)(ks_ + (size_t)key1 * NKV); vreg = *(const GAS v4u*)(vs_ + key1); }
#pragma unroll
                for (int sub = 0; sub < 2; ++sub) { const int key0 = t0 - 512 + 64 * kt + 32 * sub; bf16x8 kf[4]; DENSE_LDK(kf, buf, sub); bf16x8 vf[2][2]; DENSE_LDV(vf, buf, sub);
                    f32x16 st; NSA_QK(st, kf, qf);
                    if (kt >= 1 && kt <= 7) lw += st_softmax_in<1>(st, t_l - key0 - 4 * hi, blp, 1.0f); else lw += st_softmax<2, 1>(st, t_l - key0 - 4 * hi, blp, 1.0f);
                    const bf16x8 pb0 = pack8(st, 0), pb1 = pack8(st, 1);
#pragma unroll
                    for (int mt = 0; mt < 2; ++mt) { ow[mt] = MFMA32(vf[mt][0], pb0, ow[mt]); ow[mt] = MFMA32(vf[mt][1], pb1, ow[mt]); } }
                if (kt + 1 < 9) { DENSE_STK(buf ^ 1); DENSE_STV(buf ^ 1); }
                __syncthreads(); }
            lw += __shfl_xor(lw, 32);
            const float gw = sigmoid_f(bf2f(QG[mrow * NQINP + D + h * 3 + 2])) / lw * rs_;
#pragma unroll
            for (int mt = 0; mt < 2; ++mt)
#pragma unroll
                for (int r = 0; r < 16; ++r) ofin[mt][r] += ow[mt][r] * gw;
            float* pk = OPARK + mrow * D + h * 64;
#pragma unroll
            for (int mt = 0; mt < 2; ++mt)
#pragma unroll
                for (int q = 0; q < 4; ++q) *(GAS f32x4*)(pk + 32 * mt + 8 * q + 4 * hi) = (f32x4){ofin[mt][4 * q], ofin[mt][4 * q + 1], ofin[mt][4 * q + 2], ofin[mt][4 * q + 3]};
        }
        {
            const bf16* kbase = KV + (size_t)b * T * NKV + 512 + 64 * g + (size_t)(lane & 31) * NKV + 8 * hi;
            const bf16* vbase = VTS + (size_t)bg * 64 * T + (size_t)(lane & 31) * T + 8 * hi;
            SUBREP(3) {
            int tio = tid; asm volatile("" : "+v"(tio));
            const bf16* ks_ = KV + (size_t)b * T * NKV + 512 + 64 * g + (size_t)(tio >> 3) * NKV + 8 * (tio & 7);
            const bf16* vs_ = VTS + (size_t)bg * 64 * T + (size_t)(tio >> 3) * T + 8 * (tio & 7);
            f32x16 os[2]; os[0] = (f32x16){0.f,0.f,0.f,0.f,0.f,0.f,0.f,0.f,0.f,0.f,0.f,0.f,0.f,0.f,0.f,0.f}; os[1] = os[0]; float ls = 0.f;
            const int nfb = cur >= 2 ? 3 : cur + 1; v4u kreg, vreg;
            kreg = pf_dk; vreg = pf_dv;
#pragma unroll
            for (int c = 0; c < 4; ++c) { const int ch = tio + 512 * c, row = ch >> 3, part = ch & 7; pf_q[c] = *(const GAS v4u*)(QN + ((size_t)b * T + t0 + (row >> 2)) * D + (4 * g + (row & 3)) * 64 + 8 * part); }
            DENSE_STK(0); DENSE_STV(0); __syncthreads();
            for (int fi = 0; fi < nfb; ++fi) { const int fb = fi == 0 ? cur : (fi == 1 ? cur - 1 : 0);
                if (fi + 1 < nfb) { const int key1 = 64 * (fi == 0 ? cur - 1 : 0); kreg = *(const GAS v4u*)(ks_ + (size_t)key1 * NKV); vreg = *(const GAS v4u*)(vs_ + key1); }
#pragma unroll
                for (int sub = 0; sub < 2; ++sub) { const int key0 = 64 * fb + 32 * sub; bf16x8 kf[4]; DENSE_LDK(kf, fi & 1, sub); bf16x8 vf[2][2]; DENSE_LDV(vf, fi & 1, sub);
                    f32x16 st; NSA_QK(st, kf, qf);
                    if (fi == 1) ls += st_softmax_in<1>(st, t_l - key0 - 4 * hi, blp, 1.0f);
                    else if (fi == 2 && t0 - 63 >= 2047) ls += st_softmax_far(st, cbias, 1.0f);
                    else if (fi == 2 && t0 + 63 <= 2047) ls += st_softmax_in<1>(st, t_l - key0 - 4 * hi, blp, 1.0f);
                    else ls += st_softmax<1, 1>(st, t_l - key0 - 4 * hi, blp, 1.0f);
                    const bf16x8 pb0 = pack8(st, 0), pb1 = pack8(st, 1);
#pragma unroll
                    for (int mt = 0; mt < 2; ++mt) { os[mt] = MFMA32(vf[mt][0], pb0, os[mt]); os[mt] = MFMA32(vf[mt][1], pb1, os[mt]); } }
                if (fi + 1 < nfb) { DENSE_STK((fi + 1) & 1); DENSE_STV((fi + 1) & 1); }
                __syncthreads(); }
            {   int rowi = ti * 4 + hp; asm volatile("" : "+v"(rowi)); LAS int* orow = OACC + rowi * 64; const int swz = rowi & 31;
#pragma unroll
                for (int mt = 0; mt < 2; ++mt)
#pragma unroll
                    for (int r = 0; r < 16; ++r) { const int dim = 32 * mt + (r & 3) + 8 * (r >> 2) + 4 * hi; __hip_atomic_fetch_add(orow + (dim ^ swz), __float2int_rn(os[mt][r] * rs_ * OFIX), __ATOMIC_RELAXED, __HIP_MEMORY_SCOPE_WORKGROUP); }
                __hip_atomic_fetch_add(LACC + rowi, __float2int_rn(ls * rs_ * LFIX), __ATOMIC_RELAXED, __HIP_MEMORY_SCOPE_WORKGROUP); }
            }
            { int tio = tid; asm volatile("" : "+v"(tio));
#pragma unroll
              for (int c = 0; c < 4; ++c) { const int ch = tio + 512 * c, row = ch >> 3, part = ch & 7;
                  *(LAS v4u*)(QL + row * 72 + 8 * part) = pf_q[c]; } }
            __syncthreads();
            for (int rep_ = 0; rep_ < ((REP_SUB == 4 || REP_SUB == 6) ? 2 : 1); ++rep_) if (const float rs_ = rep_ ? 0.f : 1.f; true) {
#define NSA_NEXTBLK(sv) do { for (;;) { unsigned t_ = 0u; if (lane == 0) t_ = __hip_atomic_fetch_add(BCTR, 1u, __ATOMIC_RELAXED, __HIP_MEMORY_SCOPE_WORKGROUP); sv = 1 + __builtin_amdgcn_readfirstlane((int)t_); if (sv > cur - 2) break; \
        const unsigned long long m_ = BM[sv]; if (__builtin_amdgcn_readfirstlane((unsigned)m_) | __builtin_amdgcn_readfirstlane((unsigned)(m_ >> 32))) break; } } while (0)
#define NSA_LDK8(dst, sv) do { const size_t fb_ = ((size_t)(bg * 128 + (sv)) * 8) * 64 + lane; _Pragma("unroll") for (int k_ = 0; k_ < 8; ++k_) dst[k_] = KF[fb_ + (size_t)k_ * 64]; } while (0)
#define NSA_LDV8(dst, sv) do { const size_t fb_ = ((size_t)(bg * 128 + (sv)) * 8) * 64 + lane; _Pragma("unroll") for (int k_ = 0; k_ < 8; ++k_) dst[8 + k_] = VF[fb_ + (size_t)k_ * 64]; } while (0)
            v4u kv_[16];
            int s; NSA_NEXTBLK(s);
            while (s <= cur - 2) {
                NSA_LDK8(kv_, s); NSA_LDV8(kv_, s);
                const bool far_ = (t0 - 64 * s - 63) >= 2047, in_ = (t0 + 63 - 64 * s) <= 2047;
                unsigned long long mk = BM[s]; unsigned mlo = __builtin_amdgcn_readfirstlane((unsigned)mk), mhi = __builtin_amdgcn_readfirstlane((unsigned)(mk >> 32));
                mk = ((unsigned long long)mhi << 32) | mlo;
                while (mk) {
                    int mytok = -1;
#pragma unroll
                    for (int k = 0; k < 8; ++k) { int tkk = -1; if (mk) { tkk = __builtin_ctzll(mk); mk &= mk - 1; } mytok = ((col >> 2) == k) ? tkk : mytok; }
                    const bool valid = mytok >= 0; const int tq = valid ? mytok : 0; const int tq_abs = t0 + tq;
                    bf16x8 q2[4];
                    { const LAS unsigned short* qp = QL + (tq * 4 + hp) * 72 + 8 * hi;
#pragma unroll
                      for (int k = 0; k < 4; ++k) q2[k] = *(const LAS bf16x8*)(qp + 16 * k); }
                    f32x16 oi[2]; oi[0] = (f32x16){0.f,0.f,0.f,0.f,0.f,0.f,0.f,0.f,0.f,0.f,0.f,0.f,0.f,0.f,0.f,0.f}; oi[1] = oi[0]; float li = 0.f;
#pragma unroll
                    for (int sub = 0; sub < 2; ++sub) { f32x16 st = (f32x16){0.f,0.f,0.f,0.f,0.f,0.f,0.f,0.f,0.f,0.f,0.f,0.f,0.f,0.f,0.f,0.f};
#pragma unroll
                      for (int k = 0; k < 4; ++k) st = MFMA32(__builtin_bit_cast(bf16x8, kv_[4 * sub + k]), q2[k], st);
                      if (far_) li += st_softmax_far(st, cbias, 1.0f); else if (in_) li += st_softmax_in<1>(st, tq_abs - 64 * s - 32 * sub - 4 * hi, blp, 1.0f); else li += st_softmax<0, 1>(st, tq_abs - 64 * s - 32 * sub - 4 * hi, blp, 1.0f);
                      const bf16x8 pb0 = pack8(st, 0), pb1 = pack8(st, 1);
#pragma unroll
                      for (int mt = 0; mt < 2; ++mt) { oi[mt] = MFMA32(__builtin_bit_cast(bf16x8, kv_[8 + 4 * sub + 2 * mt]), pb0, oi[mt]); oi[mt] = MFMA32(__builtin_bit_cast(bf16x8, kv_[8 + 4 * sub + 2 * mt + 1]), pb1, oi[mt]); }
                      __builtin_amdgcn_sched_barrier(0); }
                    if (valid && !(REP_SUB == 6 && rep_)) { const int rowi = tq * 4 + hp; LAS int* orow = OACC + rowi * 64; const int swz = rowi & 31;
#pragma unroll
                        for (int mt = 0; mt < 2; ++mt)
#pragma unroll
                            for (int r = 0; r < 16; ++r) { const int dim = 32 * mt + (r & 3) + 8 * (r >> 2) + 4 * hi; __hip_atomic_fetch_add(orow + (dim ^ swz), __float2int_rn(oi[mt][r] * rs_ * OFIX), __ATOMIC_RELAXED, __HIP_MEMORY_SCOPE_WORKGROUP); }
                        __hip_atomic_fetch_add(LACC + rowi, __float2int_rn(li * rs_ * LFIX), __ATOMIC_RELAXED, __HIP_MEMORY_SCOPE_WORKGROUP); }
                }
                NSA_NEXTBLK(s);
            }
            }
        }
        __syncthreads();
        {
            int rowi = ti * 4 + hp; asm volatile("" : "+v"(rowi)); const LAS int* orow = OACC + rowi * 64; const int swz = rowi & 31;
            const float gs = sigmoid_f(bf2f(QG[mrow * NQINP + D + h * 3 + 1])) / ((float)LACC[rowi] * (1.0f / LFIX)) * (1.0f / OFIX);
            bf16* od = OATT + mrow * D + h * 64;
#pragma unroll
            for (int mt = 0; mt < 2; ++mt)
#pragma unroll
                for (int q = 0; q < 4; ++q) { const int dim0 = 32 * mt + 8 * q + 4 * hi; float o4[4];
                    const f32x4 pk4 = *(const GAS f32x4*)(OPARK + mrow * D + h * 64 + dim0);
#pragma unroll
                    for (int e = 0; e < 4; ++e) o4[e] = pk4[e] + (float)orow[(dim0 + e) ^ swz] * gs;
                    *(GAS unsigned long long*)(od + dim0) = (unsigned long long)cvtpk(o4[0], o4[1]) | ((unsigned long long)cvtpk(o4[2], o4[3]) << 32); }
        }
    }
}

enum Phase { P_PRO, P_IN0, P_HA, P_HB, P_HC, P_OUT0, P_GU0, P_DN0, P_KVQ, P_PREP, P_NSA, P_OUT1, P_ROUTE, P_MOE1, P_MOE2, P_COMB, N_PHASES };
#define NREP(k) (REP_PHASE == (int)(k) ? 2 : 1)
#define REPEAT(k, call) do { if (REP_PHASE == (int)(k)) { __syncthreads(); call; } } while (0)
__global__ void __launch_bounds__(NWAVES * 64, 2) fwd_kernel(Args args) {
    extern __shared__ __attribute__((aligned(16))) unsigned char lds[];
    Frame F;
    F.lds = (LAS unsigned char*)lds;
    F.MISC = (volatile LAS unsigned*)(F.lds + MISC_OFF);
    F.tid = threadIdx.x; F.lane = F.tid & 63; F.wave = __builtin_amdgcn_readfirstlane(F.tid >> 6);
    F.G = gridDim.x; { const int bx = blockIdx.x; F.vcu = (F.G % 8 == 0) ? (bx % 8) * (F.G / 8) + bx / 8 : bx; }
    F.ws = args.ws; F.out = args.out; F.ctl = (gu32*)(args.ws + WS_CTL);
    unsigned char* ws = args.ws;
    for (int u = F.tid; u < (LDS_BYTES - LDSCTL_OFF) / 4; u += NWAVES * 64) ((LAS unsigned*)(F.lds + LDSCTL_OFF))[u] = 0u;
    __syncthreads();
    XcdBarrier bar; bar.bar = (unsigned*)(F.ctl + CW_BAR); bar.x = 0; bar.st = nullptr;
    if (MK_SINGLE) bar = xcd_barrier_post((unsigned*)(F.ctl + CW_BAR), F.MISC + 8);
    const int lo = args.ph_lo, hi = args.ph_hi;
#define IN(k) (lo <= (k) && (k) < hi)
#define SEAM(k) do { if (MK_SINGLE && IN(k) && hi > (k) + 1) xcd_barrier(bar); } while (0)
    bf16* XN = (bf16*)(ws + WS_XN);

#define GEMM_IN0() do { pg8::Gemm g{XN, (const bf16*)(ws + WS_W_IN0), D}; pg8::StaticOrder S; S.init(M, NIN0, F.G, (int)blockIdx.x); pg8::EpiBf16 E{(bf16*)(ws + WS_QFIG), NIN0, nullptr, 0, nullptr, 0}; \
        pg8::gemm_phase<pg8::EpiBf16, pg8::StaticOrder, true>(F.lds + RING_OFF, g, S, E); } while (0)
#define GEMM_OUT0() do { pg8::Gemm g{(const bf16*)(ws + WS_OG), (const bf16*)(ws + WS_W_OUT0), D}; pg8::StaticOrder S; S.init(M, D, F.G, (int)blockIdx.x); pg8::EpiResF32 E{args.in[I_X], nullptr, nullptr, D, XN, (float*)(ws + WS_SSP1), nullptr}; \
        pg8::gemm_phase<pg8::EpiResF32, pg8::StaticOrder, true>(F.lds + RING_OFF, g, S, E); } while (0)
#define GEMM_GU0() do { pg8::Gemm g{XN, (const bf16*)(ws + WS_W_GU0), D}; pg8::StaticOrder S; S.init(M, 2 * FF, F.G, (int)blockIdx.x); pg8::EpiSwiglu E{(bf16*)(ws + WS_ACT), FF, (const float*)(ws + WS_SSP1)}; \
        pg8::gemm_phase<pg8::EpiSwiglu, pg8::StaticOrder, true>(F.lds + RING_OFF, g, S, E); } while (0)
#define GEMM_DN0() do { pg8::Gemm g{(const bf16*)(ws + WS_ACT), (const bf16*)(ws + WS_W_DN0), FF}; pg8::StaticOrder S; S.init(M, D, F.G, (int)blockIdx.x); pg8::EpiResF32 E{nullptr, XN, nullptr, D, XN, (float*)(ws + WS_SSP2), nullptr}; \
        pg8::gemm_phase<pg8::EpiResF32, pg8::StaticOrder, true>(F.lds + RING_OFF, g, S, E); } while (0)
#define GEMM_KVQ() do { pg8::Gemm g{XN, (const bf16*)(ws + WS_W_KV), D}; pg8::StaticOrder S; S.init(M, NKV + NQINP, F.G, (int)blockIdx.x); \
        pg8::EpiBf16 E{(bf16*)(ws + WS_KV), NKV, (const float*)(ws + WS_SSP2), NKV / 256, (bf16*)(ws + WS_QG), NQINP}; pg8::gemm_phase<pg8::EpiBf16, pg8::StaticOrder, true>(F.lds + RING_OFF, g, S, E); } while (0)
#define GEMM_OUT1() do { pg8::Gemm g{(const bf16*)(ws + WS_OATT), (const bf16*)(ws + WS_W_OUT1), D}; pg8::StaticOrder S; S.init(M, D, F.G, (int)blockIdx.x); pg8::EpiResF32 E{nullptr, XN, F.out, D, XN, (float*)(ws + WS_SSP3), nullptr}; \
        pg8::gemm_phase<pg8::EpiResF32, pg8::StaticOrder, true>(F.lds + RING_OFF, g, S, E); } while (0)
#define GEMM_MOE1() do { pg8::Gemm g{(const bf16*)(ws + WS_XG8), (const bf16*)(ws + WS_W_GU1), D}; MoeOrder S; S.init(F.ctl + CW_ECNT, 2 * EF / 256, F.G, F.vcu, true); \
        pg8::EpiSwigluF8 E{(unsigned char*)(ws + WS_ACT2), EF, (const float*)(ws + WS_RS_E)}; pg8::gemm_phase<pg8::EpiSwigluF8, MoeOrder, true, true>(F.lds + RING_OFF, g, S, E); } while (0)
#define GEMM_MOE2() do { pg8::Gemm g{(const bf16*)(ws + WS_ACT2), (const bf16*)(ws + WS_W_DN1), EF}; MoeOrderKS S; S.init(F.ctl + CW_ECNT, D / 256, F.G, F.vcu, false); \
        pg8::EpiMoeDown E{(bf16*)(ws + WS_Y2), D, 1.0f / (pg8::F8_WSCALE * pg8::F8_ASCALE), (bf16*)(ws + WS_YP1), (bf16*)(ws + WS_YP2), (bf16*)(ws + WS_YP3)}; pg8::gemm_phase<pg8::EpiMoeDown, MoeOrderKS, true, true>(F.lds + RING_OFF, g, S, E); } while (0)
    if (IN(P_PRO)) { p0_prologue(F, args); REPEAT(P_PRO, p0_prologue(F, args)); } SEAM(P_PRO);
    if (IN(P_IN0)) { GEMM_IN0(); REPEAT(P_IN0, GEMM_IN0()); } SEAM(P_IN0);
    if (IN(P_HA)) { p_hg_a(F); REPEAT(P_HA, p_hg_a(F)); } SEAM(P_HA);
    if (IN(P_HB)) { p_hg_b(F); REPEAT(P_HB, p_hg_b(F)); } SEAM(P_HB);
    if (IN(P_HC)) { p_hg_c(F, args.in[I_A_ONORM]); REPEAT(P_HC, p_hg_c(F, args.in[I_A_ONORM])); } SEAM(P_HC);
    if (IN(P_OUT0)) { GEMM_OUT0();  } SEAM(P_OUT0);
    if (IN(P_GU0)) { GEMM_GU0(); REPEAT(P_GU0, GEMM_GU0()); } SEAM(P_GU0);
    if (IN(P_DN0)) { GEMM_DN0();  } SEAM(P_DN0);
    if (IN(P_KVQ)) { GEMM_KVQ(); REPEAT(P_KVQ, GEMM_KVQ()); } SEAM(P_KVQ);
    if (IN(P_PREP)) { p_knorm(F, args.in[I_K_NORM]); p_qnorm(F, args.in[I_B_QNORM]); p_biaslut(F, args.in[I_REL_BIAS]); p_vtrans(F); __syncthreads(); p_compress_mfma(F, args.in[I_K_NORM]);
        REPEAT(P_PREP, p_qnorm(F, args.in[I_B_QNORM]); p_biaslut(F, args.in[I_REL_BIAS]); p_vtrans(F); __syncthreads(); p_compress_mfma(F, args.in[I_K_NORM])); } SEAM(P_PREP);
    if (IN(P_NSA)) { p_nsa(F, args); REPEAT(P_NSA, p_nsa(F, args)); } SEAM(P_NSA);
    if (IN(P_OUT1)) { GEMM_OUT1();  } SEAM(P_OUT1);
    if (IN(P_ROUTE)) { p_route(F, args); REPEAT(P_ROUTE, p_route(F, args, true)); } SEAM(P_ROUTE);
    if (IN(P_MOE1)) { GEMM_MOE1(); REPEAT(P_MOE1, GEMM_MOE1()); } SEAM(P_MOE1);
    if (IN(P_MOE2)) { GEMM_MOE2(); REPEAT(P_MOE2, GEMM_MOE2()); } SEAM(P_MOE2);
    if (IN(P_COMB)) { p_moe_combine(F); }
#undef IN
#undef SEAM
}

extern "C" void kernel_launch(void* const* d_in, const int* in_sizes, int n_in, void* d_out, int out_size, void* d_ws, size_t ws_size, hipStream_t stream) {
    static int grid = 0;
    if (grid == 0) {
        if (n_in != N_IN || in_sizes[0] != M * D || out_size != M * D || ws_size < WS_END) { fprintf(stderr, "kernel_launch: unexpected shapes (n_in %d, in0 %d, out %d, ws %zu < %zu); nothing launched\n", n_in, n_in > 0 ? in_sizes[0] : -1, out_size, ws_size, (size_t)WS_END); grid = -1; return; }
        int dev = 0, cus = 0, per_cu = 0;
        if (hipGetDevice(&dev) != hipSuccess || hipDeviceGetAttribute(&cus, hipDeviceAttributeMultiprocessorCount, dev) != hipSuccess) { grid = -1; return; }
        if (hipFuncSetAttribute((const void*)fwd_kernel, hipFuncAttributeMaxDynamicSharedMemorySize, LDS_BYTES) != hipSuccess) { fprintf(stderr, "kernel_launch: hipFuncSetAttribute failed\n"); grid = -1; return; }
        if (hipOccupancyMaxActiveBlocksPerMultiprocessor(&per_cu, (const void*)fwd_kernel, NWAVES * 64, LDS_BYTES) != hipSuccess || per_cu < 1)
            fprintf(stderr, "kernel_launch: note: occupancy query reports %d workgroups per CU\n", per_cu);
        (void)hipGetLastError();
        grid = cus;
    }
    if (grid < 0) return;
    if (hipMemsetAsync((char*)d_ws + WS_CTL, 0, CTL_ZERO_BYTES, stream) != hipSuccess) { fprintf(stderr, "kernel_launch: hipMemsetAsync failed\n"); return; }
    Args a{};
    for (int i = 0; i < N_IN; ++i) a.in[i] = (const float*)d_in[i];
    a.out = (float*)d_out; a.ws = (unsigned char*)d_ws;
#if MK_SINGLE
    a.ph_lo = 0; a.ph_hi = N_PHASES;
    hipLaunchKernelGGL(fwd_kernel, dim3(grid), dim3(NWAVES * 64), LDS_BYTES, stream, a);
#else
    for (int p = 0; p < N_PHASES; ++p) { a.ph_lo = p; a.ph_hi = p + 1; hipLaunchKernelGGL(fwd_kernel, dim3(grid), dim3(NWAVES * 64), LDS_BYTES, stream, a); }
#endif
}
```

```cpp
#include <hip/hip_runtime.h>
#include <cstdio>
#include <cstdint>

#ifndef REP_PHASE
#define REP_PHASE -1
#endif
#ifndef MK_SINGLE
#define MK_SINGLE 1
#endif

namespace pg8 {
#define PG8_LAS __attribute__((address_space(3)))
typedef unsigned short bf16_t;
typedef short bf16x8 __attribute__((ext_vector_type(8)));
typedef float f32x4 __attribute__((ext_vector_type(4)));
typedef unsigned u32x4 __attribute__((ext_vector_type(4)));
typedef float f32x2 __attribute__((ext_vector_type(2)));
constexpr int BM = 256, BK = 64, HALF = 128, HTB = HALF * BK * 2  , STAGE_BYTES = 8 * HTB, NXCD = 8, WGM = 8;

__host__ __device__ __forceinline__ int lds_byte(int r, int c) { const int st = (r >> 4) * 2 + (c >> 5), rr = r & 15, cc = c & 31, ob = rr * 64 + cc * 2; return st * 1024 + (ob ^ (((ob >> 9) & 1) << 5)); }
__host__ __device__ __forceinline__ void stage_rc(int b, int& R, int& C) { const int st = b / 1024, sb = b % 1024, swz = sb ^ (((sb >> 9) & 1) << 5); R = (st >> 1) * 16 + swz / 64; C = (st & 1) * 32 + (swz % 64) / 2; }
__host__ __device__ __forceinline__ int perm32(int rho) { const int n = rho >> 4, i = rho & 15; return 8 * (i >> 2) + 4 * n + (i & 3); }

struct Unit { int pm, pn, pnl, pa, nv, k0, nk, part; };
struct Gemm { const bf16_t* A; const bf16_t* Bt; int K; };

struct StaticOrder {
    static constexpr bool KSPLIT = false;
    int nM, nN, nwg, G, c;
    __host__ __device__ void init(int M, int N, int G_, int c_) { nM = M / BM; nN = N / BM; nwg = nM * nN; G = G_; c = c_; }
    __host__ __device__ bool next(int i, Unit& u) const {
        const long L = (long)i * G + c; if (L >= nwg) return false;
        int wgid = (int)L; { const int q = nwg / NXCD, r = nwg % NXCD, xcd = wgid % NXCD, off = wgid / NXCD; wgid = (xcd < r ? xcd * (q + 1) : r * (q + 1) + (xcd - r) * q) + off; }
        const int nig = WGM * nN, gid = wgid / nig, fm = gid * WGM, gsz = (nM - fm) < WGM ? (nM - fm) : WGM;
        u.pm = fm + ((wgid % nig) % gsz); u.pn = (wgid % nig) / gsz; u.pnl = u.pn; u.pa = u.pm; u.nv = BM; return true;
    }
};

__device__ __forceinline__ unsigned cvt_pk_bf16(float lo, float hi) { unsigned r; asm volatile("v_cvt_pk_bf16_f32 %0, %1, %2" : "=v"(r) : "v"(lo), "v"(hi)); return r; }

__device__ __forceinline__ float row_rstd(const float* ssp, int row) {
    const f32x4* p = (const f32x4*)(ssp + (size_t)row * 16); const f32x4 a = p[0], b = p[1], c = p[2], d = p[3];
    const float s = ((a[0] + a[1]) + (a[2] + a[3])) + ((b[0] + b[1]) + (b[2] + b[3])) + (((c[0] + c[1]) + (c[2] + c[3])) + ((d[0] + d[1]) + (d[2] + d[3])));
    return 1.0f / sqrtf(s * (1.0f / 1024.0f) + 1e-6f);
}
struct EpiBf16 {
    static constexpr bool PERM = true;
    bf16_t* O; int ldc; const float* ssp; int split; bf16_t* O2; int ldc2;
    static constexpr bool HAS_PREP = true;
    __device__ __forceinline__ void prep(const Unit& u, PG8_LAS float* slot) const { if (ssp && threadIdx.x < 256) slot[threadIdx.x] = row_rstd(ssp, u.pm * BM + threadIdx.x); }
    __device__ __forceinline__ void operator()(const f32x4 (&acc)[2][2][4][2], const Unit& u, int wr, int wc, int fr, int fq, const PG8_LAS float* rsl) const {
        const int row0 = u.pm * BM + wr * 64 + fr; bf16_t* base = O; int ld = ldc, pt = u.pnl;
        if (split > 0 && pt >= split) { base = O2; ld = ldc2; pt -= split; }
        const int col0 = pt * BM + wc * 32 + 8 * fq;
        const __amdgpu_buffer_rsrc_t rsrc = __builtin_amdgcn_make_buffer_rsrc(base, 0, 0x7fffffff, 0x00020000);
#pragma unroll
        for (int ai = 0; ai < 2; ++ai)
#pragma unroll
            for (int m = 0; m < 4; ++m) { const int row = row0 + ai * HALF + m * 16; const unsigned boff = (unsigned)(((size_t)row * ld + col0) * 2); const float rs = ssp ? rsl[row - u.pm * BM] : 1.0f;
#pragma unroll
                for (int bj = 0; bj < 2; ++bj) { const f32x4 v0 = acc[ai][bj][m][0] * rs, v1 = acc[ai][bj][m][1] * rs;
                    u32x4 w; w.x = cvt_pk_bf16(v0[0], v0[1]); w.y = cvt_pk_bf16(v0[2], v0[3]); w.z = cvt_pk_bf16(v1[0], v1[1]); w.w = cvt_pk_bf16(v1[2], v1[3]);
                    __builtin_amdgcn_raw_buffer_store_b128(w, rsrc, boff + bj * HALF * 2, 0, 18); } }
    }
};
__device__ __forceinline__ float silu_f(float x) { return x * __builtin_amdgcn_rcpf(1.0f + __expf(-x)); }
__device__ __forceinline__ f32x4 swiglu4(const f32x4 g, const f32x4 u, float rsn, float rs2) {
    const f32x4 t = g * rsn; f32x4 d = {__builtin_amdgcn_exp2f(t[0]), __builtin_amdgcn_exp2f(t[1]), __builtin_amdgcn_exp2f(t[2]), __builtin_amdgcn_exp2f(t[3])};
    d = d + 1.0f; const f32x4 r = {__builtin_amdgcn_rcpf(d[0]), __builtin_amdgcn_rcpf(d[1]), __builtin_amdgcn_rcpf(d[2]), __builtin_amdgcn_rcpf(d[3])};
    return ((g * u) * rs2) * r;
}
__device__ __forceinline__ float clamp8(float x) { return __builtin_amdgcn_fmed3f(x, -440.0f, 440.0f); }
__device__ __forceinline__ unsigned pk4_fp8(float a, float b, float c, float d) { int w = __builtin_amdgcn_cvt_pk_fp8_f32(clamp8(a), clamp8(b), 0, false); w = __builtin_amdgcn_cvt_pk_fp8_f32(clamp8(c), clamp8(d), w, true); return (unsigned)w; }
constexpr float F8_WSCALE = 256.0f;
constexpr float F8_ASCALE = 8.0f;
struct EpiSwiglu {
    static constexpr bool PERM = true;
    bf16_t* O; int ldc; const float* ssp;
    static constexpr bool HAS_PREP = true;
    __device__ __forceinline__ void prep(const Unit& u, PG8_LAS float* slot) const { if (threadIdx.x < 256) slot[threadIdx.x] = row_rstd(ssp, u.pm * BM + threadIdx.x); }
    __device__ __forceinline__ void operator()(const f32x4 (&acc)[2][2][4][2], const Unit& u, int wr, int wc, int fr, int fq, const PG8_LAS float* rsl) const {
        const int row0 = u.pm * BM + wr * 64 + fr; const int col0 = u.pnl * HALF + wc * 32 + 8 * fq;
#pragma unroll
        for (int ai = 0; ai < 2; ++ai)
#pragma unroll
            for (int m = 0; m < 4; ++m) { const int row = row0 + ai * HALF + m * 16; bf16_t* rowp = O + (size_t)row * ldc + col0; const float rs = rsl[row - u.pm * BM];
                const float rsn = rs * -1.4426950408889634f, rs2 = rs * rs; const f32x4 h0 = swiglu4(acc[ai][0][m][0], acc[ai][1][m][0], rsn, rs2), h1 = swiglu4(acc[ai][0][m][1], acc[ai][1][m][1], rsn, rs2);
                u32x4 w; w.x = cvt_pk_bf16(h0[0], h0[1]); w.y = cvt_pk_bf16(h0[2], h0[3]); w.z = cvt_pk_bf16(h1[0], h1[1]); w.w = cvt_pk_bf16(h1[2], h1[3]);
                *(u32x4*)rowp = w; }
    }
};
struct EpiResF32 {
    static constexpr bool PERM = false;
    const float* res; const bf16_t* resb; float* out; int ldc; bf16_t* xh; float* ssp; unsigned char* x8  ;
    static constexpr bool HAS_PREP = false;
    __device__ __forceinline__ void prep(const Unit&, PG8_LAS float*) const {}
    __device__ __forceinline__ void operator()(const f32x4 (&acc)[2][2][4][2], const Unit& u, int wr, int wc, int fr, int fq, const PG8_LAS float*) const {
        const int col0 = u.pnl * BM + wc * 32 + 4 * fq;
#pragma unroll
        for (int ai = 0; ai < 2; ++ai)
#pragma unroll
            for (int m = 0; m < 4; ++m) { const int row = u.pm * BM + ai * HALF + wr * 64 + m * 16 + fr; const size_t off = (size_t)row * ldc + col0; float ss = 0.f;
#pragma unroll
                for (int bj = 0; bj < 2; ++bj)
#pragma unroll
                    for (int n = 0; n < 2; ++n) { f32x4 bs;
                        if (res) bs = *(const f32x4*)(res + off + bj * HALF + n * 16);
                        else { const unsigned long long rb = *(const unsigned long long*)(resb + off + bj * HALF + n * 16); const unsigned lo = (unsigned)rb, hi = (unsigned)(rb >> 32);
                            bs = (f32x4){__builtin_bit_cast(float, lo << 16), __builtin_bit_cast(float, lo & 0xffff0000u), __builtin_bit_cast(float, hi << 16), __builtin_bit_cast(float, hi & 0xffff0000u)}; }
                        const f32x4 o = bs + acc[ai][bj][m][n]; if (out) *(f32x4*)(out + off + bj * HALF + n * 16) = o;
                        ss += (o[0] * o[0] + o[1] * o[1]) + (o[2] * o[2] + o[3] * o[3]);
                        *(unsigned long long*)(xh + off + bj * HALF + n * 16) = (unsigned long long)cvt_pk_bf16(o[0], o[1]) | ((unsigned long long)cvt_pk_bf16(o[2], o[3]) << 32);
                        if (x8) *(unsigned*)(x8 + off + bj * HALF + n * 16) = pk4_fp8(o[0], o[1], o[2], o[3]); }
                ss += __shfl_xor(ss, 16); ss += __shfl_xor(ss, 32);
                if (fq == 0) ssp[(size_t)row * 16 + 4 * u.pnl + wc] = ss; }
    }
};
struct EpiSwigluF8 {
    static constexpr bool PERM = true;
    unsigned char* O; int ldc; const float* rs_e;
    static constexpr bool HAS_PREP = true;
    __device__ __forceinline__ void prep(const Unit& u, PG8_LAS float* slot) const { if (threadIdx.x < 256) slot[threadIdx.x] = (int)threadIdx.x < u.nv ? rs_e[(size_t)u.pa * BM + threadIdx.x] * (1.0f / F8_WSCALE) : 0.f; }
    __device__ __forceinline__ void operator()(const f32x4 (&acc)[2][2][4][2], const Unit& u, int wr, int wc, int fr, int fq, const PG8_LAS float* rsl) const {
        const int row0 = u.pm * BM + wr * 64 + fr; const int col0 = u.pnl * HALF + wc * 32 + 8 * fq;
#pragma unroll
        for (int ai = 0; ai < 2; ++ai)
#pragma unroll
            for (int m = 0; m < 4; ++m) { const int row = row0 + ai * HALF + m * 16; unsigned char* rowp = O + (size_t)row * ldc + col0; const float rs = rsl[row - u.pm * BM];
                const float rsn = rs * -1.4426950408889634f, rs2 = rs * rs * F8_ASCALE; const f32x4 h0 = swiglu4(acc[ai][0][m][0], acc[ai][1][m][0], rsn, rs2), h1 = swiglu4(acc[ai][0][m][1], acc[ai][1][m][1], rsn, rs2);
                const unsigned w0 = pk4_fp8(h0[0], h0[1], h0[2], h0[3]);
                const unsigned w1 = pk4_fp8(h1[0], h1[1], h1[2], h1[3]);
                *(unsigned long long*)rowp = (unsigned long long)w0 | ((unsigned long long)w1 << 32); }
    }
};
struct EpiMoeDown {
    static constexpr bool PERM = true;
    bf16_t* Y; int ldc; float scale; bf16_t* Y1; bf16_t* Y2; bf16_t* Y3;
    static constexpr bool HAS_PREP = false;
    __device__ __forceinline__ void prep(const Unit&, PG8_LAS float*) const {}
    __device__ __forceinline__ void operator()(const f32x4 (&acc)[2][2][4][2], const Unit& u, int wr, int wc, int fr, int fq, const PG8_LAS float*) const {
        const int row0 = u.pm * BM + wr * 64 + fr; const int col0 = u.pnl * BM + wc * 32 + 8 * fq;
        bf16_t* const Yb = u.part == 0 ? Y : u.part == 1 ? Y1 : u.part == 2 ? Y2 : Y3;
#pragma unroll
        for (int ai = 0; ai < 2; ++ai)
#pragma unroll
            for (int m = 0; m < 4; ++m) { bf16_t* rowp = Yb + (size_t)(row0 + ai * HALF + m * 16) * ldc + col0;
#pragma unroll
                for (int bj = 0; bj < 2; ++bj) { const f32x4 v0 = acc[ai][bj][m][0] * scale, v1 = acc[ai][bj][m][1] * scale;
                    u32x4 w; w.x = cvt_pk_bf16(v0[0], v0[1]); w.y = cvt_pk_bf16(v0[2], v0[3]); w.z = cvt_pk_bf16(v1[0], v1[1]); w.w = cvt_pk_bf16(v1[2], v1[3]);
                    *(u32x4*)(rowp + bj * HALF) = w; } }
    }
};

template <class Epi, class Sched, bool ALIGN_EPI, bool F8 = false>
__device__ __forceinline__ void gemm_phase(PG8_LAS unsigned char* lds, const Gemm g, const Sched& S, const Epi& E) {
    const int tid = threadIdx.x, wid = __builtin_amdgcn_readfirstlane(tid >> 6), lane = tid & 63, wr = wid >> 2, wc = wid & 3, fr = lane & 15, fq = lane >> 4;
    constexpr int EB = F8 ? 1 : 2;
    const int K = g.K; int nt = K * EB / (BK * 2);
    unsigned voffB[2], voffA[2];
#pragma unroll
    for (int i = 0; i < 2; ++i) { int R, C; stage_rc(tid * 16 + i * 8192, R, C); const int Rb = Epi::PERM ? ((R & ~31) + perm32(R & 31)) : R;
        voffA[i] = (unsigned)(R * K * EB + C * 2); voffB[i] = (unsigned)(Rb * K * EB + C * 2); }
    const size_t kstep = (size_t)(BK * 2);
    const size_t hstep = (size_t)HALF * K * EB;
    const size_t tstep = 2 * hstep;
    const unsigned ldsw = (unsigned)wid * 1024u;
    const int aoff = lds_byte(wr * 64 + fr, fq * (F8 ? 16 : 8)), boff = lds_byte(wc * 32 + fr, fq * (F8 ? 16 : 8));
    typedef int v8i_ __attribute__((ext_vector_type(8))); typedef int v4i_ __attribute__((ext_vector_type(4)));
#define PG8_SA(b, h) (((b) * 2 + (h)) * HTB)
#define PG8_SB(b, h) ((4 + (b) * 2 + (h)) * HTB)
#define PG8_STAGE(bufoff, gbase, voff) do { _Pragma("unroll") for (int _i = 0; _i < 2; ++_i) \
        __builtin_amdgcn_global_load_lds((const unsigned*)((const char*)(gbase) + (voff)[_i]), (PG8_LAS unsigned*)(lds + (bufoff) + ldsw + _i * 8192), 16, 0, 0); } while (0)
#define PG8_LD32(p) __builtin_shufflevector(*(const PG8_LAS v4i_*)(p), *(const PG8_LAS v4i_*)((p) + 16), 0, 1, 2, 3, 4, 5, 6, 7)
#define PG8_LDA(dst, b, h) do { _Pragma("unroll") for (int m = 0; m < 4; ++m) { if constexpr (F8) dst##8[m] = PG8_LD32(lds + PG8_SA(b, h) + aoff + m * 2048); else { _Pragma("unroll") for (int k = 0; k < 2; ++k) dst[m][k] = *(const PG8_LAS bf16x8*)(lds + PG8_SA(b, h) + aoff + m * 2048 + k * 1024); } } } while (0)
#define PG8_LDB(dst, b, h) do { _Pragma("unroll") for (int n = 0; n < 2; ++n) { if constexpr (F8) dst##8[n] = PG8_LD32(lds + PG8_SB(b, h) + boff + n * 2048); else { _Pragma("unroll") for (int k = 0; k < 2; ++k) dst[n][k] = *(const PG8_LAS bf16x8*)(lds + PG8_SB(b, h) + boff + n * 2048 + k * 1024); } } } while (0)
#define PG8_MMA(ai, bj, At, Bt) do { __builtin_amdgcn_s_setprio(1); _Pragma("unroll") for (int m = 0; m < 4; ++m) _Pragma("unroll") for (int n = 0; n < 2; ++n) { \
        if constexpr (F8) acc[ai][bj][m][n] = __builtin_amdgcn_mfma_scale_f32_16x16x128_f8f6f4(Bt##8[n], At##8[m], acc[ai][bj][m][n], 0, 0, 0, 0x7F7F7F7F, 0, 0x7F7F7F7F); \
        else { _Pragma("unroll") for (int k = 0; k < 2; ++k) acc[ai][bj][m][n] = __builtin_amdgcn_mfma_f32_16x16x32_bf16(Bt[n][k], At[m][k], acc[ai][bj][m][n], 0, 0, 0); } } \
        if constexpr (F8) { _Pragma("unroll") for (int m = 0; m < 4; ++m) _Pragma("unroll") for (int n = 0; n < 2; ++n) asm volatile("" : "+v"(acc[ai][bj][m][n])); }     \
        __builtin_amdgcn_s_setprio(0); } while (0)
#define PG8_WAIT_V(n) asm volatile("s_waitcnt vmcnt(" #n ")" ::: "memory")
#define PG8_WAIT_L(n) asm volatile("s_waitcnt lgkmcnt(" #n ")" ::: "memory")
#define PG8_BAR __builtin_amdgcn_s_barrier()
#define PG8_SCHED __builtin_amdgcn_sched_barrier(0)
    Unit cur, nxt; int ui = 0;
    if (!S.next(0, cur)) return;
    f32x4 acc[2][2][4][2];
#pragma unroll
    for (int a = 0; a < 2; ++a)
#pragma unroll
        for (int b = 0; b < 2; ++b)
#pragma unroll
            for (int m = 0; m < 4; ++m)
#pragma unroll
                for (int n = 0; n < 2; ++n) acc[a][b][m][n] = (f32x4){0.f, 0.f, 0.f, 0.f};
    bf16x8 At[4][2], B0[2][2], B1[2][2]; v8i_ At8[4], B08[2], B18[2];
    const char* cA = (const char*)g.A + (size_t)cur.pa * tstep; const char* cB = (const char*)g.Bt + (size_t)cur.pn * tstep;
    if constexpr (Sched::KSPLIT) { cA += (size_t)cur.k0 * (BK * 2); cB += (size_t)cur.k0 * (BK * 2); nt = cur.nk; }
    PG8_LAS float* const rsl0 = (PG8_LAS float*)(lds + STAGE_BYTES);
    if constexpr (Epi::HAS_PREP) E.prep(cur, rsl0);
    PG8_STAGE(PG8_SB(0, 0), cB, voffB); PG8_STAGE(PG8_SB(0, 1), cB + hstep, voffB); PG8_STAGE(PG8_SA(0, 0), cA, voffA); PG8_STAGE(PG8_SA(0, 1), cA + hstep, voffA);
    if (wr == 1) PG8_BAR;
    PG8_WAIT_V(2); PG8_BAR;
    PG8_STAGE(PG8_SB(1, 0), cB + kstep, voffB); PG8_STAGE(PG8_SA(1, 0), cA + kstep, voffA); PG8_STAGE(PG8_SB(1, 1), cB + hstep + kstep, voffB);
    PG8_WAIT_V(6); PG8_BAR;
    for (;;) {
        const bool has_next = S.next(ui + 1, nxt);
        const char* nA = has_next ? (const char*)g.A + (size_t)nxt.pa * tstep : cA; const char* nB = has_next ? (const char*)g.Bt + (size_t)nxt.pn * tstep : cB;
        if constexpr (Sched::KSPLIT) { if (has_next) { nA += (size_t)nxt.k0 * kstep; nB += (size_t)nxt.k0 * kstep; } }
        for (int t = 0; t < nt; t += 2) {
            const bool last = (t == nt - 2);
            const char* a1 = cA + (size_t)(t + 1) * kstep;
            const char* a2 = last ? nA : cA + (size_t)(t + 2) * kstep; const char* b2 = last ? nB : cB + (size_t)(t + 2) * kstep;
            const char* a3 = a2 + kstep; const char* b3 = b2 + kstep;
            PG8_LDB(B0, 0, 0); PG8_LDB(B1, 0, 1); PG8_SCHED; PG8_LDA(At, 0, 0); PG8_STAGE(PG8_SA(1, 1), a1 + hstep, voffA);
            PG8_WAIT_V(8); PG8_WAIT_L(0); PG8_BAR; PG8_MMA(0, 0, At, B0); PG8_MMA(0, 1, At, B1); PG8_BAR; PG8_SCHED;
            PG8_LDA(At, 0, 1); PG8_STAGE(PG8_SB(0, 0), b2, voffB); PG8_STAGE(PG8_SB(0, 1), b2 + hstep, voffB); PG8_STAGE(PG8_SA(0, 0), a2, voffA);
            PG8_WAIT_V(8); PG8_WAIT_L(0); PG8_BAR; PG8_MMA(1, 0, At, B0); PG8_MMA(1, 1, At, B1); PG8_BAR; PG8_SCHED;
            PG8_LDB(B0, 1, 0); PG8_LDB(B1, 1, 1); PG8_SCHED; PG8_LDA(At, 1, 0); PG8_STAGE(PG8_SA(0, 1), a2 + hstep, voffA);
            PG8_WAIT_V(8); PG8_WAIT_L(0); PG8_BAR; PG8_MMA(0, 0, At, B0); PG8_MMA(0, 1, At, B1); PG8_BAR; PG8_SCHED;
            PG8_LDA(At, 1, 1); PG8_STAGE(PG8_SB(1, 0), b3, voffB); PG8_STAGE(PG8_SB(1, 1), b3 + hstep, voffB); PG8_STAGE(PG8_SA(1, 0), a3, voffA);
            PG8_WAIT_V(8); PG8_WAIT_L(0); PG8_BAR; PG8_MMA(1, 0, At, B0); PG8_MMA(1, 1, At, B1); PG8_BAR; PG8_SCHED;
        }
        if constexpr (ALIGN_EPI) { if (wr == 0) PG8_BAR; }
        E(acc, cur, wr, wc, fr, fq, rsl0 + (ui & 1) * 256);
        if (!has_next) break;
#pragma unroll
        for (int a = 0; a < 2; ++a)
#pragma unroll
            for (int b = 0; b < 2; ++b)
#pragma unroll
                for (int m = 0; m < 4; ++m)
#pragma unroll
                    for (int n = 0; n < 2; ++n) acc[a][b][m][n] = (f32x4){0.f, 0.f, 0.f, 0.f};
        cur = nxt; cA = nA; cB = nB; ++ui; if constexpr (Sched::KSPLIT) nt = cur.nk;
        if constexpr (Epi::HAS_PREP) E.prep(cur, rsl0 + (ui & 1) * 256);
        if constexpr (ALIGN_EPI) { if (wr == 1) PG8_BAR; }
    }
    PG8_WAIT_V(0);
    if constexpr (!ALIGN_EPI) { if (wr == 0) PG8_BAR; }
    PG8_BAR;
#undef PG8_SA
#undef PG8_SB
#undef PG8_STAGE
#undef PG8_LDA
#undef PG8_LD32
#undef PG8_LDB
#undef PG8_MMA
#undef PG8_WAIT_V
#undef PG8_WAIT_L
#undef PG8_BAR
#undef PG8_SCHED
}
}

constexpr int NWAVES = 8;
constexpr int BATCH = 2, T = 8192, D = 1024, M = BATCH * T;
constexpr int HG_H = 8, HG_DH = 128;
constexpr int NH = 16, NG = 4, HPG = 4, DH = 64;
constexpr int NCMP = 511, NCMPP = 512, NSEL = 128, NTOP = 16, WIN = 512;
constexpr int FF = 2816, NE = 8, EF = 3584;
constexpr int NIN0 = 4 * D;
constexpr int NKV = 1536, NQIN = 1072, NQINP = 1280;
constexpr int NSLOT = 2 * M + NE * 256;
constexpr float NORM_EPS = 1e-6f;

constexpr size_t MiB = 1u << 20;
constexpr size_t WS_CTL = 0, CTL_ZERO_BYTES = 32 * 1024;
constexpr size_t WS_SSP1 = 222 * MiB, WS_SSP2 = 223 * MiB, WS_SSP3 = 8 * MiB;
constexpr size_t WS_LB = 1 * MiB;
constexpr size_t WS_ROUTE = 6 * MiB;
constexpr size_t WS_W_IN0 = 16 * MiB;
constexpr size_t WS_W_OUT0 = 24 * MiB;
constexpr size_t WS_W_GU0 = 26 * MiB;
constexpr size_t WS_W_DN0 = 37 * MiB;
constexpr size_t WS_W_KV = 43 * MiB;
constexpr size_t WS_W_QIN = 46 * MiB;
constexpr size_t WS_W_OUT1 = 49 * MiB;
constexpr size_t WS_W_GU1 = 51 * MiB;
constexpr size_t WS_W_DN1 = 163 * MiB;
constexpr size_t WS_RS_E = 256 * MiB;
constexpr size_t WS_W1T = 219 * MiB;
constexpr size_t WS_W2T = 221 * MiB;
constexpr size_t WS_PB = 221 * MiB + 256 * 1024;
constexpr size_t WS_XN = 224 * MiB;
constexpr size_t WS_KV = 352 * MiB;
constexpr size_t WS_QG = 400 * MiB;
constexpr size_t WS_OATT = 440 * MiB;
constexpr size_t WS_R = 480 * MiB;
constexpr size_t WS_QFIG = WS_R;
constexpr size_t WS_O0 = WS_R + 128 * MiB;
constexpr size_t WS_OG = WS_R + 192 * MiB;
constexpr size_t WS_ACT = WS_R + 288 * MiB;
constexpr size_t WS_ACT2 = WS_R;
constexpr size_t WS_XG8 = WS_R + 120 * MiB;
constexpr size_t WS_Y2 = WS_R + 256 * MiB;
constexpr size_t WS_YP1 = WS_KV, WS_YP2 = WS_XG8, WS_YP3 = WS_XG8 + 68 * MiB;
static_assert((size_t)NSLOT * D * 2 <= 68 * MiB && WS_YP1 + 68 * MiB <= WS_R && WS_YP3 + 68 * MiB <= WS_Y2, "d_ws map (K-split partials)");
constexpr size_t WS_OACC = WS_R + 272 * MiB;
constexpr size_t WS_END = WS_R + 376 * MiB;
static_assert(WS_ACT2 + (size_t)NSLOT * EF <= WS_XG8 && WS_XG8 + (size_t)NE * M * D <= WS_Y2 && WS_Y2 + (size_t)NSLOT * D * 2 <= WS_END && WS_ACT + (size_t)M * FF * 2 <= WS_END, "d_ws map");
constexpr int CW_TMO = 0;
constexpr int CW_ECNT = 64;
constexpr int CW_BAR = 4096;

constexpr int RING_OFF = 0, RING_BYTES = 131072;
constexpr int LDSCTL_OFF = 147456 - 1024, MISC_OFF = LDSCTL_OFF + 320;
constexpr int LDS_BYTES = 147456;
static_assert(MISC_OFF + 128 <= LDS_BYTES, "LDS map");

#define GAS __attribute__((address_space(1)))
#define LAS __attribute__((address_space(3)))
typedef unsigned short bf16;
typedef unsigned v4u __attribute__((ext_vector_type(4)));
typedef float f32x4 __attribute__((ext_vector_type(4)));
typedef short bf16x8 __attribute__((ext_vector_type(8)));
typedef GAS unsigned gu32;
#define RLX_AGENT __ATOMIC_RELAXED, __HIP_MEMORY_SCOPE_AGENT
#define LDS_WAIT() asm volatile("s_waitcnt lgkmcnt(0)" ::: "memory")
#define VM_WAIT() asm volatile("s_waitcnt vmcnt(0)" ::: "memory")
typedef float f32x2p_ __attribute__((ext_vector_type(2)));
typedef __bf16 bf16x2p_ __attribute__((ext_vector_type(2)));
__device__ __forceinline__ unsigned pk2(float lo, float hi) { f32x2p_ v = {lo, hi}; bf16x2p_ b = __builtin_convertvector(v, bf16x2p_); return __builtin_bit_cast(unsigned, b); }
__device__ __forceinline__ unsigned f2bf(float f) { return pk2(f, 0.f) & 0xffffu; }
__device__ __forceinline__ float bf2f(unsigned short b) { return __builtin_bit_cast(float, (unsigned)b << 16); }
__device__ __forceinline__ float bflo(unsigned w) { return __builtin_bit_cast(float, w << 16); }
__device__ __forceinline__ float bfhi(unsigned w) { return __builtin_bit_cast(float, w & 0xffff0000u); }
__device__ __forceinline__ float sigmoid_f(float x) { return __builtin_amdgcn_rcpf(1.0f + __expf(-x)); }
#define XB_TMO      128
#define XB_XCNT(j)  (256  + 64 * (j))
#define XB_XSUB(j)  (1280 + 64 * (j))
#define XB_XGEN(j)  (2304 + 64 * (j))
#define XB_TOP      3328
#define XB_TOPGEN   3392
#define XCD_BAR_WORDS 3456
#define XB_SPIN_CAP (1u << 18)

__device__ __forceinline__ unsigned xb_ld(unsigned* p)              { return __hip_atomic_load(p, __ATOMIC_RELAXED, __HIP_MEMORY_SCOPE_AGENT); }
__device__ __forceinline__ unsigned xb_add(unsigned* p, unsigned v) { return __hip_atomic_fetch_add(p, v, __ATOMIC_RELAXED, __HIP_MEMORY_SCOPE_AGENT); }
__device__ __forceinline__ unsigned xb_xcc_id() { return (unsigned)__builtin_amdgcn_s_getreg((3 << 11) | 20) & 0xFu; }
#define XB_SPIN(cond, bar) do { unsigned _sp = 0; while (cond) { __builtin_amdgcn_s_sleep(1); \
    if ((++_sp & 255u) == 0u) { if (xb_ld(&(bar)[XB_TMO])) break; if (_sp > XB_SPIN_CAP) { atomicAdd(&(bar)[XB_TMO], 1u); break; } } } } while (0)

struct XcdBarrier {
    unsigned* bar; unsigned x;
    volatile LAS unsigned* st;
};

__device__ __forceinline__ XcdBarrier xcd_barrier_post(unsigned* bar, volatile LAS unsigned* st) {
    XcdBarrier b; b.bar = bar; b.x = xb_xcc_id(); b.st = st;
    if (threadIdx.x == 0) (void)xb_add(&bar[XB_XCNT(b.x)], 1u);
    return b;
}
__device__ __forceinline__ void xcd_barrier_complete(unsigned* bar, unsigned x, unsigned& nloc, unsigned& nx) {
    const unsigned G = gridDim.x * gridDim.y * gridDim.z;
    unsigned sum, cnt, mine, sp = 0u;
    for (;;) {
        sum = 0u; cnt = 0u; mine = 0u;
#pragma unroll
        for (unsigned j = 0; j < 16; ++j) { const unsigned c = xb_ld(&bar[XB_XCNT(j)]); sum += c; cnt += (c > 0u) ? 1u : 0u; mine = (j == x) ? c : mine; }
        if (sum == G) break;
        __builtin_amdgcn_s_sleep(1);
        if ((++sp & 255u) == 0u) { if (xb_ld(&bar[XB_TMO])) break; if (sp > XB_SPIN_CAP) { atomicAdd(&bar[XB_TMO], 1u); break; } }
    }
    nloc = mine > 0u ? mine : 1u; nx = cnt > 0u ? cnt : 1u;
}

__device__ __forceinline__ void xcd_barrier(const XcdBarrier& b) {
    asm volatile("s_waitcnt vmcnt(0)" ::: "memory");
    __syncthreads();
    if (threadIdx.x == 0) {
        unsigned* bar = b.bar;
        __builtin_amdgcn_s_waitcnt(0);
        unsigned nloc = b.st[0], nx = b.st[1];
        if (nloc == 0u) { xcd_barrier_complete(bar, b.x, nloc, nx); b.st[0] = nloc; b.st[1] = nx; }
        const unsigned old = xb_add(&bar[XB_XSUB(b.x)], 1u);
        const unsigned gen = old / nloc;
        if (old + 1u == (gen + 1u) * nloc) {
            __builtin_amdgcn_fence(__ATOMIC_RELEASE, "agent");
            asm volatile("s_waitcnt vmcnt(0)" ::: "memory");
            const unsigned og = xb_add(&bar[XB_TOP], 1u);
            const unsigned tg = og / nx;
            if (og + 1u == (tg + 1u) * nx) xb_add(&bar[XB_TOPGEN], 1u);
            else XB_SPIN(xb_ld(&bar[XB_TOPGEN]) == tg, bar);
            __builtin_amdgcn_fence(__ATOMIC_ACQUIRE, "agent");
            xb_add(&bar[XB_XGEN(b.x)], 1u);
            asm volatile("s_waitcnt vmcnt(0)" ::: "memory");
        } else {
            XB_SPIN(xb_ld(&bar[XB_XGEN(b.x)]) == gen, bar);
            __builtin_amdgcn_fence(__ATOMIC_ACQUIRE, "agent");
            asm volatile("s_waitcnt vmcnt(0)" ::: "memory");
        }
    }
    __syncthreads();
}

enum InIdx { I_X = 0, I_NORM_MIX = 1, I_NORM_FFN = 2, I_A_W_IN = 3, I_A_W_OUT = 4, I_A_ONORM = 5, I_LB = 6, I_KV_NORM = 7, I_W_KV = 8, I_K_NORM = 9,
             I_CPOS_K = 10, I_CW1_K = 11, I_CW2_K = 12, I_CPOS_V = 13, I_CW1_V = 14, I_CW2_V = 15, I_B_W_IN = 16, I_B_W_OUT = 17, I_B_QNORM = 18, I_REL_BIAS = 19,
             I_FFN_GU = 20, I_FFN_DN = 21, I_MOE_ROUTER = 22, I_MOE_GU = 23, I_MOE_DN = 24, N_IN = 25 };
struct Args { const float* in[N_IN]; float* out; unsigned char* ws; int ph_lo, ph_hi; };
struct Frame {
    LAS unsigned char* lds;
    volatile LAS unsigned* MISC;
    gu32* ctl;
    int tid, lane, wave;
    int vcu, G;
    unsigned char* ws; float* out;
};
__device__ __forceinline__ float wave_sum(float v) {
#pragma unroll
    for (int o = 1; o < 64; o <<= 1) v += __shfl_xor(v, o);
    return v;
}
__device__ __forceinline__ int rel_bucket(int d) {
    d = d < 0 ? 0 : d;
    if (d < 16) return d;
    const float v = logf((float)d / 16.0f) / 4.852030263919617f * 16.0f;
    int lg = 16 + (int)v; return lg < 31 ? lg : 31;
}
__device__ __forceinline__ float gelu_tanh(float x) { const float u = 0.7978845608028654f * (x + 0.044715f * x * x * x); return x * __builtin_amdgcn_rcpf(1.0f + __expf(-2.0f * u)); }

template <bool FRAG = false> __device__ __forceinline__ void p0_transpose_item(const float* W, int ldw, int ncols, int K, bf16* WT, int dst_row0, LAS float* scr, int k0, int n0, int lane, const float* gain  ) {
    const int nn = n0 + 4 * (lane & 15); const bool ok = nn + 3 < ncols;
    f32x4 v[16];
#pragma unroll
    for (int i = 0; i < 16; ++i) { const int kk = 4 * i + (lane >> 4); v[i] = ok ? *(const GAS f32x4*)(W + (size_t)(k0 + kk) * ldw + nn) : (f32x4){0.f, 0.f, 0.f, 0.f}; }
#pragma unroll
    for (int i = 0; i < 16; ++i) { const int kk = 4 * i + (lane >> 4); const float gk = gain ? gain[k0 + kk] : 1.0f; LAS float* d = scr + kk * 65 + 4 * (lane & 15);
        d[0] = v[i].x * gk; d[1] = v[i].y * gk; d[2] = v[i].z * gk; d[3] = v[i].w * gk; }
    LDS_WAIT(); asm volatile("" ::: "memory");
#pragma unroll
    for (int i = 0; i < 8; ++i) { const int c = i * 64 + lane, n = c >> 3, kc = c & 7; const LAS float* s = scr + (8 * kc) * 65 + n;
        v4u o; o.x = pk2(s[0 * 65], s[1 * 65]); o.y = pk2(s[2 * 65], s[3 * 65]); o.z = pk2(s[4 * 65], s[5 * 65]); o.w = pk2(s[6 * 65], s[7 * 65]);
        if constexpr (FRAG) { const int rown = dst_row0 + n, kk8 = k0 + 8 * kc; *(GAS v4u*)(WT + ((((size_t)(rown >> 5) * (K >> 4) + (kk8 >> 4)) * 64) + ((kk8 >> 3) & 1) * 32 + (rown & 31)) * 8) = o; }
        else *(GAS v4u*)(WT + (size_t)(dst_row0 + n) * K + k0 + 8 * kc) = o; }
    LDS_WAIT(); asm volatile("" ::: "memory");
}
__device__ __forceinline__ void p0_transpose_item_f8(const float* W, int ldw, int K, unsigned char* WT, int dst_row0, LAS float* scr, int k0, int n0, int lane, const float* gain) {
    const int nn = n0 + 4 * (lane & 15);
    f32x4 v[16];
#pragma unroll
    for (int i = 0; i < 16; ++i) { const int kk = 4 * i + (lane >> 4); v[i] = *(const GAS f32x4*)(W + (size_t)(k0 + kk) * ldw + nn); }
#pragma unroll
    for (int i = 0; i < 16; ++i) { const int kk = 4 * i + (lane >> 4); const float gk = (gain ? gain[k0 + kk] : 1.0f) * pg8::F8_WSCALE; LAS float* d = scr + kk * 65 + 4 * (lane & 15);
        d[0] = v[i].x * gk; d[1] = v[i].y * gk; d[2] = v[i].z * gk; d[3] = v[i].w * gk; }
    LDS_WAIT(); asm volatile("" ::: "memory");
#pragma unroll
    for (int i = 0; i < 4; ++i) { const int c = i * 64 + lane, n = c >> 2, kc = c & 3; const LAS float* s = scr + (16 * kc) * 65 + n;
        v4u o; o.x = pg8::pk4_fp8(s[0 * 65], s[1 * 65], s[2 * 65], s[3 * 65]); o.y = pg8::pk4_fp8(s[4 * 65], s[5 * 65], s[6 * 65], s[7 * 65]);
        o.z = pg8::pk4_fp8(s[8 * 65], s[9 * 65], s[10 * 65], s[11 * 65]); o.w = pg8::pk4_fp8(s[12 * 65], s[13 * 65], s[14 * 65], s[15 * 65]);
        *(GAS v4u*)(WT + (size_t)(dst_row0 + n) * K + k0 + 16 * kc) = o; }
    LDS_WAIT(); asm volatile("" ::: "memory");
}
template <int GU> __device__ __forceinline__ void p0_item_f8(const float* W, int ldw, int npad, int K, unsigned char* WT, LAS float* scr, int r, int lane, const float* gain) {
    const int nblk = npad / 64, kb = r / nblk, nb = r % nblk, n0 = 64 * nb;
    int dst = n0;
    if (GU) { if (n0 < GU) dst = 256 * (n0 / 128) + (n0 % 128); else { const int n1 = n0 - GU; dst = 256 * (n1 / 128) + 128 + (n1 % 128); } }
    p0_transpose_item_f8(W, ldw, K, WT, dst, scr, 64 * kb, n0, lane, gain);
}
template <int GU, bool FRAG = false> __device__ __forceinline__ void p0_item(const float* W, int ldw, int ncols, int npad, int K, bf16* WT, LAS float* scr, int r, int lane, const float* gain = nullptr) {
    const int nblk = npad / 64, kb = r / nblk, nb = r % nblk, n0 = 64 * nb;
    int dst = n0;
    if (GU) { if (n0 < GU) dst = 256 * (n0 / 128) + (n0 % 128); else { const int n1 = n0 - GU; dst = 256 * (n1 / 128) + 128 + (n1 % 128); } }
    p0_transpose_item<FRAG>(W, ldw, ncols, K, WT, dst, scr, 64 * kb, n0, lane, gain);
}
__device__ __forceinline__ void rms_row_to_bf16(const float* xrow, const float* gain, bf16* orow, int lane) {
    const GAS f32x4* xr = (const GAS f32x4*)xrow + lane; const GAS f32x4* gr = (const GAS f32x4*)gain + lane;
    f32x4 v[4]; float s = 0.f;
#pragma unroll
    for (int j = 0; j < 4; ++j) { v[j] = xr[64 * j]; s += (v[j].x * v[j].x + v[j].y * v[j].y) + (v[j].z * v[j].z + v[j].w * v[j].w); }
    const float rstd = 1.0f / sqrtf(wave_sum(s) * (1.f / D) + NORM_EPS);
    GAS unsigned long long* o8 = (GAS unsigned long long*)orow + lane;
#pragma unroll
    for (int j = 0; j < 4; ++j) { const f32x4 gg = gain ? gr[64 * j] : (f32x4){1.f, 1.f, 1.f, 1.f}; o8[64 * j] = (unsigned long long)pk2(v[j].x * rstd * gg.x, v[j].y * rstd * gg.y) | ((unsigned long long)pk2(v[j].z * rstd * gg.z, v[j].w * rstd * gg.w) << 32); }
}
constexpr int DEF_Q = 5;
constexpr int P0_I8 = 16 * 112, NWG_GU0 = (M / 256) * (2 * FF / 256), NWG_KVQ = (M / 256) * ((NKV + NQINP) / 256);
__device__ __forceinline__ void defer_counts(int G, int& nA, int& nB) { const int ra = NWG_GU0 % G, rb = NWG_KVQ % G; nA = ra ? (G - ra) * NWAVES * DEF_Q : 0; nB = rb ? (G - rb) * NWAVES * DEF_Q : 0;
    if (nA + nB > NE * P0_I8) { nA = 0; nB = 0; } }
__device__ __forceinline__ void p0_deferred(Frame& F, const Args& a, int nwg, bool second) {
    const int rem = nwg % F.G, c = (int)blockIdx.x; if (rem == 0 || c < rem) return;
    int nA, nB; defer_counts(F.G, nA, nB); if (nA + nB == 0) return;
    LAS float* scr = (LAS float*)(F.lds + RING_OFF + F.wave * 16640);
    const int wv = (c - rem) * NWAVES + F.wave, nw = (F.G - rem) * NWAVES, first = NE * P0_I8 - nA - nB + (second ? nA : 0);
    for (int q = 0; q < DEF_Q; ++q) { const int r = first + q * nw + wv; const int e = r / P0_I8;
        p0_item_f8<EF>(a.in[I_MOE_GU] + (size_t)e * D * 2 * EF, 2 * EF, 2 * EF, D, (unsigned char*)(F.ws + WS_W_GU1) + (size_t)e * 2 * EF * D, scr, r % P0_I8, F.lane, a.in[I_NORM_FFN] + D); }
}
__device__ __forceinline__ void p0_prologue(Frame& F, const Args& a) {
    LAS float* scr = (LAS float*)(F.lds + RING_OFF + F.wave * 16640);
    const int gw = F.vcu * NWAVES + F.wave, NGW = F.G * NWAVES;
    unsigned char* ws = F.ws;
    constexpr int I1 = 16 * 64, I2 = 16 * 16, I3 = 16 * 88, I4 = 44 * 16, I5 = 16 * 24, I6 = 16 * 20, I7 = 16 * 16, I8 = P0_I8, I9 = 56 * 16;
    int nA, nB; defer_counts(F.G, nA, nB); const int ndef = nA + nB, DEF0 = I1 + I2 + I3 + I4 + I5 + I6 + I7 + NE * I8 - ndef;
    constexpr int I10 = 32 * 4, I11 = 4 * 1;
    constexpr int NITEMS = I1 + I2 + I3 + I4 + I5 + I6 + I7 + NE * I8 + NE * I9 + 2 * I10 + 2 * I11;
    for (int it = gw; it < NITEMS - ndef; it += NGW) {
        int r = it; if (r >= DEF0) r += ndef;
        if (r < I1) { p0_item<0>(a.in[I_A_W_IN], NIN0, NIN0, NIN0, D, (bf16*)(ws + WS_W_IN0), scr, r, F.lane, a.in[I_NORM_MIX]); continue; } r -= I1;
        if (r < I2) { p0_item<0>(a.in[I_A_W_OUT], D, D, D, D, (bf16*)(ws + WS_W_OUT0), scr, r, F.lane); continue; } r -= I2;
        if (r < I3) { p0_item<FF>(a.in[I_FFN_GU], 2 * FF, 2 * FF, 2 * FF, D, (bf16*)(ws + WS_W_GU0), scr, r, F.lane, a.in[I_NORM_FFN]); continue; } r -= I3;
        if (r < I4) { p0_item<0>(a.in[I_FFN_DN], D, D, D, FF, (bf16*)(ws + WS_W_DN0), scr, r, F.lane); continue; } r -= I4;
        if (r < I5) { p0_item<0>(a.in[I_W_KV], NKV, NKV, NKV, D, (bf16*)(ws + WS_W_KV), scr, r, F.lane, a.in[I_KV_NORM]); continue; } r -= I5;
        if (r < I6) { p0_item<0>(a.in[I_B_W_IN], NQIN, NQIN, NQINP, D, (bf16*)(ws + WS_W_QIN), scr, r, F.lane, a.in[I_NORM_MIX] + D); continue; } r -= I6;
        if (r < I7) { p0_item<0>(a.in[I_B_W_OUT], D, D, D, D, (bf16*)(ws + WS_W_OUT1), scr, r, F.lane); continue; } r -= I7;
        if (r < NE * I8) { const int e = r / I8; p0_item_f8<EF>(a.in[I_MOE_GU] + (size_t)e * D * 2 * EF, 2 * EF, 2 * EF, D, (unsigned char*)(ws + WS_W_GU1) + (size_t)e * 2 * EF * D, scr, r % I8, F.lane, a.in[I_NORM_FFN] + D); continue; } r -= NE * I8;
        if (r < NE * I9) { const int e = r / I9; p0_item_f8<0>(a.in[I_MOE_DN] + (size_t)e * EF * D, D, D, EF, (unsigned char*)(ws + WS_W_DN1) + (size_t)e * D * EF, scr, r % I9, F.lane, nullptr); continue; } r -= NE * I9;
        if (r < 2 * I10) { const int kv = r / I10; p0_item<0, true>(a.in[kv ? I_CW1_V : I_CW1_K], 256, 256, 256, 2048, (bf16*)(ws + WS_W1T) + (size_t)kv * 256 * 2048, scr, r % I10, F.lane); continue; } r -= 2 * I10;
        { const int kv = r / I11; p0_item<0>(a.in[kv ? I_CW2_V : I_CW2_K], 64, 64, 64, 256, (bf16*)(ws + WS_W2T) + (size_t)kv * 64 * 256, scr, r % I11, F.lane); }
    }
    if (blockIdx.x == 0) {
        const float* lbp = a.in[I_LB]; float* lbv = (float*)(ws + WS_LB);
        for (int c = F.tid; c < D; c += NWAVES * 64) { const float p0 = lbp[c], p1 = lbp[D + c], mx = fmaxf(p0, p1), e0 = __expf(p0 - mx), e1 = __expf(p1 - mx); lbv[c] = e0 / (e0 + e1); }
    }
    if (blockIdx.x == 1) {
        const int kv = F.tid >> 8, hidx = F.tid & 255; const float* w1 = a.in[kv ? I_CW1_V : I_CW1_K]; const float* pos = a.in[kv ? I_CPOS_V : I_CPOS_K]; float s = 0.f;
        for (int kk = 0; kk < 2048; ++kk) s += pos[kk] * w1[(size_t)kk * 256 + hidx];
        ((float*)(ws + WS_PB))[kv * 256 + hidx] = s;
    }
    const float* x = a.in[I_X]; const float* gmix = a.in[I_NORM_MIX]; bf16* XN = (bf16*)(ws + WS_XN);
    {
        f32x4 vn[4];
#pragma unroll
        for (int j = 0; j < 4; ++j) vn[j] = gw < M ? ((const GAS f32x4*)(x + (size_t)gw * D) + F.lane)[64 * j] : (f32x4){0.f, 0.f, 0.f, 0.f};
        for (int m = gw; m < M; m += NGW) {
            f32x4 v[4]; float s = 0.f;
#pragma unroll
            for (int j = 0; j < 4; ++j) { v[j] = vn[j]; s += (v[j].x * v[j].x + v[j].y * v[j].y) + (v[j].z * v[j].z + v[j].w * v[j].w); }
            if (m + NGW < M) { const GAS f32x4* xn = (const GAS f32x4*)(x + (size_t)(m + NGW) * D) + F.lane;
#pragma unroll
                for (int j = 0; j < 4; ++j) vn[j] = xn[64 * j]; }
            const float rstd = 1.0f / sqrtf(wave_sum(s) * (1.f / D) + NORM_EPS);
            GAS unsigned long long* o8 = (GAS unsigned long long*)(XN + (size_t)m * D) + F.lane;
#pragma unroll
            for (int j = 0; j < 4; ++j) o8[64 * j] = (unsigned long long)pk2(v[j].x * rstd, v[j].y * rstd) | ((unsigned long long)pk2(v[j].z * rstd, v[j].w * rstd) << 32);
        }
    }
}


typedef float f32x16 __attribute__((ext_vector_type(16)));
typedef float f32x2v __attribute__((ext_vector_type(2)));
typedef __bf16 bf16x2v __attribute__((ext_vector_type(2)));
#define MFMA32(a, b, c) __builtin_amdgcn_mfma_f32_32x32x16_bf16((a), (b), (c), 0, 0, 0)
constexpr float LOG2E = 1.4426950408889634f;
constexpr size_t WS_QN = WS_R + 336 * MiB;
constexpr size_t WS_VTS = 8 * MiB;
constexpr size_t WS_VTW = WS_R + 368 * MiB;
constexpr size_t WS_KF = WS_R + 240 * MiB;
constexpr size_t WS_VF = WS_R + 248 * MiB;
constexpr size_t WS_KC16 = 2 * MiB;
constexpr size_t WS_VTC = 3 * MiB;
constexpr size_t WS_BLG = 3 * MiB + 512 * 1024;
static_assert(WS_QN + (size_t)M * D * 2 <= WS_VTW && WS_VTW + 8 * MiB <= WS_END && WS_OACC + (size_t)M * D * 4 <= WS_QN, "d_ws map (attention)");
__device__ __forceinline__ int perm16(int x) { const int g4 = (x >> 2) & 3; const int gp = (g4 == 1) ? 2 : ((g4 == 2) ? 1 : g4); return (gp << 2) | (x & 3); }
__device__ __forceinline__ unsigned cvtpk(float lo, float hi) { f32x2v v = {lo, hi}; bf16x2v b = __builtin_convertvector(v, bf16x2v); return __builtin_bit_cast(unsigned, b); }
__device__ __forceinline__ bf16x8 pack8(const f32x16& p, int s) { v4u w; w.x = cvtpk(p[8 * s], p[8 * s + 1]); w.y = cvtpk(p[8 * s + 2], p[8 * s + 3]); w.z = cvtpk(p[8 * s + 4], p[8 * s + 5]); w.w = cvtpk(p[8 * s + 6], p[8 * s + 7]); return __builtin_bit_cast(bf16x8, w); }
__device__ __forceinline__ bf16x8 ldg8(const bf16* p) { return *(const GAS bf16x8*)p; }


constexpr size_t WS_UT = WS_O0;
constexpr size_t WS_ST = WS_ACT;
constexpr size_t WS_DEC = 2 * MiB;
constexpr int HG_SEG = 0, HG_AP = 2048, HG_AQ = HG_AP + 64 * 136 * 2, HG_BP = HG_AQ + 64 * 136 * 2, HG_VT = HG_BP + 64 * 136 * 2, HG_KDT = HG_VT + 128 * 72 * 2, HG_PS = HG_KDT + 128 * 72 * 2;
static_assert(HG_PS + 1024 <= RING_BYTES, "HGRN2 LDS map");
__device__ __forceinline__ void hg_gates_raw(const unsigned short (&rf)[16], float lb, LAS float* SEG, int d, int seg, float (&kk)[16], float (&bb)[16], float& b31, float& blast) {
    float acc = 0.f;
#pragma unroll
    for (int u = 0; u < 16; ++u) { const float f = bf2f(rf[u]); const float g = lb + (1.f - lb) * sigmoid_f(f); kk[u] = 1.f - g; acc += __logf(g); bb[u] = acc; }
    SEG[seg * 128 + d] = acc;
    __syncthreads();
    const float s0 = SEG[d], s1 = SEG[128 + d], s2 = SEG[256 + d], s3 = SEG[384 + d];
    const float pre = seg == 0 ? 0.f : (seg == 1 ? s0 : (seg == 2 ? s0 + s1 : s0 + s1 + s2));
    b31 = s0 + s1; blast = (s0 + s1) + (s2 + s3);
#pragma unroll
    for (int u = 0; u < 16; ++u) bb[u] += pre;
}
__device__ __forceinline__ void p_hg_a(Frame& F) {
    const bf16* QFIG = (const bf16*)(F.ws + WS_QFIG); bf16* UT = (bf16*)(F.ws + WS_UT); float* DEC = (float*)(F.ws + WS_DEC); const float* lbv = (const float*)(F.ws + WS_LB);
    LAS float* SEG = (LAS float*)(F.lds + HG_SEG); LAS unsigned short* VT = (LAS unsigned short*)(F.lds + HG_VT); LAS unsigned short* KDT = (LAS unsigned short*)(F.lds + HG_KDT);
    const int tid = F.tid, lane = F.lane, w = F.wave, d = tid & 127, seg = tid >> 7, l31 = lane & 31, hi = lane >> 5;
    unsigned short rf[16], rv[16]; float lbn = 0.f;
#define HA_LOAD_RAW(un) do { const int bh_ = (un) >> 7, j_ = (un) & 127; const bf16* r0_ = QFIG + (size_t)((bh_ >> 3) * T + 64 * j_ + 16 * seg) * NIN0 + (bh_ & 7) * 128 + d; \
        lbn = lbv[(bh_ & 7) * 128 + d]; _Pragma("unroll") for (int u = 0; u < 16; ++u) { rf[u] = r0_[(size_t)u * NIN0 + D]; rv[u] = r0_[(size_t)u * NIN0 + 2 * D]; } } while (0)
    const int nunits = BATCH * HG_H * (T / 64);
    if (F.vcu < nunits) HA_LOAD_RAW(F.vcu);
    for (int unit = F.vcu; unit < nunits; unit += F.G) {
        const int bh = unit >> 7, h = bh & 7;
        float kk[16], bb[16], b31, blast;
        __syncthreads();
        hg_gates_raw(rf, lbn, SEG, d, seg, kk, bb, b31, blast);
#pragma unroll
        for (int h2 = 0; h2 < 2; ++h2) { v4u kq, vq;
#pragma unroll
            for (int k = 0; k < 4; ++k) { const int u = 8 * h2 + 2 * k; kq[k] = pk2(kk[u] * __expf(blast - bb[u]), kk[u + 1] * __expf(blast - bb[u + 1])); vq[k] = (unsigned)rv[u] | ((unsigned)rv[u + 1] << 16); }
            *(LAS v4u*)(KDT + d * 72 + 16 * seg + 8 * h2) = kq; *(LAS v4u*)(VT + d * 72 + 16 * seg + 8 * h2) = vq; }
        if (seg == 3) DEC[(size_t)unit * 128 + d] = __expf(blast);
        if (unit + F.G < nunits) HA_LOAD_RAW(unit + F.G);
        __syncthreads();
        const int et = w >> 1;
#pragma unroll
        for (int dd = 0; dd < 2; ++dd) { const int dt = (w & 1) * 2 + dd; f32x16 c = (f32x16){0.f,0.f,0.f,0.f,0.f,0.f,0.f,0.f,0.f,0.f,0.f,0.f,0.f,0.f,0.f,0.f};
#pragma unroll
            for (int ks = 0; ks < 4; ++ks) { const bf16x8 av = *(const LAS bf16x8*)(VT + (32 * et + l31) * 72 + 16 * ks + 8 * hi), bv = *(const LAS bf16x8*)(KDT + (32 * dt + l31) * 72 + 16 * ks + 8 * hi); c = MFMA32(av, bv, c); }
            bf16* up = UT + ((size_t)unit * 128 + 32 * et + 4 * hi) * 128 + 32 * dt + l31;
#pragma unroll
            for (int r = 0; r < 16; ++r) up[(size_t)((r & 3) + 8 * (r >> 2)) * 128] = (bf16)f2bf(c[r]); }
    }
#undef HA_LOAD_RAW
}
__device__ __forceinline__ void p_hg_b(Frame& F) {
    const unsigned* UT = (const unsigned*)(F.ws + WS_UT); unsigned* ST = (unsigned*)(F.ws + WS_ST); const float* DEC = (const float*)(F.ws + WS_DEC);
    const int gt = F.vcu * (NWAVES * 64) + F.tid, NT = F.G * NWAVES * 64;
    for (int idx = gt; idx < BATCH * HG_H * 128 * 64; idx += NT) {
        const int bh = idx >> 13, e = (idx >> 6) & 127, dp = idx & 63;
        float s0 = 0.f, s1 = 0.f;
        size_t off = ((size_t)(bh * 128) * 128 + e) * 64 + dp;
        const float* dc = DEC + (size_t)(bh * 128) * 128 + 2 * dp;
        unsigned un[8]; f32x2v dn[8];
#pragma unroll
        for (int k = 0; k < 8; ++k) { un[k] = UT[off + (size_t)k * 128 * 64]; dn[k] = *(const GAS f32x2v*)(dc + (size_t)k * 128); }
        for (int j0 = 0; j0 < 128; j0 += 8) {
            unsigned uu[8]; f32x2v dd[8];
#pragma unroll
            for (int k = 0; k < 8; ++k) { uu[k] = un[k]; dd[k] = dn[k]; }
            if (j0 + 8 < 128) {
#pragma unroll
                for (int k = 0; k < 8; ++k) { un[k] = UT[off + (size_t)(j0 + 8 + k) * 128 * 64]; dn[k] = *(const GAS f32x2v*)(dc + (size_t)(j0 + 8 + k) * 128); } }
#pragma unroll
            for (int k = 0; k < 8; ++k) { ST[off + (size_t)(j0 + k) * 128 * 64] = pk2(s0, s1); s0 = dd[k].x * s0 + bflo(uu[k]); s1 = dd[k].y * s1 + bfhi(uu[k]); }
        }
    }
}
__device__ __forceinline__ void p_hg_c(Frame& F, const float* gon) {
    const bf16* QFIG = (const bf16*)(F.ws + WS_QFIG); const bf16* ST = (const bf16*)(F.ws + WS_ST); bf16* OG = (bf16*)(F.ws + WS_OG); const float* lbv = (const float*)(F.ws + WS_LB);
    LAS float* SEG = (LAS float*)(F.lds + HG_SEG); LAS unsigned short* AP = (LAS unsigned short*)(F.lds + HG_AP); LAS unsigned short* AQ = (LAS unsigned short*)(F.lds + HG_AQ);
    LAS unsigned short* BP = (LAS unsigned short*)(F.lds + HG_BP); LAS unsigned short* VT = (LAS unsigned short*)(F.lds + HG_VT); LAS float* PS = (LAS float*)(F.lds + HG_PS);
    const int tid = F.tid, lane = F.lane, w = F.wave, d = tid & 127, seg = tid >> 7, l31 = lane & 31, hi = lane >> 5;
    const int st = w & 1, et = w >> 1;
    unsigned short rq[16], rf[16], rv[16]; bf16x8 sfr[8]; float lbn = 0.f;
#define HC_LOAD_RAW(un) do { const int bh_ = (un) >> 7, j_ = (un) & 127; const bf16* r0_ = QFIG + (size_t)((bh_ >> 3) * T + 64 * j_ + 16 * seg) * NIN0 + (bh_ & 7) * 128 + d; \
        lbn = lbv[(bh_ & 7) * 128 + d]; _Pragma("unroll") for (int u = 0; u < 16; ++u) { rq[u] = r0_[(size_t)u * NIN0]; rf[u] = r0_[(size_t)u * NIN0 + D]; rv[u] = r0_[(size_t)u * NIN0 + 2 * D]; } } while (0)
#define HC_LOAD_ST(un) do { const bf16* sp_ = ST + ((size_t)(un) * 128 + 32 * et + l31) * 128 + 8 * hi; _Pragma("unroll") for (int ks = 0; ks < 8; ++ks) sfr[ks] = ldg8(sp_ + 16 * ks); } while (0)
    const int nunits = BATCH * HG_H * (T / 64);
    if (F.vcu < nunits) { HC_LOAD_RAW(F.vcu); HC_LOAD_ST(F.vcu); }
    for (int unit = F.vcu; unit < nunits; unit += F.G) {
        const int bh = unit >> 7, j = unit & 127, b = bh >> 3, h = bh & 7;
        float kk[16], bb[16], b31, blast;
        __syncthreads();
        hg_gates_raw(rf, lbn, SEG, d, seg, kk, bb, b31, blast);
        const float eb31 = __expf(b31);
#pragma unroll
        for (int u = 0; u < 16; ++u) { const int tok = 16 * seg + u; const float q = bf2f(rq[u]);
            const float er = __expf(bb[u] - b31);
            AP[tok * 136 + d] = (unsigned short)f2bf(q * er); AQ[tok * 136 + d] = (unsigned short)f2bf(q * er * eb31);
            BP[tok * 136 + d] = (unsigned short)f2bf(kk[u] * __builtin_amdgcn_rcpf(er)); }
#pragma unroll
        for (int h2 = 0; h2 < 2; ++h2) { v4u vq;
#pragma unroll
            for (int k = 0; k < 4; ++k) { const int p0 = 8 * h2 + 2 * k; vq[k] = (unsigned)rv[perm16(p0)] | ((unsigned)rv[perm16(p0 + 1)] << 16); }
            *(LAS v4u*)(VT + d * 72 + 16 * seg + 8 * h2) = vq; }
        if (unit + F.G < nunits) HC_LOAD_RAW(unit + F.G);
        unsigned long long gpre[4]; f32x4 gopre[4];
        { const size_t mrow_ = (size_t)b * T + 64 * j + 32 * st + l31; const bf16* gp_ = QFIG + mrow_ * NIN0 + 3 * D + h * 128 + 32 * et + 4 * hi; const float* gop_ = gon + 32 * et + 4 * hi;
#pragma unroll
          for (int q4 = 0; q4 < 4; ++q4) { gpre[q4] = *(const GAS unsigned long long*)(gp_ + 8 * q4); gopre[q4] = *(const GAS f32x4*)(gop_ + 8 * q4); } }
        __syncthreads();
        f32x16 o = (f32x16){0.f,0.f,0.f,0.f,0.f,0.f,0.f,0.f,0.f,0.f,0.f,0.f,0.f,0.f,0.f,0.f};
#pragma unroll
        for (int ks = 0; ks < 8; ++ks) { const bf16x8 bv = *(const LAS bf16x8*)(AQ + (32 * st + l31) * 136 + 16 * ks + 8 * hi); o = MFMA32(sfr[ks], bv, o); }
        if (unit + F.G < nunits) HC_LOAD_ST(unit + F.G);
        for (int ut = 0; ut <= st; ++ut) { f32x16 at = (f32x16){0.f,0.f,0.f,0.f,0.f,0.f,0.f,0.f,0.f,0.f,0.f,0.f,0.f,0.f,0.f,0.f};
#pragma unroll
            for (int ks = 0; ks < 8; ++ks) { const bf16x8 av = *(const LAS bf16x8*)(BP + (32 * ut + l31) * 136 + 16 * ks + 8 * hi), bv = *(const LAS bf16x8*)(AP + (32 * st + l31) * 136 + 16 * ks + 8 * hi); at = MFMA32(av, bv, at); }
            if (ut == st) {
#pragma unroll
                for (int r = 0; r < 16; ++r) at[r] = ((r & 3) + 8 * (r >> 2) + 4 * hi <= l31) ? at[r] : 0.f; }
            const bf16x8 pb0 = pack8(at, 0), pb1 = pack8(at, 1);
            const bf16x8 v0 = *(const LAS bf16x8*)(VT + (32 * et + l31) * 72 + 32 * ut + 8 * hi), v1 = *(const LAS bf16x8*)(VT + (32 * et + l31) * 72 + 32 * ut + 16 + 8 * hi);
            o = MFMA32(v0, pb0, o); o = MFMA32(v1, pb1, o); }
        float ss = 0.f;
#pragma unroll
        for (int r = 0; r < 16; ++r) ss += o[r] * o[r];
        ss += __shfl_xor(ss, 32);
        if (hi == 0) PS[et * 64 + 32 * st + l31] = ss;
        __syncthreads();
        const int s = 32 * st + l31; const float tot = (PS[s] + PS[64 + s]) + (PS[128 + s] + PS[192 + s]);
        const float rstd = 1.0f / sqrtf(tot * (1.f / 128.f) + NORM_EPS);
        const size_t mrow = (size_t)b * T + 64 * j + s;
        const bf16* gp = QFIG + mrow * NIN0 + 3 * D + h * 128 + 32 * et + 4 * hi; bf16* op = OG + mrow * D + h * 128 + 32 * et + 4 * hi; const float* gop = gon + 32 * et + 4 * hi;
#pragma unroll
        for (int q4 = 0; q4 < 4; ++q4) { const unsigned long long gw8 = gpre[q4]; const unsigned glo = (unsigned)gw8, ghi = (unsigned)(gw8 >> 32); const f32x4 go = gopre[q4];
            const float a0 = bflo(glo), a1 = bfhi(glo), a2 = bflo(ghi), a3 = bfhi(ghi);
            const float y0 = o[4 * q4] * rstd * go.x * (a0 * sigmoid_f(a0)), y1 = o[4 * q4 + 1] * rstd * go.y * (a1 * sigmoid_f(a1)), y2 = o[4 * q4 + 2] * rstd * go.z * (a2 * sigmoid_f(a2)), y3 = o[4 * q4 + 3] * rstd * go.w * (a3 * sigmoid_f(a3));
            *(GAS unsigned long long*)(op + 8 * q4) = (unsigned long long)cvtpk(y0, y1) | ((unsigned long long)cvtpk(y2, y3) << 32); }
    }
}

__device__ __forceinline__ void p_knorm(Frame& F, const float* kng, const float* gq  ) {
    bf16* KV = (bf16*)(F.ws + WS_KV);
    const int gt = F.vcu * (NWAVES * 64) + F.tid, NT = F.G * NWAVES * 64;
    for (int idx = gt; idx < M * 8; idx += NT) {
        const int m = idx >> 3, j = idx & 7; const int col0 = j < 4 ? 512 + 64 * j : 1024 + 64 * (j - 4); const float* gain = kng + (j < 4 ? 64 : 128);
        GAS v4u* p = (GAS v4u*)(KV + (size_t)m * NKV + col0);
        v4u w[8]; float ss = 0.f;
#pragma unroll
        for (int i = 0; i < 8; ++i) { w[i] = p[i];
#pragma unroll
            for (int k = 0; k < 4; ++k) { const float a = bflo(w[i][k]), b = bfhi(w[i][k]); ss += a * a + b * b; } }
        const float rstd = 1.0f / sqrtf(ss * (1.f / 64.f) + NORM_EPS);
#pragma unroll
        for (int i = 0; i < 8; ++i) { v4u o;
#pragma unroll
            for (int k = 0; k < 4; ++k) o[k] = pk2(bflo(w[i][k]) * rstd * (gain[8 * i + 2 * k] * gq[8 * i + 2 * k]), bfhi(w[i][k]) * rstd * (gain[8 * i + 2 * k + 1] * gq[8 * i + 2 * k + 1]));
            p[i] = o;
            if (j < 4) { const int bq = m >> 13, tq = m & (T - 1);
                ((v4u*)(F.ws + WS_KF))[(size_t)((((bq * 4 + j) * 128 + (tq >> 6)) * 2 + ((tq >> 5) & 1)) * 4 + (i >> 1)) * 64 + (i & 1) * 32 + (tq & 31)] = o; } }
    }
}
__device__ __forceinline__ void p_route(Frame& F, const Args& a, bool dry = false) {
    const bf16* H3 = (const bf16*)(F.ws + WS_XN); const float* gain = a.in[I_NORM_FFN] + D; const float* wr = a.in[I_MOE_ROUTER];
    unsigned* route = (unsigned*)(F.ws + WS_ROUTE); gu32* ecnt = F.ctl + CW_ECNT;
    const int gw = F.vcu * NWAVES + F.wave, NGW = F.G * NWAVES;
    f32x4 wq[4][4][2];
#pragma unroll
    for (int j = 0; j < 4; ++j) { const GAS f32x4* wp = (const GAS f32x4*)(wr + (size_t)(256 * j + 4 * F.lane) * 8);
#pragma unroll
        for (int k = 0; k < 4; ++k) { wq[j][k][0] = wp[2 * k]; wq[j][k][1] = wp[2 * k + 1]; } }
    bool pend = false; int pm = 0, pe0 = 0, pe1 = 0; unsigned pp0 = 0u, pp1 = 0u, pw8[4] = {0u, 0u, 0u, 0u}; float pw0 = 0.f, pw1 = 0.f, prs = 0.f;
    unsigned long long xn[4];
#pragma unroll
    for (int j = 0; j < 4; ++j) xn[j] = gw < M ? ((const GAS unsigned long long*)(H3 + (size_t)gw * D) + F.lane)[64 * j] : 0ull;
    for (int m = gw; m < M; m += NGW) {
        const GAS f32x4* gr = (const GAS f32x4*)gain + F.lane;
        f32x4 v[4]; float s = 0.f; unsigned long long xq[4];
#pragma unroll
        for (int j = 0; j < 4; ++j) xq[j] = xn[j];
        if (m + NGW < M) { const GAS unsigned long long* xr2 = (const GAS unsigned long long*)(H3 + (size_t)(m + NGW) * D) + F.lane;
#pragma unroll
            for (int j = 0; j < 4; ++j) xn[j] = xr2[64 * j]; }
#pragma unroll
        for (int j = 0; j < 4; ++j) { v[j] = (f32x4){bflo((unsigned)xq[j]), bfhi((unsigned)xq[j]), bflo((unsigned)(xq[j] >> 32)), bfhi((unsigned)(xq[j] >> 32))}; s += (v[j].x * v[j].x + v[j].y * v[j].y) + (v[j].z * v[j].z + v[j].w * v[j].w); }
        const float rstd = 1.0f / sqrtf(wave_sum(s) * (1.f / D) + NORM_EPS);
        float lg[8];
#pragma unroll
        for (int e = 0; e < 8; ++e) lg[e] = 0.f;
#pragma unroll
        for (int j = 0; j < 4; ++j) { const f32x4 gg = gr[64 * j]; const f32x4 y = (f32x4){v[j].x * rstd * gg.x, v[j].y * rstd * gg.y, v[j].z * rstd * gg.z, v[j].w * rstd * gg.w};
#pragma unroll
            for (int k = 0; k < 4; ++k) { const f32x4 w0 = wq[j][k][0], w1 = wq[j][k][1]; const float yk = y[k];
                lg[0] += yk * w0.x; lg[1] += yk * w0.y; lg[2] += yk * w0.z; lg[3] += yk * w0.w; lg[4] += yk * w1.x; lg[5] += yk * w1.y; lg[6] += yk * w1.z; lg[7] += yk * w1.w; } }
#pragma unroll
        for (int e = 0; e < 8; ++e) lg[e] = wave_sum(lg[e]);
        if (dry) continue;
        int e0 = 0; float v0 = lg[0];
#pragma unroll
        for (int e = 1; e < 8; ++e) if (lg[e] > v0) { v0 = lg[e]; e0 = e; }
        int e1 = -1; float v1 = -3.0e38f;
#pragma unroll
        for (int e = 0; e < 8; ++e) if (e != e0 && lg[e] > v1) { v1 = lg[e]; e1 = e; }
        const float w0 = 1.0f / (1.0f + __expf(v1 - v0)), w1 = 1.0f - w0;
        unsigned p0 = 0u, p1 = 0u;
        if (F.lane == 0) { p0 = __hip_atomic_fetch_add(ecnt + e0, 1u, RLX_AGENT); p1 = __hip_atomic_fetch_add(ecnt + e1, 1u, RLX_AGENT); }
        unsigned w8n[4];
#pragma unroll
        for (int j = 0; j < 4; ++j) w8n[j] = pg8::pk4_fp8(v[j].x, v[j].y, v[j].z, v[j].w);
#define ROUTE_FLUSH() do { if (F.lane == 0) { unsigned* r = route + (size_t)pm * 8; r[0] = (unsigned)pe0; r[1] = (unsigned)pe1; r[2] = pp0; r[3] = pp1; r[4] = __float_as_uint(pw0); r[5] = __float_as_uint(pw1); \
            float* rse = (float*)(F.ws + WS_RS_E); rse[(size_t)pe0 * M + pp0] = prs; rse[(size_t)pe1 * M + pp1] = prs; } \
        const unsigned q0_ = (unsigned)__builtin_amdgcn_readfirstlane((int)pp0), q1_ = (unsigned)__builtin_amdgcn_readfirstlane((int)pp1); \
        unsigned char* x0 = (unsigned char*)(F.ws + WS_XG8) + ((size_t)pe0 * M + q0_) * D, *x1 = (unsigned char*)(F.ws + WS_XG8) + ((size_t)pe1 * M + q1_) * D; \
        _Pragma("unroll") for (int j = 0; j < 4; ++j) { ((GAS unsigned*)(x0 + 256 * j))[F.lane] = pw8[j]; ((GAS unsigned*)(x1 + 256 * j))[F.lane] = pw8[j]; } } while (0)
        if (pend) ROUTE_FLUSH();
        pend = true; pm = m; pe0 = e0; pe1 = e1; pp0 = p0; pp1 = p1; pw0 = w0; pw1 = w1; prs = rstd;
#pragma unroll
        for (int j = 0; j < 4; ++j) pw8[j] = w8n[j];
    }
    if (pend) ROUTE_FLUSH();
#undef ROUTE_FLUSH
}
template <bool KS> struct MoeOrderT {
    static constexpr bool KSPLIT = KS;
    int cn[8]; int ncol, G, c, Ls; bool apm;
    __device__ __forceinline__ void init(const gu32* cnt, int ncol_, int G_, int c_, bool apm_) { ncol = ncol_; G = G_; c = c_; apm = apm_;
#pragma unroll
        for (int e = 0; e < 8; ++e) cn[e] = __builtin_amdgcn_readfirstlane((int)__hip_atomic_load(cnt + e, RLX_AGENT));
        if constexpr (KS) Ls = ksplit_first(cn, G); else Ls = 0; }
    static __device__ __forceinline__ int ksplit_first(const int (&cnt8)[8], int G) {
        int base = 0, ls = 0;
#pragma unroll
        for (int e = 0; e < 8; ++e) { const int n = (cnt8[e] + 255) >> 8;
#pragma unroll
            for (int p = 0; p < 4; ++p) { const int b = base + p * n; ls = b <= 2 * G ? b : ls; }
            base += 4 * n; }
        return base <= 2 * G ? base : ls;
    }
    __device__ __forceinline__ bool next_xcd(int i, pg8::Unit& u) const {
        int U = 0;
#pragma unroll
        for (int e = 0; e < 8; ++e) U += ((cn[e] + 255) >> 8) * ncol;
        const int cpx = G / pg8::NXCD, x = c / cpx, l = c - x * cpx, q = U / pg8::NXCD, r = U - q * pg8::NXCD;
        const int li = i * cpx + l, cntx = q + (x < r ? 1 : 0); if (li >= cntx) return false;
        const int L = (x < r ? x * (q + 1) : r * (q + 1) + (x - r) * q) + li;
        int base = 0, tiles = 0; bool found = false;
#pragma unroll
        for (int e = 0; e < 8; ++e) { const int n = (cn[e] + 255) >> 8; const int units = n * ncol;
            if (!found && L < base + units) { found = true; const int rr0 = L - base, g = rr0 / (8 * ncol), fm = 8 * g, gsz = (n - fm) < 8 ? (n - fm) : 8, rr = rr0 - g * 8 * ncol;
                u.pnl = rr / gsz; const int rt = fm + rr - u.pnl * gsz; u.pm = tiles + rt; u.pn = e * ncol + u.pnl; u.pa = apm ? e * (M / 256) + rt : u.pm; u.nv = cn[e] - 256 * rt; }
            base += units; tiles += n; }
        return found;
    }
    __device__ __forceinline__ bool next(int i, pg8::Unit& u) const {
        if constexpr (!KS) { if (G % pg8::NXCD == 0) return next_xcd(i, u); }
        int L = i * G + c, part = 0; bool sp = false; int base = 0, tiles = 0; bool found = false;
        if constexpr (KS) { if (L >= Ls) { const int q = L - Ls; L = Ls + (q >> 2); part = q & 3; sp = true; }
            u.part = part; u.k0 = sp ? part * 8 - (part == 3 ? 2 : 0) : 0; u.nk = sp ? (part < 2 ? 8 : 6) : EF / 128; }
#pragma unroll
        for (int e = 0; e < 8; ++e) { const int n = (cn[e] + 255) >> 8; const int units = n * ncol;
            if (!found && L < base + units) { found = true; const int r = L - base; u.pnl = r / n; const int rt = r - u.pnl * n; u.pm = tiles + rt; u.pn = e * ncol + u.pnl; u.pa = apm ? e * (M / 256) + rt : u.pm; u.nv = cn[e] - 256 * rt; }
            base += units; tiles += n; }
        return found;
    }
};
typedef MoeOrderT<false> MoeOrder; typedef MoeOrderT<true> MoeOrderKS;
static_assert(EF / 128 == 28 && D / 256 == 4, "the K-split parts are 8 + 8 + 6 + 6 K-tiles; four column tiles per expert");

__device__ __forceinline__ void p_moe_combine(Frame& F) {
    const unsigned* route = (const unsigned*)(F.ws + WS_ROUTE); const bf16* Y = (const bf16*)(F.ws + WS_Y2); float* out = F.out; const bf16* H3 = (const bf16*)(F.ws + WS_XN);
    const int gw = F.vcu * NWAVES + F.wave, NGW = F.G * NWAVES;
    int off[9]; off[0] = 0;
#pragma unroll
    for (int e = 0; e < 8; ++e) off[e + 1] = off[e] + (((int)__hip_atomic_load(F.ctl + CW_ECNT + e, RLX_AGENT) + 255) & ~255);
    int cn8[8];
#pragma unroll
    for (int e = 0; e < 8; ++e) cn8[e] = off[e + 1] - off[e];
    const int Ls = MoeOrderKS::ksplit_first(cn8, F.G);
    const bf16* Y1 = (const bf16*)(F.ws + WS_YP1); const bf16* Y2 = (const bf16*)(F.ws + WS_YP2); const bf16* Y3 = (const bf16*)(F.ws + WS_YP3);
    for (int m = gw; m < M; m += NGW) { const unsigned* r = route + (size_t)m * 8; const float w0 = __uint_as_float(r[4]), w1 = __uint_as_float(r[5]); const int e0 = (int)r[0], e1 = (int)r[1];
        int o0 = 0, o1 = 0;
#pragma unroll
        for (int e = 0; e < 8; ++e) { o0 = (e == e0) ? off[e] : o0; o1 = (e == e1) ? off[e] : o1; }
        const int s0 = o0 + (int)r[2], s1 = o1 + (int)r[3];
        int n0 = 0, n1 = 0;
#pragma unroll
        for (int e = 0; e < 8; ++e) { n0 = (e == e0) ? (off[e + 1] - off[e]) >> 8 : n0; n1 = (e == e1) ? (off[e + 1] - off[e]) >> 8 : n1; }
        const int l0 = (o0 >> 8) * 4 - Ls, l1 = (o1 >> 8) * 4 - Ls;
        GAS f32x4* o = (GAS f32x4*)(out + (size_t)m * D) + F.lane; const GAS unsigned long long* hr = (const GAS unsigned long long*)(H3 + (size_t)m * D) + F.lane;
        const GAS unsigned long long* y0 = (const GAS unsigned long long*)(Y + (size_t)s0 * D) + F.lane; const GAS unsigned long long* y1 = (const GAS unsigned long long*)(Y + (size_t)s1 * D) + F.lane;
#pragma unroll
        for (int j = 0; j < 4; ++j) { const unsigned long long hq = hr[64 * j]; f32x4 v = {bflo((unsigned)hq), bfhi((unsigned)hq), bflo((unsigned)(hq >> 32)), bfhi((unsigned)(hq >> 32))}; const unsigned long long a = y0[64 * j], b = y1[64 * j];
            f32x4 ya = {bflo((unsigned)a), bfhi((unsigned)a), bflo((unsigned)(a >> 32)), bfhi((unsigned)(a >> 32))}, yb = {bflo((unsigned)b), bfhi((unsigned)b), bflo((unsigned)(b >> 32)), bfhi((unsigned)(b >> 32))};
            if (l0 + j * n0 >= 0) {
#pragma unroll
                for (int p = 0; p < 3; ++p) { const unsigned long long q = ((const GAS unsigned long long*)((p == 0 ? Y1 : p == 1 ? Y2 : Y3) + (size_t)s0 * D) + F.lane)[64 * j];
                    ya += (f32x4){bflo((unsigned)q), bfhi((unsigned)q), bflo((unsigned)(q >> 32)), bfhi((unsigned)(q >> 32))}; } }
            if (l1 + j * n1 >= 0) {
#pragma unroll
                for (int p = 0; p < 3; ++p) { const unsigned long long q = ((const GAS unsigned long long*)((p == 0 ? Y1 : p == 1 ? Y2 : Y3) + (size_t)s1 * D) + F.lane)[64 * j];
                    yb += (f32x4){bflo((unsigned)q), bfhi((unsigned)q), bflo((unsigned)(q >> 32)), bfhi((unsigned)(q >> 32))}; } }
            v.x += w0 * ya[0] + w1 * yb[0]; v.y += w0 * ya[1] + w1 * yb[1]; v.z += w0 * ya[2] + w1 * yb[2]; v.w += w0 * ya[3] + w1 * yb[3];
            o[64 * j] = v; } }
}

__device__ __forceinline__ void p_compress_mfma(Frame& F, const float* kng0, const float* gq) {
    const bf16* KV = (const bf16*)(F.ws + WS_KV); const bf16* W1T = (const bf16*)(F.ws + WS_W1T); const bf16* W2T = (const bf16*)(F.ws + WS_W2T); const float* PB = (const float*)(F.ws + WS_PB);
    LAS unsigned short* TK = (LAS unsigned short*)(F.lds);
    LAS unsigned short* HD = TK + 528 * 72;
    const int tid = F.tid, lane = F.lane, w = F.wave, l31 = lane & 31, hi = lane >> 5;
    for (int unit = F.vcu; unit < 256; unit += F.G) {
        const int kvsel = unit >> 7, bg = (unit >> 4) & 7, rg = unit & 15, n0 = 32 * rg, b = bg >> 2, g = bg & 3;
        const int col0 = kvsel * 256 + g * 64;
        __syncthreads();
        {
            v4u tv[9];
#pragma unroll
            for (int q = 0; q < 9; ++q) { const int c = tid + q * NWAVES * 64, row = c >> 3, part = c & 7; int tok = 16 * n0 + row; tok = tok < T ? tok : T - 1;
                tv[q] = c < 528 * 8 ? *(const GAS v4u*)(KV + (size_t)(b * T + tok) * NKV + col0 + 8 * part) : (v4u){0u, 0u, 0u, 0u}; }
#pragma unroll
            for (int q = 0; q < 9; ++q) { const int c = tid + q * NWAVES * 64, row = c >> 3, part = c & 7;
                if (c < 528 * 8) *(LAS v4u*)(TK + ((row & 15) * 33 + (row >> 4)) * 72 + 8 * part) = tv[q]; }
        }
        __syncthreads();
        f32x16 acc = (f32x16){0.f,0.f,0.f,0.f,0.f,0.f,0.f,0.f,0.f,0.f,0.f,0.f,0.f,0.f,0.f,0.f};
        const bf16* bp = W1T + (size_t)kvsel * 256 * 2048 + ((size_t)w * 128 * 64 + lane) * 8;
        for (int k0 = 0; k0 < 128; k0 += 32) { bf16x8 bv[32];
#pragma unroll
            for (int i = 0; i < 32; ++i) bv[i] = ldg8(bp + (size_t)(k0 + i) * 512);
#pragma unroll
            for (int i = 0; i < 32; ++i) { const int ks = k0 + i, j = ks >> 2, d0 = 16 * (ks & 3) + 8 * hi;
                const bf16x8 av = *(const LAS bf16x8*)(TK + ((j & 15) * 33 + l31 + (j >> 4)) * 72 + d0);   acc = MFMA32(av, bv[i], acc); } }
        { const float pb = PB[kvsel * 256 + 32 * w + l31];
#pragma unroll
          for (int r = 0; r < 16; ++r) HD[((r & 3) + 8 * (r >> 2) + 4 * hi) * 264 + 32 * w + l31] = (unsigned short)f2bf(gelu_tanh(acc[r] + pb)); }
        __syncthreads();
        if (w == 0) {
            f32x16 c2[2]; c2[0] = (f32x16){0.f,0.f,0.f,0.f,0.f,0.f,0.f,0.f,0.f,0.f,0.f,0.f,0.f,0.f,0.f,0.f}; c2[1] = c2[0];
#pragma unroll
            for (int mt = 0; mt < 2; ++mt) { const bf16* ap = W2T + (size_t)(kvsel * 64 + 32 * mt + l31) * 256 + 8 * hi;
#pragma unroll
                for (int ks = 0; ks < 16; ++ks) { const bf16x8 av = ldg8(ap + 16 * ks), bv = *(const LAS bf16x8*)(HD + l31 * 264 + 16 * ks + 8 * hi); c2[mt] = MFMA32(av, bv, c2[mt]); } }
            const int n = n0 + l31; const bool ok = n < NCMP;
            if (kvsel == 0) { float ss = 0.f;
#pragma unroll
                for (int mt = 0; mt < 2; ++mt)
#pragma unroll
                    for (int r = 0; r < 16; ++r) ss += c2[mt][r] * c2[mt][r];
                ss += __shfl_xor(ss, 32);
                const float rstd = ok ? 1.0f / sqrtf(ss * (1.f / 64.f) + NORM_EPS) : 0.f;
                bf16* kp = (bf16*)(F.ws + WS_KC16) + (size_t)(bg * NCMPP + n) * 64 + 4 * hi;
#pragma unroll
                for (int mt = 0; mt < 2; ++mt)
#pragma unroll
                    for (int q4 = 0; q4 < 4; ++q4) { const f32x4 gg = *(const GAS f32x4*)(kng0 + 32 * mt + 8 * q4 + 4 * hi) * *(const GAS f32x4*)(gq + 32 * mt + 8 * q4 + 4 * hi);
                        *(GAS unsigned long long*)(kp + 32 * mt + 8 * q4) = (unsigned long long)cvtpk(c2[mt][4 * q4] * rstd * gg.x, c2[mt][4 * q4 + 1] * rstd * gg.y) | ((unsigned long long)cvtpk(c2[mt][4 * q4 + 2] * rstd * gg.z, c2[mt][4 * q4 + 3] * rstd * gg.w) << 32); }
            } else { bf16* vp = (bf16*)(F.ws + WS_VTC) + (size_t)(bg * 64 + 4 * hi) * NCMPP + (n & ~15) + perm16(n & 15);
#pragma unroll
                for (int mt = 0; mt < 2; ++mt)
#pragma unroll
                    for (int r = 0; r < 16; ++r) vp[(size_t)(32 * mt + (r & 3) + 8 * (r >> 2)) * NCMPP] = (bf16)f2bf(ok ? c2[mt][r] : 0.f); }
        }
    }
}
__device__ __forceinline__ void p_qnorm(Frame& F, const float* gq) {
    const bf16* QG = (const bf16*)(F.ws + WS_QG); bf16* QN = (bf16*)(F.ws + WS_QN);
    const int gt = F.vcu * (NWAVES * 64) + F.tid, NT = F.G * NWAVES * 64;
    for (int idx = gt; idx < M * NH; idx += NT) { const int m = idx >> 4, h = idx & 15;
        const GAS v4u* p = (const GAS v4u*)(QG + (size_t)m * NQINP + h * 64); GAS v4u* o = (GAS v4u*)(QN + (size_t)m * D + h * 64);
        v4u w[8]; float ss = 0.f;
#pragma unroll
        for (int i = 0; i < 8; ++i) { w[i] = p[i];
#pragma unroll
            for (int k = 0; k < 4; ++k) { const float x0 = bflo(w[i][k]), x1 = bfhi(w[i][k]); ss += x0 * x0 + x1 * x1; } }
        const float rs = (0.125f * LOG2E) * __builtin_amdgcn_rsqf(ss * (1.f / 64.f) + NORM_EPS);
#pragma unroll
        for (int i = 0; i < 8; ++i) { v4u r;
#pragma unroll
            for (int k = 0; k < 4; ++k) r[k] = cvtpk(bflo(w[i][k]) * rs * gq[8 * i + 2 * k], bfhi(w[i][k]) * rs * gq[8 * i + 2 * k + 1]);
            o[i] = r; } }
}
__device__ __forceinline__ void p_vtrans(Frame& F) {
    const bf16* KV = (const bf16*)(F.ws + WS_KV);
    LAS unsigned short* scr = (LAS unsigned short*)(F.lds + F.wave * 8192);
    const int gw = F.vcu * NWAVES + F.wave, NGW = F.G * NWAVES, lane = F.lane;
    for (int item = gw; item < 2 * 8 * (T / 64); item += NGW) {
        const int which = item >> 10, bg = (item >> 7) & 7, tile = item & 127, b = bg >> 2, g = bg & 3;
        const GAS v4u* p = (const GAS v4u*)(KV + (size_t)(b * T + 64 * tile + lane) * NKV + (which ? 1280 : 768) + 64 * g);
        const int posn = (lane & ~15) + perm16(lane & 15);
#pragma unroll
        for (int i = 0; i < 8; ++i) { const v4u w = p[i];
#pragma unroll
            for (int k = 0; k < 4; ++k) { scr[(8 * i + 2 * k) * 64 + posn] = (unsigned short)(w[k] & 0xffffu); scr[(8 * i + 2 * k + 1) * 64 + posn] = (unsigned short)(w[k] >> 16); } }
        LDS_WAIT(); asm volatile("" ::: "memory");
        bf16* VT = (bf16*)(F.ws + (which ? WS_VTW : WS_VTS));
        GAS v4u* o = (GAS v4u*)(VT + (size_t)(bg * 64 + lane) * T + 64 * tile); const LAS v4u* s = (const LAS v4u*)(scr + lane * 64);
#pragma unroll
        for (int i = 0; i < 8; ++i) o[i] = s[i];
        if (which == 0) { v4u* VF = (v4u*)(F.ws + WS_VF);
#pragma unroll
            for (int i = 0; i < 8; ++i) { v4u sv = s[i]; sv.x += 0x05000500u; sv.y += 0x05000500u; sv.z += 0x05000500u; sv.w += 0x05000500u;
                VF[(size_t)(((((bg * 128 + tile) * 2 + (i >> 2)) * 2 + (lane >> 5)) * 2 + ((i >> 1) & 1)) * 64) + (i & 1) * 32 + (lane & 31)] = sv; } }
        LDS_WAIT(); asm volatile("" ::: "memory");
    }
}

__device__ __forceinline__ void p_biaslut(Frame& F, const float* relb) {
    float* BLG = (float*)(F.ws + WS_BLG);
    const int gt = F.vcu * (NWAVES * 64) + F.tid, NT = F.G * NWAVES * 64;
    for (int idx = gt; idx < NH * 2048; idx += NT) { const int h = idx >> 11, d = idx & 2047; BLG[idx] = relb[rel_bucket(d) * NH + h] * LOG2E; }
}

template <int MASK, int DS> __device__ __forceinline__ float st_softmax(f32x16& st, int dbase, const LAS float* blp, float scale) {
    float l = 0.f; asm volatile("" : "+v"(dbase));
#pragma unroll
    for (int r = 0; r < 16; ++r) { const int d = dbase - DS * ((r & 3) + 8 * (r >> 2)); int di = d < 0 ? 0 : d; di = di > 2047 ? 2047 : di;
        float e = __builtin_amdgcn_exp2f(st[r] + blp[di]) * scale;
        if (MASK == 1) e = d >= 0 ? e : 0.f;
        if (MASK == 2) e = (d >= 0 && d < WIN) ? e : 0.f;
        st[r] = e; l += e; }
    return l;
}
template <int DS> __device__ __forceinline__ float st_softmax_in(f32x16& st, int dbase, const LAS float* blp, float scale) {
    float l = 0.f; const LAS float* bp = blp + (dbase - 27 * DS); asm volatile("" : "+v"(bp));
#pragma unroll
    for (int r = 0; r < 16; ++r) { const float e = __builtin_amdgcn_exp2f(st[r] + bp[(27 - ((r & 3) + 8 * (r >> 2))) * DS]) * scale; st[r] = e; l += e; }
    return l;
}
constexpr float OFIX = 1024.0f, LFIX = 256.0f;
#ifndef REP_SUB
#define REP_SUB 0
#endif
#define SUBREP(k) for (int rep_ = 0; rep_ < (REP_SUB == (k) ? 2 : 1); ++rep_) if (const float rs_ = rep_ ? 0.f : 1.f; true)
__device__ __forceinline__ float st_softmax_far(f32x16& st, float cb, float scale) {
    float l = 0.f;
#pragma unroll
    for (int r = 0; r < 16; ++r) { const float e = __builtin_amdgcn_exp2f(st[r] + cb) * scale; st[r] = e; l += e; }
    return l;
}
template <int DS> __device__ __forceinline__ void st_bias(f32x16& st, int dbase, const LAS float* blp) {
    asm volatile("" : "+v"(dbase));
#pragma unroll
    for (int r = 0; r < 16; ++r) { const int d = dbase - DS * ((r & 3) + 8 * (r >> 2)); int di = d < 0 ? 0 : d; di = di > 2047 ? 2047 : di; st[r] = blp[di]; }
}
template <int DS> __device__ __forceinline__ void st_bias_in(f32x16& st, int dbase, const LAS float* blp) {
    const LAS float* bp = blp + (dbase - 27 * DS); asm volatile("" : "+v"(bp));
#pragma unroll
    for (int r = 0; r < 16; ++r) st[r] = bp[(27 - ((r & 3) + 8 * (r >> 2))) * DS];
}
__device__ __forceinline__ void st_bias_far(f32x16& st, float cb) {
#pragma unroll
    for (int r = 0; r < 16; ++r) st[r] = cb;
}
template <int MASK, int DS> __device__ __forceinline__ float st_exp(f32x16& st, int dbase) {
    float l = 0.f; if (MASK) asm volatile("" : "+v"(dbase));
#pragma unroll
    for (int r = 0; r < 16; ++r) { float e = __builtin_amdgcn_exp2f(st[r]);
        if (MASK) { const int d = dbase - DS * ((r & 3) + 8 * (r >> 2)); if (MASK == 1) e = d >= 0 ? e : 0.f; if (MASK == 2) e = (d >= 0 && d < WIN) ? e : 0.f; }
        st[r] = e; l += e; }
    return l;
}
#define NSA_QKB(st, kf, qf) do { _Pragma("unroll") for (int _k = 0; _k < 4; ++_k) st = MFMA32(kf[_k], qf[_k], st); } while (0)
#define DENSE_STK(buf) (*(LAS v4u*)(KT + (buf) * 4608 + (tio >> 3) * 72 + 8 * (tio & 7)) = kreg)
#define DENSE_STV(buf) (*(LAS v4u*)(VTT + (buf) * 4608 + (tio >> 3) * 72 + 8 * (tio & 7)) = vreg)
#define DENSE_LDK(kf, buf, sub) do { _Pragma("unroll") for (int _k = 0; _k < 4; ++_k) kf[_k] = *(const LAS bf16x8*)(KT + (buf) * 4608 + (32 * (sub) + (lane & 31)) * 72 + 16 * _k + 8 * hi); } while (0)
#define DENSE_LDV(vf, buf, sub) do { _Pragma("unroll") for (int _m = 0; _m < 2; ++_m) _Pragma("unroll") for (int _s = 0; _s < 2; ++_s) vf[_m][_s] = *(const LAS bf16x8*)(VTT + (buf) * 4608 + (32 * _m + (lane & 31)) * 72 + 32 * (sub) + 16 * _s + 8 * hi); } while (0)
__device__ __forceinline__ float q8_ss(const v4u w) { float ss = 0.f;
#pragma unroll
    for (int e = 0; e < 4; ++e) { const float x0 = bflo(w[e]), x1 = bfhi(w[e]); ss += x0 * x0 + x1 * x1; }
    return ss; }
__device__ __forceinline__ v4u q8_scale(const v4u w, float rs) { v4u r;
#pragma unroll
    for (int e = 0; e < 4; ++e) r[e] = cvtpk(bflo(w[e]) * rs, bfhi(w[e]) * rs);
    return r; }
#define NSA_LDK(kf, base) do { _Pragma("unroll") for (int _k = 0; _k < 4; ++_k) kf[_k] = ldg8((base) + 16 * _k); } while (0)
#define NSA_QK(st, kf, qf) do { st = (f32x16){0.f,0.f,0.f,0.f,0.f,0.f,0.f,0.f,0.f,0.f,0.f,0.f,0.f,0.f,0.f,0.f}; _Pragma("unroll") for (int _k = 0; _k < 4; ++_k) st = MFMA32(kf[_k], qf[_k], st); } while (0)

__device__ __forceinline__ void p_nsa(Frame& F, const Args& a) {
    const bf16* QN = (const bf16*)(F.ws + WS_QN); const bf16* QG = (const bf16*)(F.ws + WS_QG); const bf16* KV = (const bf16*)(F.ws + WS_KV);
    const bf16* KC = (const bf16*)(F.ws + WS_KC16); const bf16* VTC = (const bf16*)(F.ws + WS_VTC); const bf16* VTS = (const bf16*)(F.ws + WS_VTS); const bf16* VTW = (const bf16*)(F.ws + WS_VTW);
    const float* BLG = (const float*)(F.ws + WS_BLG); bf16* OATT = (bf16*)(F.ws + WS_OATT); float* OPARK = (float*)(F.ws + WS_OACC);
    LAS float* BL = (LAS float*)(F.lds);
    LAS int* OACC = (LAS int*)(BL + 4 * 2056);
    LAS float* IMPL = (LAS float*)OACC;
    LAS int* LACC = OACC + 16384;
    LAS unsigned* SELM = (LAS unsigned*)(LACC + 256);
    LAS unsigned long long* BM = (LAS unsigned long long*)(SELM + 256);
    LAS unsigned short* KT = (LAS unsigned short*)(BM + 128);
    LAS unsigned short* VTT = KT + 2 * 4608;
    LAS unsigned* BCTR = (LAS unsigned*)(F.lds + MISC_OFF + 64);
    LAS unsigned short* QL = KT;
    LAS float* GATE = (LAS float*)(VTT + 2 * 4608);
    const v4u* KF = (const v4u*)(F.ws + WS_KF); const v4u* VF = (const v4u*)(F.ws + WS_VF);
    static_assert(4 * 2056 * 4 + 16384 * 4 + 1024 + 1024 + 1024 + 4 * 4608 * 2 + 256 * 3 * 4 <= LDSCTL_OFF, "attention LDS map");
    const int tid = F.tid, lane = F.lane, w = F.wave;
    const int col = lane & 31, hi = lane >> 5, hp = col & 3, ti = w * 8 + (col >> 2);
    const LAS float* blp = BL + hp * 2056;
    int last_g = -1;
    for (int it = 0;; ++it) {
        int bg, tt;
        if (F.G == 256) { if (it >= 4) break; const int j = F.vcu & 31; bg = F.vcu >> 5; tt = it == 0 ? j : (it == 1 ? 127 - j : (it == 2 ? 32 + j : 95 - j)); }
        else { const int id = F.vcu + F.G * it; if (id >= BATCH * NG * (T / 64)) break; bg = id >> 7; tt = (it & 1) ? 127 - (id & 127) : (id & 127); }
        const int b = bg >> 2, g = bg & 3;
        const int t0 = tt * 64, cur = tt, t_l = t0 + ti, h = 4 * g + hp;
        const size_t mrow = (size_t)b * T + t_l;
        __syncthreads();
        if (g != last_g) { int tio = tid; asm volatile("" : "+v"(tio)); for (int i = tio; i < 4 * 2048; i += NWAVES * 64) BL[(i >> 11) * 2056 + (i & 2047)] = BLG[(size_t)(4 * g) * 2048 + i]; }
        last_g = g;
        for (int i = tid; i < 64 * 132 / 4; i += NWAVES * 64) ((LAS v4u*)IMPL)[i] = (v4u){0u, 0u, 0u, 0u};
        __syncthreads();
        bf16x8 qf[4];
#pragma unroll
        for (int k = 0; k < 4; ++k) qf[k] = ldg8(QG + mrow * NQINP + h * 64 + 16 * k + 8 * hi);
        {
            float ss = 0.f;
#pragma unroll
            for (int k = 0; k < 4; ++k) ss += q8_ss(__builtin_bit_cast(v4u, qf[k]));
            ss += __shfl_xor(ss, 32);
            const float rs = (0.125f * LOG2E) * __builtin_amdgcn_rsqf(ss * (1.f / 64.f) + NORM_EPS);
#pragma unroll
            for (int k = 0; k < 4; ++k) qf[k] = __builtin_bit_cast(bf16x8, q8_scale(__builtin_bit_cast(v4u, qf[k]), rs));
        }
        if (hi == 0) { const bf16* gq_ = QG + mrow * NQINP + D + h * 3; const unsigned short g0_ = gq_[0], g1_ = gq_[1], g2_ = gq_[2]; LAS float* gd_ = GATE + (ti * 4 + hp) * 3;
            gd_[0] = sigmoid_f(bf2f(g0_)); gd_[1] = sigmoid_f(bf2f(g1_)); gd_[2] = sigmoid_f(bf2f(g2_)); }
        f32x16 ofin[2];
        const float cbias = blp[2047];
        SUBREP(1) {
            const int ncv_max = ((t0 + 63 - 31) >> 4) + 1; int n_kt = (ncv_max >> 5) + 1; n_kt = n_kt > 16 ? 16 : n_kt; const int n64 = (n_kt + 1) >> 1;
            int tio = tid; asm volatile("" : "+v"(tio));
            const bf16* kcs = KC + (size_t)bg * NCMPP * 64 + (size_t)(tio >> 3) * 64 + 8 * (tio & 7); const bf16* vcs = VTC + (size_t)bg * 64 * NCMPP + (size_t)(tio >> 3) * NCMPP + 8 * (tio & 7);
            float l = 0.f; v4u kreg, vreg;
            f32x16 oc[2]; oc[0] = (f32x16){0.f,0.f,0.f,0.f,0.f,0.f,0.f,0.f,0.f,0.f,0.f,0.f,0.f,0.f,0.f,0.f}; oc[1] = oc[0];
            unsigned av[16][2];
#pragma unroll
            for (int kt = 0; kt < 16; ++kt) { av[kt][0] = 0u; av[kt][1] = 0u; }
            float prevx3 = 0.f;
            kreg = *(const GAS v4u*)kcs; vreg = *(const GAS v4u*)vcs; DENSE_STK(0); DENSE_STV(0); __syncthreads();
#pragma unroll
            for (int i = 0; i < 8; ++i) { if (i < n64) { if (i + 1 < n64) { kreg = *(const GAS v4u*)(kcs + (size_t)(i + 1) * 64 * 64); vreg = *(const GAS v4u*)(vcs + (i + 1) * 64); }
#pragma unroll
                for (int sub = 0; sub < 2; ++sub) { const int kt = 2 * i + sub; if (kt < n_kt) { bf16x8 kf[4]; DENSE_LDK(kf, i & 1, sub); bf16x8 vf[2][2]; DENSE_LDV(vf, i & 1, sub);
                    f32x16 st; const int dbc_ = t_l - 31 - 512 * kt - 64 * hi; const bool cfar_ = t0 - 512 * kt - 527 >= 2047, cin_ = t0 - 512 * kt - 527 >= 0 && t0 + 32 - 512 * kt <= 2047;
                    if (cfar_) st_bias_far(st, cbias); else if (cin_) st_bias_in<16>(st, dbc_, blp); else st_bias<16>(st, dbc_, blp);
                    NSA_QKB(st, kf, qf);
                    if (cfar_ || cin_) l += st_exp<0, 16>(st, 0); else l += st_exp<1, 16>(st, dbc_);
                    float xq[4], aq[4];
#pragma unroll
                    for (int q = 0; q < 4; ++q) { const float cr = 0.5f * st[4 * q + 3]; aq[q] = st[4 * q] + st[4 * q + 1] + st[4 * q + 2] + cr; xq[q] = __shfl_xor(cr, 32); }
#pragma unroll
                    for (int q = 0; q < 4; ++q) aq[q] += hi ? xq[q] : (q == 0 ? prevx3 : xq[q > 0 ? q - 1 : 0]);
                    prevx3 = xq[3]; av[kt][0] = cvtpk(aq[0], aq[1]); av[kt][1] = cvtpk(aq[2], aq[3]);
                    const bf16x8 pb0 = pack8(st, 0), pb1 = pack8(st, 1);
#pragma unroll
                    for (int mt = 0; mt < 2; ++mt) { oc[mt] = MFMA32(vf[mt][0], pb0, oc[mt]); oc[mt] = MFMA32(vf[mt][1], pb1, oc[mt]); } } }
                if (i + 1 < n64) { DENSE_STK((i + 1) & 1); DENSE_STV((i + 1) & 1); }
                __syncthreads(); } }
            l += __shfl_xor(l, 32);
            const float gate = GATE[(ti * 4 + hp) * 3 + 0];
            const float inv = l > 0.f ? 1.0f / l : 0.f;
#pragma unroll
            for (int kt = 0; kt < 16; ++kt) { if (kt < n_kt) {
#pragma unroll
                for (int q = 0; q < 4; ++q) { float v = ((q & 1) ? bfhi(av[kt][q >> 1]) : bflo(av[kt][q >> 1])) * inv; v += __shfl_xor(v, 1); v += __shfl_xor(v, 2); if (hp == 0) IMPL[ti * 132 + 8 * kt + 2 * q + hi] = v; } } }
            const float og = gate * inv;
#pragma unroll
            for (int mt = 0; mt < 2; ++mt)
#pragma unroll
                for (int r = 0; r < 16; ++r) ofin[mt][r] = oc[mt][r] * og;
        }
        __syncthreads();
        v4u pf_wk, pf_wv, pf_dk, pf_dv, pf_q[4];
        { int tio = tid; asm volatile("" : "+v"(tio)); const int kt_lo_ = t0 >= 512 ? 0 : (512 - t0) >> 6, keyw = t0 - 512 + 64 * kt_lo_;
          pf_wk = *(const GAS v4u*)(KV + (size_t)b * T * NKV + 1024 + 64 * g + (size_t)(tio >> 3) * NKV + 8 * (tio & 7) + (size_t)keyw * NKV); pf_wv = *(const GAS v4u*)(VTW + (size_t)bg * 64 * T + (size_t)(tio >> 3) * T + 8 * (tio & 7) + keyw); }
        SUBREP(2) {
            int tk = tid >> 3, j = tid & 7; asm volatile("" : "+v"(tk), "+v"(j)); float v[16];
#pragma unroll
            for (int k = 0; k < 16; ++k) { const int s = 16 * j + k; v[k] = (s >= 1 && s <= cur - 2) ? IMPL[tk * 132 + s] : -1.0f; }
            unsigned msk = 0u;
#pragma unroll
            for (int k = 0; k < 16; ++k) { const int s = 16 * j + k; if (s <= cur && (s == 0 || s >= cur - 1)) msk |= 1u << k; }
            const int ncand = cur - 2 > 0 ? cur - 2 : 0; const int n_need = ncand < NTOP - 3 ? ncand : NTOP - 3;
            for (int itn = 0; itn < n_need; ++itn) {
                float bm = fmaxf(fmaxf(fmaxf(v[0], v[1]), fmaxf(v[2], v[3])), fmaxf(fmaxf(v[4], v[5]), fmaxf(v[6], v[7])));
                bm = fmaxf(bm, fmaxf(fmaxf(fmaxf(v[8], v[9]), fmaxf(v[10], v[11])), fmaxf(fmaxf(v[12], v[13]), fmaxf(v[14], v[15]))));
#define DPP_I(x, ctl) __builtin_amdgcn_update_dpp(0, (x), (ctl), 0xF, 0xF, true)
#define DPP_F(x, ctl) __builtin_bit_cast(float, __builtin_amdgcn_update_dpp(0, __builtin_bit_cast(int, (x)), (ctl), 0xF, 0xF, true))
                float gm = bm; gm = fmaxf(gm, DPP_F(gm, 0xB1)); gm = fmaxf(gm, DPP_F(gm, 0x4E)); gm = fmaxf(gm, DPP_F(gm, 0x141));
                unsigned eq = 0u;
#pragma unroll
                for (int k = 0; k < 16; ++k) eq |= (v[k] == gm) ? (1u << k) : 0u;
                int cand = eq ? 16 * j + (__ffs(eq) - 1) : 9999; int o1 = DPP_I(cand, 0xB1); cand = o1 < cand ? o1 : cand; o1 = DPP_I(cand, 0x4E); cand = o1 < cand ? o1 : cand; o1 = DPP_I(cand, 0x141); cand = o1 < cand ? o1 : cand;
#undef DPP_I
#undef DPP_F
                const unsigned hit = (unsigned)(cand - 16 * j) < 16u ? (1u << (cand - 16 * j)) : 0u; msk |= hit;
#pragma unroll
                for (int k = 0; k < 16; ++k) v[k] = (hit >> k) & 1u ? -1.0f : v[k];
            }
            ((LAS unsigned short*)SELM)[tk * 8 + j] = (unsigned short)msk;
        }
        __syncthreads();
        if (tid == 0) *BCTR = 0u;
        for (int i = tid; i < (16384 + 256) / 4; i += NWAVES * 64) ((LAS v4u*)OACC)[i] = (v4u){0u, 0u, 0u, 0u};
        {
            const unsigned wsel = SELM[lane * 4 + (w >> 1)]; const unsigned part = (w & 1) ? (wsel >> 16) : (wsel & 0xffffu);
#pragma unroll
            for (int k = 0; k < 16; ++k) { const unsigned long long bal = __ballot((part >> k) & 1u); if (lane == 0) BM[16 * w + k] = bal; }
        }
        __syncthreads();
        SUBREP(5) {
            int tio = tid; asm volatile("" : "+v"(tio));
            const bf16* ks_ = KV + (size_t)b * T * NKV + 1024 + 64 * g + (size_t)(tio >> 3) * NKV + 8 * (tio & 7);
            const bf16* vs_ = VTW + (size_t)bg * 64 * T + (size_t)(tio >> 3) * T + 8 * (tio & 7);
            f32x16 ow[2]; ow[0] = (f32x16){0.f,0.f,0.f,0.f,0.f,0.f,0.f,0.f,0.f,0.f,0.f,0.f,0.f,0.f,0.f,0.f}; ow[1] = ow[0]; float lw = 0.f;
            const int kt_lo = t0 >= 512 ? 0 : (512 - t0) >> 6; v4u kreg, vreg, kr2, vr2;
            kreg = pf_wk; vreg = pf_wv;
            { const int keyd = 64 * cur;
              pf_dk = *(const GAS v4u*)(KV + (size_t)b * T * NKV + 512 + 64 * g + (size_t)(tio >> 3) * NKV + 8 * (tio & 7) + (size_t)keyd * NKV); pf_dv = *(const GAS v4u*)(VTS + (size_t)bg * 64 * T + (size_t)(tio >> 3) * T + 8 * (tio & 7) + keyd); }
            DENSE_STK(0); DENSE_STV(0);
            if (kt_lo + 1 < 9) { const int key1 = t0 - 512 + 64 * (kt_lo + 1); kreg = *(const GAS v4u*)(ks_ + (size_t)key1 * NKV); vreg = *(const GAS v4u*)(vs_ + key1); }
            __syncthreads();
            for (int kt = kt_lo; kt < 9; ++kt) { const int buf = (kt - kt_lo) & 1;
                if (kt + 2 < 9) { const int key2 = t0 - 512 + 64 * (kt + 2); kr2 = *(const GAS v4u*)(ks_ + (size_t)key2 * NKV); vr2 = *(const GAS v4u*)(vs_ + key2); }
#pragma unroll
                for (int sub = 0; sub < 2; ++sub) { const int key0 = t0 - 512 + 64 * kt + 32 * sub; bf16x8 kf[4]; DENSE_LDK(kf, buf, sub); bf16x8 vf[2][2]; DENSE_LDV(vf, buf, sub);
                    f32x16 st; const int dbw_ = t_l - key0 - 4 * hi; const bool win_ = kt >= 1 && kt <= 7;
                    if (win_) st_bias_in<1>(st, dbw_, blp); else st_bias<1>(st, dbw_, blp);
                    NSA_QKB(st, kf, qf);
                    if (win_) lw += st_exp<0, 1>(st, 0); else lw += st_exp<2, 1>(st, dbw_);
                    const bf16x8 pb0 = pack8(st, 0), pb1 = pack8(st, 1);
#pragma unroll
                    for (int mt = 0; mt < 2; ++mt) { ow[mt] = MFMA32(vf[mt][0], pb0, ow[mt]); ow[mt] = MFMA32(vf[mt][1], pb1, ow[mt]); } }
                if (kt + 1 < 9) { DENSE_STK(buf ^ 1); DENSE_STV(buf ^ 1); }
                if (kt + 2 < 9) { kreg = kr2; vreg = vr2; }
                __syncthreads(); }
            lw += __shfl_xor(lw, 32);
            const float gw = GATE[(ti * 4 + hp) * 3 + 2] / lw * rs_;
#pragma unroll
            for (int mt = 0; mt < 2; ++mt)
#pragma unroll
                for (int r = 0; r < 16; ++r) ofin[mt][r] += ow[mt][r] * gw;
            bf16* pk = (bf16*)OPARK + mrow * D + h * 64;
#pragma unroll
            for (int mt = 0; mt < 2; ++mt)
#pragma unroll
                for (int q = 0; q < 4; ++q) *(GAS unsigned long long*)(pk + 32 * mt + 8 * q + 4 * hi) = (unsigned long long)cvtpk(ofin[mt][4 * q], ofin[mt][4 * q + 1]) | ((unsigned long long)cvtpk(ofin[mt][4 * q + 2], ofin[mt][4 * q + 3]) << 32);
        }
        {
            const bf16* kbase = KV + (size_t)b * T * NKV + 512 + 64 * g + (size_t)(lane & 31) * NKV + 8 * hi;
            const bf16* vbase = VTS + (size_t)bg * 64 * T + (size_t)(lane & 31) * T + 8 * hi;
            SUBREP(3) {
            int tio = tid; asm volatile("" : "+v"(tio));
            const bf16* ks_ = KV + (size_t)b * T * NKV + 512 + 64 * g + (size_t)(tio >> 3) * NKV + 8 * (tio & 7);
            const bf16* vs_ = VTS + (size_t)bg * 64 * T + (size_t)(tio >> 3) * T + 8 * (tio & 7);
            f32x16 os[2]; os[0] = (f32x16){0.f,0.f,0.f,0.f,0.f,0.f,0.f,0.f,0.f,0.f,0.f,0.f,0.f,0.f,0.f,0.f}; os[1] = os[0]; float ls = 0.f;
            const int nfb = cur >= 2 ? 3 : cur + 1; v4u kreg, vreg;
            kreg = pf_dk; vreg = pf_dv;
#pragma unroll
            for (int c = 0; c < 4; ++c) { const int ch = tio + 512 * c, row = ch >> 3, part = ch & 7; pf_q[c] = *(const GAS v4u*)(QG + ((size_t)b * T + t0 + (row >> 2)) * NQINP + (4 * g + (row & 3)) * 64 + 8 * part); }
            DENSE_STK(0); DENSE_STV(0); __syncthreads();
            for (int fi = 0; fi < nfb; ++fi) { const int fb = fi == 0 ? cur : (fi == 1 ? cur - 1 : 0);
                if (fi + 1 < nfb) { const int key1 = 64 * (fi == 0 ? cur - 1 : 0); kreg = *(const GAS v4u*)(ks_ + (size_t)key1 * NKV); vreg = *(const GAS v4u*)(vs_ + key1); }
#pragma unroll
                for (int sub = 0; sub < 2; ++sub) { const int key0 = 64 * fb + 32 * sub; bf16x8 kf[4]; DENSE_LDK(kf, fi & 1, sub); bf16x8 vf[2][2]; DENSE_LDV(vf, fi & 1, sub);
                    f32x16 st; const int dbf_ = t_l - key0 - 4 * hi;
                    const bool ffar_ = fi == 2 && t0 - 63 >= 2047, fin_ = fi == 1 || (fi == 2 && t0 + 63 <= 2047);
                    if (ffar_) st_bias_far(st, cbias); else if (fin_) st_bias_in<1>(st, dbf_, blp); else st_bias<1>(st, dbf_, blp);
                    NSA_QKB(st, kf, qf);
                    if (ffar_ || fin_) ls += st_exp<0, 1>(st, 0); else ls += st_exp<1, 1>(st, dbf_);
                    const bf16x8 pb0 = pack8(st, 0), pb1 = pack8(st, 1);
#pragma unroll
                    for (int mt = 0; mt < 2; ++mt) { os[mt] = MFMA32(vf[mt][0], pb0, os[mt]); os[mt] = MFMA32(vf[mt][1], pb1, os[mt]); } }
                if (fi + 1 < nfb) { DENSE_STK((fi + 1) & 1); DENSE_STV((fi + 1) & 1); }
                __syncthreads(); }
            {   int rowi = ti * 4 + hp; asm volatile("" : "+v"(rowi)); LAS int* orow = OACC + rowi * 64; const int swz = rowi & 31;
#pragma unroll
                for (int mt = 0; mt < 2; ++mt)
#pragma unroll
                    for (int r = 0; r < 16; ++r) { const int dim = 32 * mt + (r & 3) + 8 * (r >> 2) + 4 * hi; __hip_atomic_fetch_add(orow + (dim ^ swz), __float2int_rn(os[mt][r] * rs_ * OFIX), __ATOMIC_RELAXED, __HIP_MEMORY_SCOPE_WORKGROUP); }
                __hip_atomic_fetch_add(LACC + rowi, __float2int_rn(ls * rs_ * LFIX), __ATOMIC_RELAXED, __HIP_MEMORY_SCOPE_WORKGROUP); }
            }
            { int tio = tid; asm volatile("" : "+v"(tio));
#pragma unroll
              for (int c = 0; c < 4; ++c) { const int ch = tio + 512 * c, row = ch >> 3, part = ch & 7;
                  float ss = q8_ss(pf_q[c]); ss += __shfl_xor(ss, 1); ss += __shfl_xor(ss, 2); ss += __shfl_xor(ss, 4);
                  const float rs = (0.125f * LOG2E) * __builtin_amdgcn_rsqf(ss * (1.f / 64.f) + NORM_EPS);
                  *(LAS v4u*)(QL + row * 72 + 8 * part) = q8_scale(pf_q[c], rs); } }
            __syncthreads();
            for (int rep_ = 0; rep_ < ((REP_SUB == 4 || REP_SUB == 6) ? 2 : 1); ++rep_) if (const float rs_ = rep_ ? 0.f : 1.f; true) {
#define NSA_NEXTBLK(sv) do { for (;;) { unsigned t_ = 0u; if (lane == 0) t_ = __hip_atomic_fetch_add(BCTR, 1u, __ATOMIC_RELAXED, __HIP_MEMORY_SCOPE_WORKGROUP); sv = 1 + __builtin_amdgcn_readfirstlane((int)t_); if (sv > cur - 2) break; \
        const unsigned long long m_ = BM[sv]; if (__builtin_amdgcn_readfirstlane((unsigned)m_) | __builtin_amdgcn_readfirstlane((unsigned)(m_ >> 32))) break; } } while (0)
#define NSA_LDK8(dst, sv) do { const size_t fb_ = ((size_t)(bg * 128 + (sv)) * 8) * 64 + lane; _Pragma("unroll") for (int k_ = 0; k_ < 8; ++k_) dst[k_] = KF[fb_ + (size_t)k_ * 64]; } while (0)
#define NSA_LDV8(dst, sv) do { const size_t fb_ = ((size_t)(bg * 128 + (sv)) * 8) * 64 + lane; _Pragma("unroll") for (int k_ = 0; k_ < 8; ++k_) dst[8 + k_] = VF[fb_ + (size_t)k_ * 64]; } while (0)
            v4u kv_[16];
            int s; NSA_NEXTBLK(s);
            while (s <= cur - 2) {
                NSA_LDK8(kv_, s); NSA_LDV8(kv_, s);
                const bool far_ = (t0 - 64 * s - 63) >= 2047, in_ = (t0 + 63 - 64 * s) <= 2047;
                unsigned long long mk = BM[s]; unsigned mlo = __builtin_amdgcn_readfirstlane((unsigned)mk), mhi = __builtin_amdgcn_readfirstlane((unsigned)(mk >> 32));
                mk = ((unsigned long long)mhi << 32) | mlo;
                while (mk) {
                    int mytok = -1;
#pragma unroll
                    for (int k = 0; k < 8; ++k) { int tkk = -1; if (mk) { tkk = __builtin_ctzll(mk); mk &= mk - 1; } mytok = ((col >> 2) == k) ? tkk : mytok; }
                    const bool valid = mytok >= 0; const int tq = valid ? mytok : 0; const int tq_abs = t0 + tq;
                    bf16x8 q2[4];
                    { const LAS unsigned short* qp = QL + (tq * 4 + hp) * 72 + 8 * hi;
#pragma unroll
                      for (int k = 0; k < 4; ++k) q2[k] = *(const LAS bf16x8*)(qp + 16 * k); }
                    f32x16 oi[2]; oi[0] = (f32x16){0.f,0.f,0.f,0.f,0.f,0.f,0.f,0.f,0.f,0.f,0.f,0.f,0.f,0.f,0.f,0.f}; oi[1] = oi[0]; float li = 0.f;
#pragma unroll
                    for (int sub = 0; sub < 2; ++sub) { f32x16 st; const int dbs_ = tq_abs - 64 * s - 32 * sub - 4 * hi;
                      if (far_) st_bias_far(st, cbias); else if (in_) st_bias_in<1>(st, dbs_, blp); else st_bias<1>(st, dbs_, blp);
#pragma unroll
                      for (int k = 0; k < 4; ++k) st = MFMA32(__builtin_bit_cast(bf16x8, kv_[4 * sub + k]), q2[k], st);
                      li += st_exp<0, 1>(st, 0);
                      const bf16x8 pb0 = pack8(st, 0), pb1 = pack8(st, 1);
#pragma unroll
                      for (int mt = 0; mt < 2; ++mt) { oi[mt] = MFMA32(__builtin_bit_cast(bf16x8, kv_[8 + 4 * sub + 2 * mt]), pb0, oi[mt]); oi[mt] = MFMA32(__builtin_bit_cast(bf16x8, kv_[8 + 4 * sub + 2 * mt + 1]), pb1, oi[mt]); }
                      __builtin_amdgcn_sched_barrier(0); }
                    if (valid && !(REP_SUB == 6 && rep_)) { const int rowi = tq * 4 + hp; LAS int* orow = OACC + rowi * 64; const int swz = rowi & 31;
#pragma unroll
                        for (int mt = 0; mt < 2; ++mt)
#pragma unroll
                            for (int r = 0; r < 16; ++r) { const int dim = 32 * mt + (r & 3) + 8 * (r >> 2) + 4 * hi; __hip_atomic_fetch_add(orow + (dim ^ swz), __float2int_rn(oi[mt][r] * rs_), __ATOMIC_RELAXED, __HIP_MEMORY_SCOPE_WORKGROUP); }
                        __hip_atomic_fetch_add(LACC + rowi, __float2int_rn(li * rs_ * LFIX), __ATOMIC_RELAXED, __HIP_MEMORY_SCOPE_WORKGROUP); }
                }
                NSA_NEXTBLK(s);
            }
            }
        }
        __syncthreads();
        {
            int rowi = ti * 4 + hp; asm volatile("" : "+v"(rowi)); const LAS int* orow = OACC + rowi * 64; const int swz = rowi & 31;
            const float gs = GATE[(ti * 4 + hp) * 3 + 1] / ((float)LACC[rowi] * (1.0f / LFIX)) * (1.0f / OFIX);
            bf16* od = OATT + mrow * D + h * 64;
#pragma unroll
            for (int mt = 0; mt < 2; ++mt)
#pragma unroll
                for (int q = 0; q < 4; ++q) { const int dim0 = 32 * mt + 8 * q + 4 * hi; float o4[4];
                    const unsigned long long pkq = *(const GAS unsigned long long*)((const bf16*)OPARK + mrow * D + h * 64 + dim0);
                    const f32x4 pk4 = {bflo((unsigned)pkq), bfhi((unsigned)pkq), bflo((unsigned)(pkq >> 32)), bfhi((unsigned)(pkq >> 32))};
#pragma unroll
                    for (int e = 0; e < 4; ++e) o4[e] = pk4[e] + (float)orow[(dim0 + e) ^ swz] * gs;
                    *(GAS unsigned long long*)(od + dim0) = (unsigned long long)cvtpk(o4[0], o4[1]) | ((unsigned long long)cvtpk(o4[2], o4[3]) << 32); }
        }
    }
}

enum Phase { P_PRO, P_IN0, P_HA, P_HB, P_HC, P_OUT0, P_GU0, P_DN0, P_KVQ, P_PREP, P_NSA, P_OUT1, P_ROUTE, P_MOE1, P_MOE2, P_COMB, N_PHASES };
#define NREP(k) (REP_PHASE == (int)(k) ? 2 : 1)
#define REPEAT(k, call) do { if (REP_PHASE == (int)(k)) { __syncthreads(); call; } } while (0)
__global__ void __launch_bounds__(NWAVES * 64, 2) fwd_kernel(Args args) {
    extern __shared__ __attribute__((aligned(16))) unsigned char lds[];
    Frame F;
    F.lds = (LAS unsigned char*)lds;
    F.MISC = (volatile LAS unsigned*)(F.lds + MISC_OFF);
    F.tid = threadIdx.x; F.lane = F.tid & 63; F.wave = __builtin_amdgcn_readfirstlane(F.tid >> 6);
    F.G = gridDim.x; { const int bx = blockIdx.x; F.vcu = (F.G % 8 == 0) ? (bx % 8) * (F.G / 8) + bx / 8 : bx; }
    F.ws = args.ws; F.out = args.out; F.ctl = (gu32*)(args.ws + WS_CTL);
    unsigned char* ws = args.ws;
    for (int u = F.tid; u < (LDS_BYTES - LDSCTL_OFF) / 4; u += NWAVES * 64) ((LAS unsigned*)(F.lds + LDSCTL_OFF))[u] = 0u;
    __syncthreads();
    XcdBarrier bar; bar.bar = (unsigned*)(F.ctl + CW_BAR); bar.x = 0; bar.st = nullptr;
    if (MK_SINGLE) bar = xcd_barrier_post((unsigned*)(F.ctl + CW_BAR), F.MISC + 8);
    const int lo = args.ph_lo, hi = args.ph_hi;
#define IN(k) (lo <= (k) && (k) < hi)
#define SEAM(k) do { if (MK_SINGLE && IN(k) && hi > (k) + 1) xcd_barrier(bar); } while (0)
    bf16* XN = (bf16*)(ws + WS_XN);

#define GEMM_IN0() do { pg8::Gemm g{XN, (const bf16*)(ws + WS_W_IN0), D}; pg8::StaticOrder S; S.init(M, NIN0, F.G, (int)blockIdx.x); pg8::EpiBf16 E{(bf16*)(ws + WS_QFIG), NIN0, nullptr, 0, nullptr, 0}; \
        pg8::gemm_phase<pg8::EpiBf16, pg8::StaticOrder, true>(F.lds + RING_OFF, g, S, E); } while (0)
#define GEMM_OUT0() do { pg8::Gemm g{(const bf16*)(ws + WS_OG), (const bf16*)(ws + WS_W_OUT0), D}; pg8::StaticOrder S; S.init(M, D, F.G, (int)blockIdx.x); pg8::EpiResF32 E{args.in[I_X], nullptr, nullptr, D, XN, (float*)(ws + WS_SSP1), nullptr}; \
        pg8::gemm_phase<pg8::EpiResF32, pg8::StaticOrder, true>(F.lds + RING_OFF, g, S, E); } while (0)
#define GEMM_GU0() do { pg8::Gemm g{XN, (const bf16*)(ws + WS_W_GU0), D}; pg8::StaticOrder S; S.init(M, 2 * FF, F.G, (int)blockIdx.x); pg8::EpiSwiglu E{(bf16*)(ws + WS_ACT), FF, (const float*)(ws + WS_SSP1)}; \
        pg8::gemm_phase<pg8::EpiSwiglu, pg8::StaticOrder, true>(F.lds + RING_OFF, g, S, E); } while (0)
#define GEMM_DN0() do { pg8::Gemm g{(const bf16*)(ws + WS_ACT), (const bf16*)(ws + WS_W_DN0), FF}; pg8::StaticOrder S; S.init(M, D, F.G, (int)blockIdx.x); pg8::EpiResF32 E{nullptr, XN, nullptr, D, XN, (float*)(ws + WS_SSP2), nullptr}; \
        pg8::gemm_phase<pg8::EpiResF32, pg8::StaticOrder, true>(F.lds + RING_OFF, g, S, E); } while (0)
#define GEMM_KVQ() do { pg8::Gemm g{XN, (const bf16*)(ws + WS_W_KV), D}; pg8::StaticOrder S; S.init(M, NKV + NQINP, F.G, (int)blockIdx.x); \
        pg8::EpiBf16 E{(bf16*)(ws + WS_KV), NKV, (const float*)(ws + WS_SSP2), NKV / 256, (bf16*)(ws + WS_QG), NQINP}; pg8::gemm_phase<pg8::EpiBf16, pg8::StaticOrder, true>(F.lds + RING_OFF, g, S, E); } while (0)
#define GEMM_OUT1() do { pg8::Gemm g{(const bf16*)(ws + WS_OATT), (const bf16*)(ws + WS_W_OUT1), D}; pg8::StaticOrder S; S.init(M, D, F.G, (int)blockIdx.x); pg8::EpiResF32 E{nullptr, XN, nullptr, D, XN, (float*)(ws + WS_SSP3), nullptr}; \
        pg8::gemm_phase<pg8::EpiResF32, pg8::StaticOrder, true>(F.lds + RING_OFF, g, S, E); } while (0)
#define GEMM_MOE1() do { pg8::Gemm g{(const bf16*)(ws + WS_XG8), (const bf16*)(ws + WS_W_GU1), D}; MoeOrder S; S.init(F.ctl + CW_ECNT, 2 * EF / 256, F.G, F.vcu, true); \
        pg8::EpiSwigluF8 E{(unsigned char*)(ws + WS_ACT2), EF, (const float*)(ws + WS_RS_E)}; pg8::gemm_phase<pg8::EpiSwigluF8, MoeOrder, true, true>(F.lds + RING_OFF, g, S, E); } while (0)
#define GEMM_MOE2() do { pg8::Gemm g{(const bf16*)(ws + WS_ACT2), (const bf16*)(ws + WS_W_DN1), EF}; MoeOrderKS S; S.init(F.ctl + CW_ECNT, D / 256, F.G, F.vcu, false); \
        pg8::EpiMoeDown E{(bf16*)(ws + WS_Y2), D, 1.0f / (pg8::F8_WSCALE * pg8::F8_ASCALE), (bf16*)(ws + WS_YP1), (bf16*)(ws + WS_YP2), (bf16*)(ws + WS_YP3)}; pg8::gemm_phase<pg8::EpiMoeDown, MoeOrderKS, true, true>(F.lds + RING_OFF, g, S, E); } while (0)
    if (IN(P_PRO)) { p0_prologue(F, args); p_biaslut(F, args.in[I_REL_BIAS]); REPEAT(P_PRO, p0_prologue(F, args)); } SEAM(P_PRO);
    if (IN(P_IN0)) { GEMM_IN0(); REPEAT(P_IN0, GEMM_IN0()); } SEAM(P_IN0);
    if (IN(P_HA)) { p_hg_a(F); REPEAT(P_HA, p_hg_a(F)); } SEAM(P_HA);
    if (IN(P_HB)) { p_hg_b(F); REPEAT(P_HB, p_hg_b(F)); } SEAM(P_HB);
    if (IN(P_HC)) { p_hg_c(F, args.in[I_A_ONORM]); REPEAT(P_HC, p_hg_c(F, args.in[I_A_ONORM])); } SEAM(P_HC);
    if (IN(P_OUT0)) { GEMM_OUT0();  } SEAM(P_OUT0);
    if (IN(P_GU0)) { GEMM_GU0(); REPEAT(P_GU0, GEMM_GU0()); p0_deferred(F, args, NWG_GU0, false); } SEAM(P_GU0);
    if (IN(P_DN0)) { GEMM_DN0();  } SEAM(P_DN0);
    if (IN(P_KVQ)) { GEMM_KVQ(); REPEAT(P_KVQ, GEMM_KVQ()); p0_deferred(F, args, NWG_KVQ, true); } SEAM(P_KVQ);
    if (IN(P_PREP)) { p_knorm(F, args.in[I_K_NORM], args.in[I_B_QNORM]); p_vtrans(F); __syncthreads(); p_compress_mfma(F, args.in[I_K_NORM], args.in[I_B_QNORM]);
        REPEAT(P_PREP, p_vtrans(F); __syncthreads(); p_compress_mfma(F, args.in[I_K_NORM], args.in[I_B_QNORM])); } SEAM(P_PREP);
    if (IN(P_NSA)) { p_nsa(F, args); REPEAT(P_NSA, p_nsa(F, args)); } SEAM(P_NSA);
    if (IN(P_OUT1)) { GEMM_OUT1();  } SEAM(P_OUT1);
    if (IN(P_ROUTE)) { p_route(F, args); REPEAT(P_ROUTE, p_route(F, args, true)); } SEAM(P_ROUTE);
    if (IN(P_MOE1)) { GEMM_MOE1(); REPEAT(P_MOE1, GEMM_MOE1()); } SEAM(P_MOE1);
    if (IN(P_MOE2)) { GEMM_MOE2(); REPEAT(P_MOE2, GEMM_MOE2()); } SEAM(P_MOE2);
    if (IN(P_COMB)) { p_moe_combine(F); }
#undef IN
#undef SEAM
}

extern "C" void kernel_launch(void* const* d_in, const int* in_sizes, int n_in, void* d_out, int out_size, void* d_ws, size_t ws_size, hipStream_t stream) {
    static int grid = 0;
    if (grid == 0) {
        if (n_in != N_IN || in_sizes[0] != M * D || out_size != M * D || ws_size < WS_END) { fprintf(stderr, "kernel_launch: unexpected shapes (n_in %d, in0 %d, out %d, ws %zu < %zu); nothing launched\n", n_in, n_in > 0 ? in_sizes[0] : -1, out_size, ws_size, (size_t)WS_END); grid = -1; return; }
        int dev = 0, cus = 0, per_cu = 0;
        if (hipGetDevice(&dev) != hipSuccess || hipDeviceGetAttribute(&cus, hipDeviceAttributeMultiprocessorCount, dev) != hipSuccess) { grid = -1; return; }
        if (hipFuncSetAttribute((const void*)fwd_kernel, hipFuncAttributeMaxDynamicSharedMemorySize, LDS_BYTES) != hipSuccess) { fprintf(stderr, "kernel_launch: hipFuncSetAttribute failed\n"); grid = -1; return; }
        if (hipOccupancyMaxActiveBlocksPerMultiprocessor(&per_cu, (const void*)fwd_kernel, NWAVES * 64, LDS_BYTES) != hipSuccess || per_cu < 1)
            fprintf(stderr, "kernel_launch: note: occupancy query reports %d workgroups per CU\n", per_cu);
        (void)hipGetLastError();
        grid = cus;
    }
    if (grid < 0) return;
    if (hipMemsetAsync((char*)d_ws + WS_CTL, 0, CTL_ZERO_BYTES, stream) != hipSuccess) { fprintf(stderr, "kernel_launch: hipMemsetAsync failed\n"); return; }
    Args a{};
    for (int i = 0; i < N_IN; ++i) a.in[i] = (const float*)d_in[i];
    a.out = (float*)d_out; a.ws = (unsigned char*)d_ws;
#if MK_SINGLE
    a.ph_lo = 0; a.ph_hi = N_PHASES;
    hipLaunchKernelGGL(fwd_kernel, dim3(grid), dim3(NWAVES * 64), LDS_BYTES, stream, a);
#else
    for (int p = 0; p < N_PHASES; ++p) { a.ph_lo = p; a.ph_hi = p + 1; hipLaunchKernelGGL(fwd_kernel, dim3(grid), dim3(NWAVES * 64), LDS_BYTES, stream, a); }
#endif
}
```
